# Optimizing an MI355X kernel written in HIP

```python
import math
import jax
import jax.numpy as jnp
from jax import lax
import numpy as np

D_MODEL = 2048
BATCH = 8
SEQ = 2048
DEPTH = 1

CHUNK = 64
Q_BLOCK = 128
EPS = 1e-6

HG_HEADS = 8
HG_DK = 128
HG_DV = 128
HG_WIDTH = HG_HEADS * HG_DK

DA_HEADS = 8
DA_DQK = 64
DA_DV = 2 * DA_DQK
DA_WIDTH = DA_HEADS * DA_DV
ROPE_DIM = DA_DQK // 4
ROPE_THETA = 500000.0

IN_SPLITS = (HG_WIDTH, HG_WIDTH, HG_WIDTH, HG_WIDTH,
             DA_WIDTH, DA_WIDTH, DA_WIDTH,
             D_MODEL, D_MODEL)
IN_COLS = sum(IN_SPLITS)

N_GROUPS = 4
EXPERTS_PER_GROUP = 8
N_EXPERTS = N_GROUPS * EXPERTS_PER_GROUP
TOP_K = 2
D_EXPERT = 1024
MOE_BLOCK = 128

kernel_name = "hybrid_hgrn2_diffattn_hmoe_block"


def rms_norm(x, w):
    xf = x.astype(jnp.float32)
    y = xf * lax.rsqrt(jnp.mean(xf * xf, axis=-1, keepdims=True) + EPS)
    return (y * w.astype(jnp.float32)).astype(x.dtype)


def partial_rope(t, cos, sin):
    r, p = t[..., :ROPE_DIM], t[..., ROPE_DIM:]
    r1, r2 = r[..., :ROPE_DIM // 2], r[..., ROPE_DIM // 2:]
    rot = jnp.concatenate([r1 * cos - r2 * sin, r2 * cos + r1 * sin], axis=-1)
    return jnp.concatenate([rot.astype(t.dtype), p], axis=-1)


def hgrn2_mixer(q, f_logit, i, g, lb, norm_w):
    B, S = q.shape[:2]
    nc = S // CHUNK
    f32 = jnp.float32
    q = jax.nn.silu(q.astype(f32)).reshape(B, S, HG_HEADS, HG_DK)
    lb = lb.astype(f32).reshape(HG_HEADS, HG_DK)
    f = lb + (1.0 - lb) * jax.nn.sigmoid(f_logit.astype(f32).reshape(B, S, HG_HEADS, HG_DK))
    k = 1.0 - f
    logf = jnp.log(f)
    v = i.astype(f32).reshape(B, S, HG_HEADS, HG_DV)

    def to_chunks(t):
        return t.reshape(B, nc, CHUNK, HG_HEADS, t.shape[-1]).transpose(1, 0, 3, 2, 4)

    qc, kc, vc, lc = (to_chunks(t) for t in (q, k, v, logf))
    bc = jnp.cumsum(lc, axis=3)
    causal = jnp.tril(jnp.ones((CHUNK, CHUNK), dtype=bool))

    def step(state, inp):
        q_, k_, v_, b_ = inp
        rel = b_[:, :, :, None, :] - b_[:, :, None, :, :]
        decay = jnp.exp(jnp.where(causal[:, :, None], rel, -jnp.inf))
        scores = jnp.sum(q_[:, :, :, None, :] * k_[:, :, None, :, :] * decay, axis=-1)
        o = (jnp.einsum('bhts,bhsv->bhtv', scores, v_)
             + jnp.einsum('bhtk,bhkv->bhtv', q_ * jnp.exp(b_), state))
        b_end = b_[:, :, -1:, :]
        state = (jnp.exp(b_end[:, :, 0, :])[..., None] * state
                 + jnp.einsum('bhsk,bhsv->bhkv', k_ * jnp.exp(b_end - b_), v_))
        return state, o

    s0 = jnp.zeros((B, HG_HEADS, HG_DK, HG_DV), f32)
    _, o = lax.scan(step, s0, (qc, kc, vc, bc))
    o = o.transpose(1, 0, 3, 2, 4).reshape(B, S, HG_HEADS, HG_DV)
    o = o * lax.rsqrt(jnp.mean(o * o, axis=-1, keepdims=True) + EPS)
    o = o * norm_w.astype(f32).reshape(HG_HEADS, HG_DV)
    o = o.reshape(B, S, HG_WIDTH) * jax.nn.sigmoid(g.astype(f32))
    return o.astype(i.dtype)


def diff_attention(q, k, v, lam, lambda_init, norm_w):
    B, S = q.shape[:2]
    f32 = jnp.float32
    q = q.reshape(B, S, DA_HEADS, 2, DA_DQK)
    k = k.reshape(B, S, DA_HEADS, 2, DA_DQK)
    v = v.reshape(B, S, DA_HEADS, DA_DV)
    pos = jnp.arange(S, dtype=f32)
    inv_freq = ROPE_THETA ** (-jnp.arange(0, ROPE_DIM, 2, dtype=f32) / ROPE_DIM)
    ang = pos[:, None] * inv_freq[None, :]
    cos = jnp.cos(ang)[None, :, None, None, :]
    sin = jnp.sin(ang)[None, :, None, None, :]
    q = partial_rope(q, cos, sin)
    k = partial_rope(k, cos, sin)
    scale = DA_DQK ** -0.5
    chunk_id = jnp.arange(S) // CHUNK
    outs = []
    for start in range(0, S, Q_BLOCK):
        end = start + Q_BLOCK
        s = jnp.einsum('bqhmd,bkhmd->bhmqk', q[:, start:end], k[:, :end]).astype(f32) * scale
        allowed = chunk_id[start:end, None] >= chunk_id[None, :end]
        p = jax.nn.softmax(jnp.where(allowed, s, -jnp.inf), axis=-1)
        a = p[:, :, 0] - lam * p[:, :, 1]
        outs.append(jnp.einsum('bhqk,bkhv->bqhv', a.astype(v.dtype), v[:, :end]))
    o = jnp.concatenate(outs, axis=1).astype(f32)
    o = o * lax.rsqrt(jnp.mean(o * o, axis=-1, keepdims=True) + EPS)
    o = o * norm_w.astype(f32).reshape(DA_HEADS, DA_DV) * (1.0 - lambda_init)
    return o.reshape(B, S, DA_WIDTH).astype(v.dtype)


def routed_experts(h, e_idx, e_w, w_gate, w_up, w_down):
    T, D = h.shape
    A = T * TOP_K
    flat_e = e_idx.reshape(-1)
    flat_tok = jnp.arange(A, dtype=jnp.int32) // TOP_K
    flat_w = e_w.reshape(-1)
    order = jnp.argsort(flat_e)
    sorted_e = flat_e[order]
    counts = jnp.bincount(flat_e, length=N_EXPERTS)
    starts = jnp.cumsum(counts) - counts
    padded = (counts + MOE_BLOCK - 1) // MOE_BLOCK * MOE_BLOCK
    pends = jnp.cumsum(padded)
    pstarts = pends - padded
    dest = pstarts[sorted_e] + (jnp.arange(A) - starts[sorted_e])
    n_blocks = A // MOE_BLOCK + N_EXPERTS
    rows = n_blocks * MOE_BLOCK
    slot_tok = jnp.full((rows,), T, dtype=jnp.int32).at[dest].set(flat_tok[order])
    slot_w = jnp.zeros((rows,), jnp.float32).at[dest].set(flat_w[order])
    block_e = jnp.searchsorted(pends, jnp.arange(n_blocks) * MOE_BLOCK, side='right')
    block_e = jnp.minimum(block_e, N_EXPERTS - 1)
    h_pad = jnp.concatenate([h, jnp.zeros((1, D), h.dtype)], axis=0)
    xb = h_pad[slot_tok].reshape(n_blocks, MOE_BLOCK, D)

    def expert_block(args):
        xblk, e = args
        return (jax.nn.silu(xblk @ w_gate[e]) * (xblk @ w_up[e])) @ w_down[e]

    yb = lax.map(expert_block, (xb, block_e)).reshape(rows, D)
    y = jnp.zeros((T + 1, D), jnp.float32).at[slot_tok].add(yb.astype(jnp.float32) * slot_w[:, None])
    return y[:T].astype(h.dtype)


def hierarchical_moe(h, w_group, b_group, w_router, b_router, w_gate, w_up, w_down):
    T = h.shape[0]
    gl = (h @ w_group).astype(jnp.float32) + b_group.astype(jnp.float32)
    gp = jax.nn.softmax(gl, axis=-1)
    g_idx = jnp.argmax(gl, axis=-1)
    g_w = jnp.take_along_axis(gp, g_idx[:, None], axis=-1)
    el = ((h @ w_router).astype(jnp.float32) + b_router.astype(jnp.float32))
    el = el.reshape(T, N_GROUPS, EXPERTS_PER_GROUP)
    el = jnp.take_along_axis(el, g_idx[:, None, None], axis=1)[:, 0]
    top_v, top_i = lax.top_k(el, TOP_K)
    e_w = jax.nn.softmax(top_v, axis=-1) * g_w
    e_idx = g_idx[:, None].astype(jnp.int32) * EXPERTS_PER_GROUP + top_i.astype(jnp.int32)
    return routed_experts(h, e_idx, e_w, w_gate, w_up, w_down)


def setup_inputs(seed: int = 0) -> dict:
    key = jax.random.key(seed)
    ks = jax.random.split(key, 32)
    f32 = jnp.float32
    L, D = DEPTH, D_MODEL

    def nrm(k, shape, scale):
        return jax.random.normal(k, shape, f32) * scale

    def gain(k, shape):
        return 1.0 + 0.05 * jax.random.normal(k, shape, f32)

    return {
        "x": nrm(ks[0], (BATCH, SEQ, D), 1.0),
        "c": nrm(ks[1], (BATCH, D), 1.0),
        "w_ada": nrm(ks[2], (L, D, 6 * D), 0.5 * D ** -0.5),
        "b_ada": nrm(ks[3], (L, 6 * D), 0.02),
        "pre_norm_mix": gain(ks[4], (L, D)),
        "post_norm_mix": gain(ks[5], (L, D)),
        "pre_norm_ffn": gain(ks[6], (L, D)),
        "post_norm_ffn": gain(ks[7], (L, D)),
        "w_in": nrm(ks[8], (L, D, IN_COLS), D ** -0.5),
        "hg_lb_param": nrm(ks[9], (L + 1, HG_WIDTH), 0.1),
        "hg_norm_w": gain(ks[10], (L, HG_WIDTH)),
        "lambda_q1": nrm(ks[11], (L, DA_DQK), 0.1),
        "lambda_k1": nrm(ks[12], (L, DA_DQK), 0.1),
        "lambda_q2": nrm(ks[13], (L, DA_DQK), 0.1),
        "lambda_k2": nrm(ks[14], (L, DA_DQK), 0.1),
        "da_norm_w": gain(ks[15], (L, DA_WIDTH)),
        "w_branch_hg": nrm(ks[16], (L, HG_WIDTH, D), HG_WIDTH ** -0.5),
        "w_branch_da": nrm(ks[17], (L, DA_WIDTH, D), DA_WIDTH ** -0.5),
        "w_out": nrm(ks[18], (L, D, D), D ** -0.5),
        "w_group": nrm(ks[19], (L, D, N_GROUPS), D ** -0.5),
        "b_group": nrm(ks[20], (L, N_GROUPS), 0.01),
        "w_expert_router": nrm(ks[21], (L, D, N_EXPERTS), D ** -0.5),
        "b_expert_router": nrm(ks[22], (L, N_EXPERTS), 0.01),
        "w_gate": nrm(ks[23], (L, N_EXPERTS, D, D_EXPERT), D ** -0.5),
        "w_up": nrm(ks[24], (L, N_EXPERTS, D, D_EXPERT), D ** -0.5),
        "w_down": nrm(ks[25], (L, N_EXPERTS, D_EXPERT, D), D_EXPERT ** -0.5),
    }


def reference(x, c, w_ada, b_ada, pre_norm_mix, post_norm_mix, pre_norm_ffn, post_norm_ffn,
              w_in, hg_lb_param, hg_norm_w, lambda_q1, lambda_k1, lambda_q2, lambda_k2, da_norm_w,
              w_branch_hg, w_branch_da, w_out, w_group, b_group, w_expert_router, b_expert_router,
              w_gate, w_up, w_down):
    B, S, D = x.shape
    lb_all = jnp.cumsum(jax.nn.softmax(hg_lb_param.astype(jnp.float32), axis=0), axis=0)
    cond = jax.nn.silu(c)
    split_pts = list(np.cumsum(IN_SPLITS)[:-1])
    for l in range(DEPTH):
        mod = cond @ w_ada[l] + b_ada[l]
        sh1, sc1, gt1, sh2, sc2, gt2 = (m[:, None, :] for m in jnp.split(mod, 6, axis=-1))

        h = rms_norm(x, pre_norm_mix[l]) * (1.0 + sc1) + sh1
        proj = h @ w_in[l]
        q_hg, f_hg, i_hg, g_hg, q_da, k_da, v_da, gate_hg, gate_da = jnp.split(proj, split_pts, axis=-1)
        y_hg = hgrn2_mixer(q_hg, f_hg, i_hg, g_hg, lb_all[l], hg_norm_w[l])
        lambda_init = 0.8 - 0.6 * math.exp(-0.3 * l)
        lam = (jnp.exp(jnp.sum(lambda_q1[l] * lambda_k1[l]).astype(jnp.float32))
               - jnp.exp(jnp.sum(lambda_q2[l] * lambda_k2[l]).astype(jnp.float32)) + lambda_init)
        y_da = diff_attention(q_da, k_da, v_da, lam, lambda_init, da_norm_w[l])
        merged = (jax.nn.sigmoid(gate_hg) * (y_hg @ w_branch_hg[l])
                  + jax.nn.sigmoid(gate_da) * (y_da @ w_branch_da[l]))
        u = merged @ w_out[l]
        x = x + gt1 * rms_norm(u, post_norm_mix[l])

        h = rms_norm(x, pre_norm_ffn[l]) * (1.0 + sc2) + sh2
        y = hierarchical_moe(h.reshape(B * S, D), w_group[l], b_group[l], w_expert_router[l],
                             b_expert_router[l], w_gate[l], w_up[l], w_down[l]).reshape(B, S, D)
        x = x + gt2 * rms_norm(y, post_norm_ffn[l])
    return x
```

```cpp
#include <hip/hip_runtime.h>
#include <cstdio>
#include <cstdint>

constexpr int DM = 2048, NB = 8, SEQ = 2048, T = NB * SEQ;
constexpr int HW = 1024;
constexpr int NH = 8, HD = 128;
constexpr int INC = 11264;
constexpr int NE = 32, EPG = 8, NG = 4, DE = 1024;
constexpr float EPS = 1e-6f;
constexpr float LAMBDA_INIT = 0.2f;
constexpr float QSCALE = 0.125f * 1.4426950408889634f;
constexpr int SLOT_MAX = 40960;

constexpr int NWAVES = 8, NTHREADS = 512;
enum { PH_PRO = 0, PH_H1, PH_PROJ, PH_MIX, PH_YDA, PH_BRANCH, PH_WOUT, PH_POST, PH_MOE1, PH_MOE2, PH_FINAL, N_PHASES };
#ifndef MK_ONE_LAUNCH
#define MK_ONE_LAUNCH 0
#endif

constexpr size_t MiB = 1u << 20;
constexpr size_t WS_CTL = 0, CTL_ZERO_BYTES = 1 * MiB;
constexpr size_t WS_MODP = 1 * MiB;
constexpr size_t WS_ROPE = 4 * MiB;
constexpr size_t WS_LB = 4 * MiB + 256 * 1024;
constexpr size_t WS_LAM = WS_LB + 8192;
constexpr size_t WS_TOKE = 5 * MiB;
constexpr size_t WS_TOKP = 5 * MiB + 256 * 1024;
constexpr size_t WS_LISTTOK = 6 * MiB;
constexpr size_t WS_LISTW = 8 * MiB;
constexpr size_t WS_WIN_T = 16 * MiB, WS_WBH_T = 60 * MiB, WS_WBD_T = 64 * MiB, WS_WOUT_T = 68 * MiB, WS_WGU_T = 76 * MiB, WS_WD_T = 332 * MiB;
constexpr size_t WS_TMPG = 76 * MiB;
constexpr size_t WS_H1 = 460 * MiB, WS_QHG = 524 * MiB, WS_LOGF = 556 * MiB, WS_VHG = 620 * MiB, WS_GHG = 652 * MiB;
constexpr size_t WS_QDA = 684 * MiB, WS_KDA = 716 * MiB, WS_VDA = 748 * MiB, WS_GATEH = 780 * MiB, WS_GATED = 844 * MiB;
constexpr size_t WS_YHG = 908 * MiB, WS_YDA = 940 * MiB, WS_O1 = 972 * MiB, WS_O2 = 1004 * MiB, WS_END = 1036 * MiB;
constexpr size_t WS_TMP = 460 * MiB;
constexpr size_t WS_MERGED = 588 * MiB;
constexpr size_t WS_U = 652 * MiB;
constexpr size_t WS_X1 = 460 * MiB;
constexpr size_t WS_H2 = 588 * MiB;
constexpr size_t WS_ACT = 716 * MiB;
constexpr size_t WS_YW = 796 * MiB;
constexpr int CW_TMO = 0, CW_CODE = 1, CW_BAR = 4096, CW_CNT = 8192  , CW_ATTQ = 9216;

constexpr int RING_BYTES = 131072 + 8192;
constexpr int LDSCTL_OFF = RING_BYTES, MISC_OFF = LDSCTL_OFF + 320;
constexpr int LDS_BYTES = 147456;
static_assert(MISC_OFF + 128 <= LDS_BYTES, "LDS map");

#define GAS __attribute__((address_space(1)))
#define LAS __attribute__((address_space(3)))
typedef unsigned short bf16;
typedef float f32x4 __attribute__((ext_vector_type(4)));
typedef unsigned u32x4 __attribute__((ext_vector_type(4)));
typedef unsigned u32x2 __attribute__((ext_vector_type(2)));
typedef GAS unsigned gu32;
#define RLX_AGENT __ATOMIC_RELAXED, __HIP_MEMORY_SCOPE_AGENT

__device__ __forceinline__ float bf2f(unsigned h) { return __uint_as_float(h << 16); }
__device__ __forceinline__ unsigned f2bf(float f) { unsigned u = __float_as_uint(f); return (u + 0x7fffu + ((u >> 16) & 1u)) >> 16; }
__device__ __forceinline__ unsigned pk2(float lo, float hi) { return f2bf(lo) | (f2bf(hi) << 16); }
__device__ __forceinline__ float sigmoidf_(float v) { return 1.0f / (1.0f + __expf(-v)); }
__device__ __forceinline__ float wave_sum(float v) {
#pragma unroll
    for (int o = 1; o < 64; o <<= 1) v += __shfl_xor(v, o);
    return v;
}

#define XB_TMO      128
#define XB_XCNT(j)  (256  + 64 * (j))
#define XB_XSUB(j)  (1280 + 64 * (j))
#define XB_XGEN(j)  (2304 + 64 * (j))
#define XB_TOP      3328
#define XB_TOPGEN   3392
#define XCD_BAR_WORDS 3456
#define XB_SPIN_CAP (1u << 22)
__device__ __forceinline__ unsigned xb_ld(unsigned* p)              { return __hip_atomic_load(p, __ATOMIC_RELAXED, __HIP_MEMORY_SCOPE_AGENT); }
__device__ __forceinline__ unsigned xb_add(unsigned* p, unsigned v) { return __hip_atomic_fetch_add(p, v, __ATOMIC_RELAXED, __HIP_MEMORY_SCOPE_AGENT); }
__device__ __forceinline__ unsigned xb_xcc_id() { return (unsigned)__builtin_amdgcn_s_getreg((3 << 11) | 20) & 0xFu; }
#define XB_SPIN(cond, bar) do { unsigned _sp = 0; while (cond) { __builtin_amdgcn_s_sleep(1); \
    if ((++_sp & 255u) == 0u) { if (xb_ld(&(bar)[XB_TMO])) break; if (_sp > XB_SPIN_CAP) { atomicAdd(&(bar)[XB_TMO], 1u); break; } } } } while (0)
struct XcdBarrier { unsigned* bar; unsigned x; volatile LAS unsigned* st; };
__device__ __forceinline__ XcdBarrier xcd_barrier_post(unsigned* bar, volatile LAS unsigned* st) {
    XcdBarrier b; b.bar = bar; b.x = xb_xcc_id(); b.st = st;
    if (threadIdx.x == 0) (void)xb_add(&bar[XB_XCNT(b.x)], 1u);
    return b;
}
__device__ __forceinline__ void xcd_barrier_complete(unsigned* bar, unsigned x, unsigned& nloc, unsigned& nx) {
    const unsigned G = gridDim.x * gridDim.y * gridDim.z;
    unsigned sum, cnt, mine, sp = 0u;
    for (;;) {
        sum = 0u; cnt = 0u; mine = 0u;
#pragma unroll
        for (unsigned j = 0; j < 16; ++j) { const unsigned c = xb_ld(&bar[XB_XCNT(j)]); sum += c; cnt += (c > 0u) ? 1u : 0u; mine = (j == x) ? c : mine; }
        if (sum == G) break;
        __builtin_amdgcn_s_sleep(1);
        if ((++sp & 255u) == 0u) { if (xb_ld(&bar[XB_TMO])) break; if (sp > XB_SPIN_CAP) { atomicAdd(&bar[XB_TMO], 1u); break; } }
    }
    nloc = mine > 0u ? mine : 1u; nx = cnt > 0u ? cnt : 1u;
}
__device__ __forceinline__ void xcd_barrier(const XcdBarrier& b) {
    asm volatile("s_waitcnt vmcnt(0)" ::: "memory");
    __syncthreads();
    if (threadIdx.x == 0) {
        unsigned* bar = b.bar;
        __builtin_amdgcn_s_waitcnt(0);
        unsigned nloc = b.st[0], nx = b.st[1];
        if (nloc == 0u) { xcd_barrier_complete(bar, b.x, nloc, nx); b.st[0] = nloc; b.st[1] = nx; }
        const unsigned old = xb_add(&bar[XB_XSUB(b.x)], 1u);
        const unsigned gen = old / nloc;
        if (old + 1u == (gen + 1u) * nloc) {
            __builtin_amdgcn_fence(__ATOMIC_RELEASE, "agent");
            asm volatile("s_waitcnt vmcnt(0)" ::: "memory");
            const unsigned og = xb_add(&bar[XB_TOP], 1u);
            const unsigned tg = og / nx;
            if (og + 1u == (tg + 1u) * nx) xb_add(&bar[XB_TOPGEN], 1u);
            else XB_SPIN(xb_ld(&bar[XB_TOPGEN]) == tg, bar);
            __builtin_amdgcn_fence(__ATOMIC_ACQUIRE, "agent");
            xb_add(&bar[XB_XGEN(b.x)], 1u);
            asm volatile("s_waitcnt vmcnt(0)" ::: "memory");
        } else {
            XB_SPIN(xb_ld(&bar[XB_XGEN(b.x)]) == gen, bar);
            __builtin_amdgcn_fence(__ATOMIC_ACQUIRE, "agent");
            asm volatile("s_waitcnt vmcnt(0)" ::: "memory");
        }
    }
    __syncthreads();
}

struct Frame {
    LAS unsigned char* lds;
    gu32* ctl;
    int tid, lane, wave, G, bid;
    unsigned char* ws;
    const float* x; const float* c; const float* w_ada; const float* b_ada;
    const float *pre_mix, *post_mix, *pre_ffn, *post_ffn;
    const float* w_in; const float* hg_lb; const float* hg_nw;
    const float *lq1, *lk1, *lq2, *lk2; const float* da_nw;
    const float *w_bhg, *w_bda, *w_out, *w_group, *b_group, *w_router, *b_router, *w_gate, *w_up, *w_down;
    float* out;
};
template <class Tp> __device__ __forceinline__ Tp* wsp(const Frame& F, size_t off) { return (Tp*)(F.ws + off); }

__device__ __forceinline__ void mod_vec(const Frame& F, LAS float* dst, int chunk, int batch) {
    const float* P = wsp<const float>(F, WS_MODP);
    for (int j = F.tid; j < DM; j += NTHREADS) {
        float s = F.b_ada[chunk * DM + j];
#pragma unroll
        for (int kc = 0; kc < 8; ++kc) s += P[(size_t)(kc * 8 + batch) * (6 * DM) + chunk * DM + j];
        dst[j] = s;
    }
}

template <class Rows, class Epi>
__device__ __forceinline__ void sg_tile(LAS float* As, LAS float* Bs, const bf16* A, int lda, const Rows& rows, const float* B, int ldb, int n0, int K, const Epi& epi) {
    int tid = threadIdx.x; asm volatile("" : "+v"(tid));
    const int tx = tid & 15, ty = tid >> 4;
    float acc[4][8];
#pragma unroll
    for (int i = 0; i < 4; ++i)
#pragma unroll
        for (int j = 0; j < 8; ++j) acc[i][j] = 0.f;
    const int ar = tid >> 2, akq = tid & 3;
    const int arow = rows(ar);
    const bf16* ap = A + (size_t)(arow < 0 ? 0 : arow) * lda + akq * 4;
    const int bk = tid >> 5, bn = (tid & 31) * 4;
    const float* bp = B + (size_t)bk * ldb + n0 + bn;
    for (int k0 = 0; k0 < K; k0 += 16) {
        u32x2 av = *(const u32x2*)(ap + k0);
        const f32x4 bv = *(const f32x4*)(bp + (size_t)k0 * ldb);
        if (arow < 0) { av.x = 0u; av.y = 0u; }
        __syncthreads();
        As[(akq * 4 + 0) * 132 + ar] = bf2f(av.x & 0xffffu);
        As[(akq * 4 + 1) * 132 + ar] = bf2f(av.x >> 16);
        As[(akq * 4 + 2) * 132 + ar] = bf2f(av.y & 0xffffu);
        As[(akq * 4 + 3) * 132 + ar] = bf2f(av.y >> 16);
        *(LAS f32x4*)&Bs[bk * 132 + bn] = bv;
        __syncthreads();
#pragma unroll 2
        for (int kk = 0; kk < 16; ++kk) {
            const f32x4 a4 = *(const LAS f32x4*)&As[kk * 132 + ty * 4];
            const f32x4 b0 = *(const LAS f32x4*)&Bs[kk * 132 + tx * 8];
            const f32x4 b1 = *(const LAS f32x4*)&Bs[kk * 132 + tx * 8 + 4];
#pragma unroll
            for (int i = 0; i < 4; ++i) {
                acc[i][0] += a4[i] * b0[0]; acc[i][1] += a4[i] * b0[1]; acc[i][2] += a4[i] * b0[2]; acc[i][3] += a4[i] * b0[3];
                acc[i][4] += a4[i] * b1[0]; acc[i][5] += a4[i] * b1[1]; acc[i][6] += a4[i] * b1[2]; acc[i][7] += a4[i] * b1[3];
            }
        }
    }
#pragma unroll
    for (int i = 0; i < 4; ++i) epi(ty * 4 + i, n0 + tx * 8, acc[i]);
}
struct RowsDense { int m0; __device__ __forceinline__ int operator()(int r) const { return m0 + r; } };
struct RowsList { const int* list; int n; __device__ __forceinline__ int operator()(int r) const { return r < n ? list[r] : -1; } };

__device__ __forceinline__ void store8_bf16(bf16* p, const float (&v)[8]) {
    u32x4 w; w.x = pk2(v[0], v[1]); w.y = pk2(v[2], v[3]); w.z = pk2(v[4], v[5]); w.w = pk2(v[6], v[7]);
    *(u32x4*)p = w;
}

__device__ __forceinline__ void proj_store8(const Frame& F, int row, int col0, const float (&vin)[8], int pxor) {
    const int sec = col0 >> 10;
    float v[8];
#pragma unroll
    for (int i = 0; i < 8; ++i) v[i] = vin[i];
    if (sec == 0) {
#pragma unroll
        for (int i = 0; i < 8; ++i) v[i] = v[i] * sigmoidf_(v[i]);
        store8_bf16(wsp<bf16>(F, WS_QHG) + (size_t)row * HW + col0, v);
    } else if (sec == 1) {
        const int j = col0 - 1024; const float* lb = wsp<const float>(F, WS_LB) + j;
        float* o = wsp<float>(F, WS_LOGF) + (size_t)row * HW + j;
        f32x4 o0, o1;
#pragma unroll
        for (int i = 0; i < 8; ++i) { const float l = lb[i]; const float f = l + (1.0f - l) * sigmoidf_(v[i]); const float lf = __logf(f); if (i < 4) o0[i] = lf; else o1[i - 4] = lf; }
        *(f32x4*)o = o0; *(f32x4*)(o + 4) = o1;
    } else if (sec == 2) {
        store8_bf16(wsp<bf16>(F, WS_VHG) + (size_t)row * HW + (col0 - 2048), v);
    } else if (sec == 3) {
#pragma unroll
        for (int i = 0; i < 8; ++i) v[i] = sigmoidf_(v[i]);
        store8_bf16(wsp<bf16>(F, WS_GHG) + (size_t)row * HW + (col0 - 3072), v);
    } else if (sec == 4 || sec == 5) {
        const int d0 = col0 & 63;
        float pv[8];
#pragma unroll
        for (int i = 0; i < 8; ++i) pv[i] = __shfl_xor(v[i], pxor);
        if (d0 < 16) {
            const float* rt = wsp<const float>(F, WS_ROPE) + (size_t)(row & (SEQ - 1)) * 16;
            const f32x4 c0 = *(const f32x4*)rt, c1 = *(const f32x4*)(rt + 4), s0 = *(const f32x4*)(rt + 8), s1 = *(const f32x4*)(rt + 12);
            const float sg = (d0 == 0) ? -1.0f : 1.0f;
#pragma unroll
            for (int i = 0; i < 8; ++i) { const float cs = i < 4 ? c0[i] : c1[i - 4], sn = i < 4 ? s0[i] : s1[i - 4]; v[i] = v[i] * cs + sg * pv[i] * sn; }
        }
        if (sec == 4) {
#pragma unroll
            for (int i = 0; i < 8; ++i) v[i] *= QSCALE;
            store8_bf16(wsp<bf16>(F, WS_QDA) + (size_t)row * HW + (col0 - 4096), v);
        } else store8_bf16(wsp<bf16>(F, WS_KDA) + (size_t)row * HW + (col0 - 5120), v);
    } else if (sec == 6) {
        store8_bf16(wsp<bf16>(F, WS_VDA) + (size_t)row * HW + (col0 - 6144), v);
    } else {
#pragma unroll
        for (int i = 0; i < 8; ++i) v[i] = sigmoidf_(v[i]);
        if (sec < 9) store8_bf16(wsp<bf16>(F, WS_GATEH) + (size_t)row * DM + (col0 - 7168), v);
        else store8_bf16(wsp<bf16>(F, WS_GATED) + (size_t)row * DM + (col0 - 9216), v);
    }
}

__device__ __forceinline__ void ph_prologue(Frame& F) {
    const int gw = F.bid * NWAVES + F.wave, NGW = F.G * NWAVES;
    float* P = wsp<float>(F, WS_MODP);
    for (int it = gw; it < 48 * 8; it += NGW) {
        const int cb = it % 48, kc = it / 48;
        f32x4 acc[8];
#pragma unroll
        for (int b = 0; b < 8; ++b) acc[b] = (f32x4){0.f, 0.f, 0.f, 0.f};
        const float* wp = F.w_ada + (size_t)(kc * 256) * (6 * DM) + cb * 256 + F.lane * 4;
        const float* cp = F.c + kc * 256;
#pragma unroll 4
        for (int k = 0; k < 256; ++k) {
            const f32x4 w = *(const f32x4*)(wp + (size_t)k * (6 * DM));
#pragma unroll
            for (int b = 0; b < 8; ++b) { const float cv = cp[b * DM + k]; const float s = cv * sigmoidf_(cv); acc[b] += w * s; }
        }
#pragma unroll
        for (int b = 0; b < 8; ++b) *(f32x4*)(P + (size_t)(kc * 8 + b) * (6 * DM) + cb * 256 + F.lane * 4) = acc[b];
    }
    const int gt = F.bid * NTHREADS + F.tid, NGT = F.G * NTHREADS;
    float* rope = wsp<float>(F, WS_ROPE);
    for (int i = gt; i < SEQ * 8; i += NGT) {
        const int pos = i >> 3, j = i & 7;
        const float invf = powf(500000.0f, -(float)(2 * j) / 16.0f);
        const float ang = (float)pos * invf;
        float sn, cs; sincosf(ang, &sn, &cs);
        rope[pos * 16 + j] = cs; rope[pos * 16 + 8 + j] = sn;
    }
    float* lb = wsp<float>(F, WS_LB);
    for (int i = gt; i < HW; i += NGT) { const float p0 = F.hg_lb[i], p1 = F.hg_lb[HW + i]; lb[i] = 1.0f / (1.0f + __expf(p1 - p0)); }
    if (F.bid == 0 && F.wave == 0) {
        const float a = wave_sum(F.lq1[F.lane] * F.lk1[F.lane]), b = wave_sum(F.lq2[F.lane] * F.lk2[F.lane]);
        if (F.lane == 0) *wsp<float>(F, WS_LAM) = __expf(a) - __expf(b) + LAMBDA_INIT;
    }
}

__device__ __forceinline__ void ph_h1(Frame& F) {
    LAS float* Lsh = (LAS float*)F.lds; LAS float* Lsc = Lsh + DM;
    bf16* H1 = wsp<bf16>(F, WS_H1);
    int curb = -1;
    for (int rb = F.bid; rb < T / 8; rb += F.G) {
        const int batch = rb / (SEQ / 8);
        if (batch != curb) { __syncthreads(); mod_vec(F, Lsh, 0, batch); mod_vec(F, Lsc, 1, batch); __syncthreads(); curb = batch; }
        const int row = rb * 8 + F.wave;
        const float* xr = F.x + (size_t)row * DM;
        f32x4 v[8]; float s = 0.f;
#pragma unroll
        for (int j = 0; j < 8; ++j) { v[j] = *(const f32x4*)(xr + 4 * F.lane + 256 * j); s += (v[j][0] * v[j][0] + v[j][1] * v[j][1]) + (v[j][2] * v[j][2] + v[j][3] * v[j][3]); }
        const float rstd = 1.0f / sqrtf(wave_sum(s) * (1.0f / DM) + EPS);
#pragma unroll
        for (int j = 0; j < 8; ++j) {
            const int c0 = 4 * F.lane + 256 * j;
            const f32x4 w = *(const f32x4*)(F.pre_mix + c0);
            const f32x4 sc = *(const LAS f32x4*)(Lsc + c0), sh = *(const LAS f32x4*)(Lsh + c0);
            const f32x4 h = v[j] * rstd * w * (sc + 1.0f) + sh;
            u32x2 o; o.x = pk2(h[0], h[1]); o.y = pk2(h[2], h[3]);
            *(u32x2*)(H1 + (size_t)row * DM + c0) = o;
        }
    }
}

struct EpiProj { const Frame* F; int m0; __device__ __forceinline__ void operator()(int r, int col0, const float (&v)[8]) const { proj_store8(*F, m0 + r, col0, v, 1); } };
__device__ __forceinline__ void ph_proj_simple(Frame& F) {
    LAS float* As = (LAS float*)F.lds; LAS float* Bs = As + 16 * 132;
    const int NT_ = INC / 128, MT_ = T / 128;
    for (int t = F.bid; t < NT_ * MT_; t += F.G) {
        const int mt = t / NT_, nt = t % NT_;
        RowsDense rows{mt * 128}; EpiProj epi{&F, mt * 128};
        sg_tile(As, Bs, wsp<const bf16>(F, WS_H1), DM, rows, F.w_in, INC, nt * 128, DM, epi);
    }
}

__device__ __forceinline__ void hgrn_chain_simple(Frame& F, int ch) {
    const int b = ch >> 3, h = ch & 7;
    LAS float* Qs = (LAS float*)F.lds;
    LAS float* Fs = Qs + 16 * 128;
    LAS float* Vs = Fs + 16 * 128;
    LAS float* Gs = Vs + 16 * 128;
    LAS float* Po = Gs + 16 * 128;
    LAS float* Red = Po + 2 * 4 * 128;
    const int v = F.tid & 127, kg = F.tid >> 7;
    float S[32];
#pragma unroll
    for (int i = 0; i < 32; ++i) S[i] = 0.f;
    const bf16* QHG = wsp<const bf16>(F, WS_QHG); const float* LOGF = wsp<const float>(F, WS_LOGF);
    const bf16* VHG = wsp<const bf16>(F, WS_VHG); const bf16* GHG = wsp<const bf16>(F, WS_GHG);
    bf16* YHG = wsp<bf16>(F, WS_YHG);
    const float nw = F.hg_nw[h * HD + v];
    const int lt = F.tid >> 5, lc = (F.tid & 31) * 4;
    for (int t0 = 0; t0 < SEQ; t0 += 16) {
        __syncthreads();
        {
            const size_t off = (size_t)(b * SEQ + t0 + lt) * HW + h * HD + lc;
            const u32x2 q = *(const u32x2*)(QHG + off), vv = *(const u32x2*)(VHG + off), g = *(const u32x2*)(GHG + off);
            const f32x4 lf = *(const f32x4*)(LOGF + off);
            LAS float* d = Qs + lt * 128 + lc; d[0] = bf2f(q.x & 0xffffu); d[1] = bf2f(q.x >> 16); d[2] = bf2f(q.y & 0xffffu); d[3] = bf2f(q.y >> 16);
            d = Vs + lt * 128 + lc; d[0] = bf2f(vv.x & 0xffffu); d[1] = bf2f(vv.x >> 16); d[2] = bf2f(vv.y & 0xffffu); d[3] = bf2f(vv.y >> 16);
            d = Gs + lt * 128 + lc; d[0] = bf2f(g.x & 0xffffu); d[1] = bf2f(g.x >> 16); d[2] = bf2f(g.y & 0xffffu); d[3] = bf2f(g.y >> 16);
            d = Fs + lt * 128 + lc; d[0] = __expf(lf[0]); d[1] = __expf(lf[1]); d[2] = __expf(lf[2]); d[3] = __expf(lf[3]);
        }
        __syncthreads();
        for (int tt = 0; tt < 16; ++tt) {
            const int p = tt & 1;
            const float vv = Vs[tt * 128 + v];
            float part = 0.f;
#pragma unroll
            for (int i = 0; i < 32; ++i) {
                const float f = Fs[tt * 128 + kg * 32 + i], q = Qs[tt * 128 + kg * 32 + i];
                S[i] = f * S[i] + (1.0f - f) * vv;
                part += q * S[i];
            }
            Po[(p * 4 + kg) * 128 + v] = part;
            __syncthreads();
            float o = 0.f;
            if (F.tid < 128) {
                o = (Po[(p * 4 + 0) * 128 + v] + Po[(p * 4 + 1) * 128 + v]) + (Po[(p * 4 + 2) * 128 + v] + Po[(p * 4 + 3) * 128 + v]);
                const float sq = wave_sum(o * o);
                if (F.lane == 0) Red[p * 2 + F.wave] = sq;
            }
            __syncthreads();
            if (F.tid < 128) {
                const float tot = Red[p * 2] + Red[p * 2 + 1];
                const float y = o * (1.0f / sqrtf(tot * (1.0f / HD) + EPS)) * nw * Gs[tt * 128 + v];
                YHG[(size_t)(b * SEQ + t0 + tt) * HW + h * HD + v] = (bf16)f2bf(y);
            }
        }
    }
}

__device__ __forceinline__ void attn_unit_simple(Frame& F, int b, int h, int c) {
    LAS float* Q1 = (LAS float*)F.lds; LAS float* Q2 = Q1 + 64 * 65; LAS float* K1 = Q2 + 64 * 65; LAS float* K2 = K1 + 64 * 65;
    LAS float* Vt = K2 + 64 * 65; LAS float* P1 = Vt + 64 * 132; LAS float* P2 = P1 + 64 * 65;
    const bf16* QDA = wsp<const bf16>(F, WS_QDA); const bf16* KDA = wsp<const bf16>(F, WS_KDA); const bf16* VDA = wsp<const bf16>(F, WS_VDA);
    const int r = F.tid >> 3, p = F.tid & 7;
    const int lr = F.tid >> 3, lc = (F.tid & 7) * 16;
    __syncthreads();
    {
        const bf16* src = QDA + (size_t)(b * SEQ + c * 64 + lr) * HW + h * HD + lc;
        const u32x4 a0 = *(const u32x4*)src, a1 = *(const u32x4*)(src + 8);
        LAS float* d = (lc < 64 ? Q1 + lr * 65 + lc : Q2 + lr * 65 + (lc - 64));
        const unsigned w[8] = {a0.x, a0.y, a0.z, a0.w, a1.x, a1.y, a1.z, a1.w};
#pragma unroll
        for (int i = 0; i < 8; ++i) { d[2 * i] = bf2f(w[i] & 0xffffu); d[2 * i + 1] = bf2f(w[i] >> 16); }
    }
    float m1 = -INFINITY, l1 = 0.f, m2 = -INFINITY, l2 = 0.f;
    float O1[16], O2[16];
#pragma unroll
    for (int i = 0; i < 16; ++i) { O1[i] = 0.f; O2[i] = 0.f; }
    for (int kt = 0; kt <= c; ++kt) {
        __syncthreads();
        {
            const size_t ro = (size_t)(b * SEQ + kt * 64 + lr) * HW + h * HD + lc;
            const u32x4 a0 = *(const u32x4*)(KDA + ro), a1 = *(const u32x4*)(KDA + ro + 8);
            const u32x4 b0 = *(const u32x4*)(VDA + ro), b1 = *(const u32x4*)(VDA + ro + 8);
            LAS float* d = (lc < 64 ? K1 + lr * 65 + lc : K2 + lr * 65 + (lc - 64));
            const unsigned w[8] = {a0.x, a0.y, a0.z, a0.w, a1.x, a1.y, a1.z, a1.w};
#pragma unroll
            for (int i = 0; i < 8; ++i) { d[2 * i] = bf2f(w[i] & 0xffffu); d[2 * i + 1] = bf2f(w[i] >> 16); }
            LAS float* dv = Vt + lr * 132 + lc;
            const unsigned wv[8] = {b0.x, b0.y, b0.z, b0.w, b1.x, b1.y, b1.z, b1.w};
#pragma unroll
            for (int i = 0; i < 8; ++i) { dv[2 * i] = bf2f(wv[i] & 0xffffu); dv[2 * i + 1] = bf2f(wv[i] >> 16); }
        }
        __syncthreads();
        float s1[8], s2[8];
#pragma unroll
        for (int j = 0; j < 8; ++j) { s1[j] = 0.f; s2[j] = 0.f; }
        for (int d = 0; d < 64; ++d) {
            const float q1 = Q1[r * 65 + d], q2 = Q2[r * 65 + d];
#pragma unroll
            for (int j = 0; j < 8; ++j) { s1[j] += q1 * K1[(p * 8 + j) * 65 + d]; s2[j] += q2 * K2[(p * 8 + j) * 65 + d]; }
        }
        float mx1 = s1[0], mx2 = s2[0];
#pragma unroll
        for (int j = 1; j < 8; ++j) { mx1 = fmaxf(mx1, s1[j]); mx2 = fmaxf(mx2, s2[j]); }
#pragma unroll
        for (int o = 1; o < 8; o <<= 1) { mx1 = fmaxf(mx1, __shfl_xor(mx1, o)); mx2 = fmaxf(mx2, __shfl_xor(mx2, o)); }
        const float mn1 = fmaxf(m1, mx1), mn2 = fmaxf(m2, mx2);
        const float al1 = exp2f(m1 - mn1), al2 = exp2f(m2 - mn2);
        float rs1 = 0.f, rs2 = 0.f;
#pragma unroll
        for (int j = 0; j < 8; ++j) { const float e1 = exp2f(s1[j] - mn1), e2 = exp2f(s2[j] - mn2); rs1 += e1; rs2 += e2; P1[r * 65 + p * 8 + j] = e1; P2[r * 65 + p * 8 + j] = e2; }
#pragma unroll
        for (int o = 1; o < 8; o <<= 1) { rs1 += __shfl_xor(rs1, o); rs2 += __shfl_xor(rs2, o); }
        l1 = l1 * al1 + rs1; l2 = l2 * al2 + rs2; m1 = mn1; m2 = mn2;
        __syncthreads();
#pragma unroll
        for (int i = 0; i < 16; ++i) { O1[i] *= al1; O2[i] *= al2; }
        for (int k = 0; k < 64; ++k) {
            const float p1 = P1[r * 65 + k], p2 = P2[r * 65 + k];
#pragma unroll
            for (int i4 = 0; i4 < 4; ++i4) {
                const f32x4 vv = *(const LAS f32x4*)&Vt[k * 132 + p * 16 + i4 * 4];
#pragma unroll
                for (int i = 0; i < 4; ++i) { O1[i4 * 4 + i] += p1 * vv[i]; O2[i4 * 4 + i] += p2 * vv[i]; }
            }
        }
    }
    const float i1 = 1.0f / l1, i2 = 1.0f / l2;
    float o1[8], o2[8];
    bf16* Ob1 = wsp<bf16>(F, WS_O1) + (size_t)(b * SEQ + c * 64 + r) * HW + h * HD + p * 16;
    bf16* Ob2 = wsp<bf16>(F, WS_O2) + (size_t)(b * SEQ + c * 64 + r) * HW + h * HD + p * 16;
#pragma unroll
    for (int hh = 0; hh < 2; ++hh) {
#pragma unroll
        for (int i = 0; i < 8; ++i) { o1[i] = O1[hh * 8 + i] * i1; o2[i] = O2[hh * 8 + i] * i2; }
        store8_bf16(Ob1 + hh * 8, o1); store8_bf16(Ob2 + hh * 8, o2);
    }
}

__device__ __forceinline__ void ph_mix_simple(Frame& F) {
    for (int ch = F.bid; ch < NB * NH; ch += F.G) hgrn_chain_simple(F, ch);
    for (int u = F.bid; u < NB * NH * 32; u += F.G) {
        const int c = 31 - (u >> 6), bh = u & 63;
        attn_unit_simple(F, bh >> 3, bh & 7, c);
    }
}

__device__ __forceinline__ void ph_yda(Frame& F) {
    const int gw = F.bid * NWAVES + F.wave, NGW = F.G * NWAVES;
    const float lam = *wsp<const float>(F, WS_LAM);
    const bf16* O1 = wsp<const bf16>(F, WS_O1); const bf16* O2 = wsp<const bf16>(F, WS_O2); bf16* YDA = wsp<bf16>(F, WS_YDA);
    for (int row = gw; row < T; row += NGW) {
        const size_t off = (size_t)row * HW + F.lane * 16;
        const u32x4 a0 = *(const u32x4*)(O1 + off), a1 = *(const u32x4*)(O1 + off + 8), b0 = *(const u32x4*)(O2 + off), b1 = *(const u32x4*)(O2 + off + 8);
        const unsigned wa[8] = {a0.x, a0.y, a0.z, a0.w, a1.x, a1.y, a1.z, a1.w}, wb[8] = {b0.x, b0.y, b0.z, b0.w, b1.x, b1.y, b1.z, b1.w};
        float o[16]; float s = 0.f;
#pragma unroll
        for (int i = 0; i < 8; ++i) {
            o[2 * i] = bf2f(wa[i] & 0xffffu) - lam * bf2f(wb[i] & 0xffffu); o[2 * i + 1] = bf2f(wa[i] >> 16) - lam * bf2f(wb[i] >> 16);
            s += o[2 * i] * o[2 * i] + o[2 * i + 1] * o[2 * i + 1];
        }
        s += __shfl_xor(s, 1); s += __shfl_xor(s, 2); s += __shfl_xor(s, 4);
        const float rs = (1.0f / sqrtf(s * (1.0f / HD) + EPS)) * (1.0f - LAMBDA_INIT);
        float y[8];
#pragma unroll
        for (int hh = 0; hh < 2; ++hh) {
#pragma unroll
            for (int i = 0; i < 8; ++i) y[i] = o[hh * 8 + i] * rs * F.da_nw[F.lane * 16 + hh * 8 + i];
            store8_bf16(YDA + off + hh * 8, y);
        }
    }
}

struct EpiBr1 { const Frame* F; int m0; __device__ __forceinline__ void operator()(int r, int col0, const float (&v)[8]) const {
    const size_t off = (size_t)(m0 + r) * DM + col0; const u32x4 g = *(const u32x4*)(wsp<const bf16>(*F, WS_GATEH) + off);
    float* o = wsp<float>(*F, WS_TMP) + off; const unsigned w[4] = {g.x, g.y, g.z, g.w};
    f32x4 o0, o1;
#pragma unroll
    for (int i = 0; i < 4; ++i) { const float a = v[2 * i] * bf2f(w[i] & 0xffffu), b = v[2 * i + 1] * bf2f(w[i] >> 16); if (i < 2) { o0[2 * i] = a; o0[2 * i + 1] = b; } else { o1[2 * i - 4] = a; o1[2 * i - 3] = b; } }
    *(f32x4*)o = o0; *(f32x4*)(o + 4) = o1; } };
struct EpiBr2 { const Frame* F; int m0; __device__ __forceinline__ void operator()(int r, int col0, const float (&v)[8]) const {
    const size_t off = (size_t)(m0 + r) * DM + col0; const u32x4 g = *(const u32x4*)(wsp<const bf16>(*F, WS_GATED) + off);
    const float* t = wsp<const float>(*F, WS_TMP) + off; const f32x4 t0 = *(const f32x4*)t, t1 = *(const f32x4*)(t + 4); const unsigned w[4] = {g.x, g.y, g.z, g.w};
    float o[8];
#pragma unroll
    for (int i = 0; i < 4; ++i) { o[2 * i] = (i < 2 ? t0[2 * i] : t1[2 * i - 4]) + v[2 * i] * bf2f(w[i] & 0xffffu); o[2 * i + 1] = (i < 2 ? t0[2 * i + 1] : t1[2 * i - 3]) + v[2 * i + 1] * bf2f(w[i] >> 16); }
    store8_bf16(wsp<bf16>(*F, WS_MERGED) + off, o); } };
__device__ __forceinline__ void ph_branch_simple(Frame& F) {
    LAS float* As = (LAS float*)F.lds; LAS float* Bs = As + 16 * 132;
    const int NT_ = DM / 128, MT_ = T / 128;
    for (int t = F.bid; t < NT_ * MT_; t += F.G) {
        const int mt = t / NT_, nt = t % NT_;
        RowsDense rows{mt * 128};
        EpiBr1 e1{&F, mt * 128}; sg_tile(As, Bs, wsp<const bf16>(F, WS_YHG), HW, rows, F.w_bhg, DM, nt * 128, HW, e1);
        EpiBr2 e2{&F, mt * 128}; sg_tile(As, Bs, wsp<const bf16>(F, WS_YDA), HW, rows, F.w_bda, DM, nt * 128, HW, e2);
    }
}
struct EpiU { const Frame* F; int m0; __device__ __forceinline__ void operator()(int r, int col0, const float (&v)[8]) const { store8_bf16(wsp<bf16>(*F, WS_U) + (size_t)(m0 + r) * DM + col0, v); } };
__device__ __forceinline__ void ph_wout_simple(Frame& F) {
    LAS float* As = (LAS float*)F.lds; LAS float* Bs = As + 16 * 132;
    const int NT_ = DM / 128, MT_ = T / 128;
    for (int t = F.bid; t < NT_ * MT_; t += F.G) {
        const int mt = t / NT_, nt = t % NT_;
        RowsDense rows{mt * 128}; EpiU e{&F, mt * 128};
        sg_tile(As, Bs, wsp<const bf16>(F, WS_MERGED), DM, rows, F.w_out, DM, nt * 128, DM, e);
    }
}

__device__ __forceinline__ void ph_post(Frame& F) {
    LAS float* Lgt = (LAS float*)F.lds; LAS float* Lsh = Lgt + DM; LAS float* Lsc = Lsh + DM;
    LAS float* Lh = Lsc + DM + F.wave * DM;
    const bf16* U = wsp<const bf16>(F, WS_U); float* X1 = wsp<float>(F, WS_X1); bf16* H2 = wsp<bf16>(F, WS_H2);
    int* TOKE = wsp<int>(F, WS_TOKE); int* TOKP = wsp<int>(F, WS_TOKP); int* LT = wsp<int>(F, WS_LISTTOK); float* LW = wsp<float>(F, WS_LISTW);
    int curb = -1;
    for (int rb = F.bid; rb < T / 8; rb += F.G) {
        const int batch = rb / (SEQ / 8);
        if (batch != curb) { __syncthreads(); mod_vec(F, Lgt, 2, batch); mod_vec(F, Lsh, 3, batch); mod_vec(F, Lsc, 4, batch); __syncthreads(); curb = batch; }
        const int row = rb * 8 + F.wave;
        f32x4 u[8]; float s = 0.f;
#pragma unroll
        for (int j = 0; j < 8; ++j) {
            const u32x2 w = *(const u32x2*)(U + (size_t)row * DM + 4 * F.lane + 256 * j);
            u[j] = (f32x4){bf2f(w.x & 0xffffu), bf2f(w.x >> 16), bf2f(w.y & 0xffffu), bf2f(w.y >> 16)};
            s += (u[j][0] * u[j][0] + u[j][1] * u[j][1]) + (u[j][2] * u[j][2] + u[j][3] * u[j][3]);
        }
        const float r1 = 1.0f / sqrtf(wave_sum(s) * (1.0f / DM) + EPS);
        float s2 = 0.f;
#pragma unroll
        for (int j = 0; j < 8; ++j) {
            const int c0 = 4 * F.lane + 256 * j;
            const f32x4 xv = *(const f32x4*)(F.x + (size_t)row * DM + c0), w = *(const f32x4*)(F.post_mix + c0), g = *(const LAS f32x4*)(Lgt + c0);
            u[j] = xv + g * (u[j] * r1 * w);
            *(f32x4*)(X1 + (size_t)row * DM + c0) = u[j];
            s2 += (u[j][0] * u[j][0] + u[j][1] * u[j][1]) + (u[j][2] * u[j][2] + u[j][3] * u[j][3]);
        }
        const float r2 = 1.0f / sqrtf(wave_sum(s2) * (1.0f / DM) + EPS);
#pragma unroll
        for (int j = 0; j < 8; ++j) {
            const int c0 = 4 * F.lane + 256 * j;
            const f32x4 w = *(const f32x4*)(F.pre_ffn + c0), sc = *(const LAS f32x4*)(Lsc + c0), sh = *(const LAS f32x4*)(Lsh + c0);
            u[j] = u[j] * r2 * w * (sc + 1.0f) + sh;
            u32x2 o; o.x = pk2(u[j][0], u[j][1]); o.y = pk2(u[j][2], u[j][3]);
            *(u32x2*)(H2 + (size_t)row * DM + c0) = o;
            *(LAS f32x4*)(Lh + c0) = u[j];
        }
        float elog, glog;
        {
            const int j = F.lane & 31, kh = F.lane >> 5;
            const float* wr = F.w_router + (size_t)(kh * 1024) * 32 + j; const LAS float* hp = Lh + kh * 1024;
            float a0 = 0.f, a1 = 0.f;
#pragma unroll 8
            for (int k = 0; k < 1024; k += 2) { a0 += hp[k] * wr[(size_t)k * 32]; a1 += hp[k + 1] * wr[(size_t)(k + 1) * 32]; }
            float a = a0 + a1; a += __shfl_xor(a, 32);
            elog = a + F.b_router[j];
            const int g = F.lane & 3, kp = F.lane >> 2;
            const float* wg = F.w_group + (size_t)(kp * 128) * 4 + g; const LAS float* hq = Lh + kp * 128;
            float c0 = 0.f;
#pragma unroll 8
            for (int k = 0; k < 128; ++k) c0 += hq[k] * wg[(size_t)k * 4];
            c0 += __shfl_xor(c0, 4); c0 += __shfl_xor(c0, 8); c0 += __shfl_xor(c0, 16); c0 += __shfl_xor(c0, 32);
            glog = c0 + F.b_group[g];
        }
        float lg[4];
#pragma unroll
        for (int i = 0; i < 4; ++i) lg[i] = __shfl(glog, i);
        int gi = 0; float gm = lg[0];
#pragma unroll
        for (int i = 1; i < 4; ++i) if (lg[i] > gm) { gm = lg[i]; gi = i; }
        float gden = 0.f;
#pragma unroll
        for (int i = 0; i < 4; ++i) gden += __expf(lg[i] - gm);
        const float gw_ = 1.0f / gden;
        float ev[8];
#pragma unroll
        for (int i = 0; i < 8; ++i) ev[i] = __shfl(elog, gi * 8 + i);
        int i0 = 0; float v0 = ev[0];
#pragma unroll
        for (int i = 1; i < 8; ++i) if (ev[i] > v0) { v0 = ev[i]; i0 = i; }
        int i1 = -1; float v1 = -INFINITY;
#pragma unroll
        for (int i = 0; i < 8; ++i) if (i != i0 && ev[i] > v1) { v1 = ev[i]; i1 = i; }
        const float e1 = __expf(v1 - v0); const float w0 = gw_ / (1.0f + e1), w1 = gw_ * e1 / (1.0f + e1);
        if (F.lane == 0) {
            const int ea = gi * 8 + i0, eb = gi * 8 + i1;
            const int pa = (int)__hip_atomic_fetch_add((unsigned*)(F.ctl + CW_CNT + 16 * ea), 1u, RLX_AGENT);
            const int pb = (int)__hip_atomic_fetch_add((unsigned*)(F.ctl + CW_CNT + 16 * eb), 1u, RLX_AGENT);
            TOKE[row * 2] = ea; TOKE[row * 2 + 1] = eb; TOKP[row * 2] = pa; TOKP[row * 2 + 1] = pb;
            LT[ea * 16384 + pa] = row; LW[ea * 16384 + pa] = w0; LT[eb * 16384 + pb] = row; LW[eb * 16384 + pb] = w1;
        }
    }
}

__device__ __forceinline__ void expert_tables(Frame& F, LAS int* tab, int tile_rows) {
    if (F.tid == 0) {
        int ps = 0, ts = 0;
        for (int e = 0; e < NE; ++e) {
            const int c = (int)__hip_atomic_load((unsigned*)(F.ctl + CW_CNT + 16 * e), RLX_AGENT);
            tab[e] = c; tab[32 + e] = ps; tab[72 + e] = ts;
            ps += (c + 255) / 256 * 256; ts += (c + tile_rows - 1) / tile_rows;
        }
        tab[32 + NE] = ps; tab[72 + NE] = ts;
    }
    __syncthreads();
}

struct EpiG { const Frame* F; int slot0, n; __device__ __forceinline__ void operator()(int r, int col0, const float (&v)[8]) const {
    if (r >= n) return; float* o = wsp<float>(*F, WS_TMPG) + (size_t)(slot0 + r) * DE + col0;
    f32x4 o0, o1;
#pragma unroll
    for (int i = 0; i < 8; ++i) { const float s = v[i] * sigmoidf_(v[i]); if (i < 4) o0[i] = s; else o1[i - 4] = s; }
    *(f32x4*)o = o0; *(f32x4*)(o + 4) = o1; } };
struct EpiUp { const Frame* F; int slot0, n; __device__ __forceinline__ void operator()(int r, int col0, const float (&v)[8]) const {
    if (r >= n) return; const float* t = wsp<const float>(*F, WS_TMPG) + (size_t)(slot0 + r) * DE + col0; const f32x4 t0 = *(const f32x4*)t, t1 = *(const f32x4*)(t + 4);
    float o[8];
#pragma unroll
    for (int i = 0; i < 8; ++i) o[i] = (i < 4 ? t0[i] : t1[i - 4]) * v[i];
    store8_bf16(wsp<bf16>(*F, WS_ACT) + (size_t)(slot0 + r) * DE + col0, o); } };
__device__ __forceinline__ void ph_moe1_simple(Frame& F) {
    LAS float* As = (LAS float*)F.lds; LAS float* Bs = As + 16 * 132; LAS int* tab = (LAS int*)(Bs + 16 * 132);
    expert_tables(F, tab, 128);
    const int NT_ = DE / 128, ntl = tab[72 + NE] * NT_;
    for (int t = F.bid; t < ntl; t += F.G) {
        const int mtg = t / NT_, nt = t % NT_;
        int e = 0;
#pragma unroll 1
        for (int q = 1; q < NE; ++q) if (tab[72 + q] <= mtg) e = q;
        const int mt = mtg - tab[72 + e], n = min(128, tab[e] - mt * 128), slot0 = tab[32 + e] + mt * 128;
        RowsList rows{wsp<const int>(F, WS_LISTTOK) + e * 16384 + mt * 128, n};
        EpiG eg{&F, slot0, n}; sg_tile(As, Bs, wsp<const bf16>(F, WS_H2), DM, rows, F.w_gate + (size_t)e * DM * DE, DE, nt * 128, DM, eg);
        EpiUp eu{&F, slot0, n}; sg_tile(As, Bs, wsp<const bf16>(F, WS_H2), DM, rows, F.w_up + (size_t)e * DM * DE, DE, nt * 128, DM, eu);
    }
}
struct EpiDown { const Frame* F; int slot0, n; const float* lw; __device__ __forceinline__ void operator()(int r, int col0, const float (&v)[8]) const {
    if (r >= n) return; const float w = lw[r]; float o[8];
#pragma unroll
    for (int i = 0; i < 8; ++i) o[i] = v[i] * w;
    store8_bf16(wsp<bf16>(*F, WS_YW) + (size_t)(slot0 + r) * DM + col0, o); } };
__device__ __forceinline__ void ph_moe2_simple(Frame& F) {
    LAS float* As = (LAS float*)F.lds; LAS float* Bs = As + 16 * 132; LAS int* tab = (LAS int*)(Bs + 16 * 132);
    expert_tables(F, tab, 128);
    const int NT_ = DM / 128, ntl = tab[72 + NE] * NT_;
    for (int t = F.bid; t < ntl; t += F.G) {
        const int mtg = t / NT_, nt = t % NT_;
        int e = 0;
#pragma unroll 1
        for (int q = 1; q < NE; ++q) if (tab[72 + q] <= mtg) e = q;
        const int mt = mtg - tab[72 + e], n = min(128, tab[e] - mt * 128), slot0 = tab[32 + e] + mt * 128;
        RowsDense rows{slot0};
        EpiDown ed{&F, slot0, n, wsp<const float>(F, WS_LISTW) + e * 16384 + mt * 128};
        sg_tile(As, Bs, wsp<const bf16>(F, WS_ACT), DE, rows, F.w_down + (size_t)e * DE * DM, DM, nt * 128, DE, ed);
    }
}

__device__ __forceinline__ void ph_final(Frame& F) {
    LAS float* Lgt = (LAS float*)F.lds; LAS int* tab = (LAS int*)(Lgt + DM);
    expert_tables(F, tab, 128);
    const float* X1 = wsp<const float>(F, WS_X1); const bf16* YW = wsp<const bf16>(F, WS_YW);
    const int* TOKE = wsp<const int>(F, WS_TOKE); const int* TOKP = wsp<const int>(F, WS_TOKP);
    int curb = -1;
    for (int rb = F.bid; rb < T / 8; rb += F.G) {
        const int batch = rb / (SEQ / 8);
        if (batch != curb) { __syncthreads(); mod_vec(F, Lgt, 5, batch); __syncthreads(); curb = batch; }
        const int row = rb * 8 + F.wave;
        const int sa = tab[32 + TOKE[row * 2]] + TOKP[row * 2], sb = tab[32 + TOKE[row * 2 + 1]] + TOKP[row * 2 + 1];
        f32x4 y[8]; float s = 0.f;
#pragma unroll
        for (int j = 0; j < 8; ++j) {
            const int c0 = 4 * F.lane + 256 * j;
            const u32x2 a = *(const u32x2*)(YW + (size_t)sa * DM + c0), b = *(const u32x2*)(YW + (size_t)sb * DM + c0);
            y[j] = (f32x4){bf2f(a.x & 0xffffu) + bf2f(b.x & 0xffffu), bf2f(a.x >> 16) + bf2f(b.x >> 16), bf2f(a.y & 0xffffu) + bf2f(b.y & 0xffffu), bf2f(a.y >> 16) + bf2f(b.y >> 16)};
            s += (y[j][0] * y[j][0] + y[j][1] * y[j][1]) + (y[j][2] * y[j][2] + y[j][3] * y[j][3]);
        }
        const float r = 1.0f / sqrtf(wave_sum(s) * (1.0f / DM) + EPS);
#pragma unroll
        for (int j = 0; j < 8; ++j) {
            const int c0 = 4 * F.lane + 256 * j;
            const f32x4 xv = *(const f32x4*)(X1 + (size_t)row * DM + c0), w = *(const f32x4*)(F.post_ffn + c0), g = *(const LAS f32x4*)(Lgt + c0);
            *(f32x4*)(F.out + (size_t)row * DM + c0) = xv + g * (y[j] * r * w);
        }
    }
}

struct Args { const float* in[26]; float* out; unsigned char* ws; int ph_lo, ph_hi; };
__global__ void __launch_bounds__(NTHREADS, 2) mk_fwd(Args args) {
    extern __shared__ __attribute__((aligned(16))) unsigned char lds[];
    Frame F;
    typedef const __attribute__((address_space(4))) Args* CArgs;
    CArgs A = (CArgs)__builtin_amdgcn_kernarg_segment_ptr();
    F.lds = (LAS unsigned char*)lds;
    F.G = gridDim.x; F.bid = blockIdx.x;
#define ENTER() do { asm volatile("" : "+s"(A)); int t_ = threadIdx.x; asm volatile("" : "+v"(t_)); F.tid = t_; F.lane = t_ & 63; F.wave = __builtin_amdgcn_readfirstlane(t_ >> 6); \
    F.ws = A->ws; F.ctl = (gu32*)(F.ws + WS_CTL); F.out = A->out; \
    F.x = A->in[0]; F.c = A->in[1]; F.w_ada = A->in[2]; F.b_ada = A->in[3]; F.pre_mix = A->in[4]; F.post_mix = A->in[5]; F.pre_ffn = A->in[6]; F.post_ffn = A->in[7]; \
    F.w_in = A->in[8]; F.hg_lb = A->in[9]; F.hg_nw = A->in[10]; F.lq1 = A->in[11]; F.lk1 = A->in[12]; F.lq2 = A->in[13]; F.lk2 = A->in[14]; F.da_nw = A->in[15]; \
    F.w_bhg = A->in[16]; F.w_bda = A->in[17]; F.w_out = A->in[18]; F.w_group = A->in[19]; F.b_group = A->in[20]; F.w_router = A->in[21]; F.b_router = A->in[22]; \
    F.w_gate = A->in[23]; F.w_up = A->in[24]; F.w_down = A->in[25]; } while (0)
    ENTER();
    volatile LAS unsigned* MISC = (volatile LAS unsigned*)(F.lds + MISC_OFF);
    for (int u = F.tid; u < (LDS_BYTES - LDSCTL_OFF) / 4; u += NTHREADS) ((LAS unsigned*)(F.lds + LDSCTL_OFF))[u] = 0u;
    __syncthreads();
    const int lo = A->ph_lo, hi = A->ph_hi;
    XcdBarrier bar; bar.bar = (unsigned*)(F.ctl + CW_BAR); bar.x = 0; bar.st = nullptr;
    if (hi - lo > 1) bar = xcd_barrier_post((unsigned*)(F.ctl + CW_BAR), MISC + 8);
#define IN(k) (lo <= (k) && (k) < hi)
#define SEAM(k) do { if (IN(k) && IN((k) + 1)) xcd_barrier(bar); } while (0)
    if (IN(PH_PRO)) { ENTER(); ph_prologue(F); } SEAM(PH_PRO);
    if (IN(PH_H1)) { ENTER(); ph_h1(F); } SEAM(PH_H1);
    if (IN(PH_PROJ)) { ENTER(); ph_proj_simple(F); } SEAM(PH_PROJ);
    if (IN(PH_MIX)) { ENTER(); ph_mix_simple(F); } SEAM(PH_MIX);
    if (IN(PH_YDA)) { ENTER(); ph_yda(F); } SEAM(PH_YDA);
    if (IN(PH_BRANCH)) { ENTER(); ph_branch_simple(F); } SEAM(PH_BRANCH);
    if (IN(PH_WOUT)) { ENTER(); ph_wout_simple(F); } SEAM(PH_WOUT);
    if (IN(PH_POST)) { ENTER(); ph_post(F); } SEAM(PH_POST);
    if (IN(PH_MOE1)) { ENTER(); ph_moe1_simple(F); } SEAM(PH_MOE1);
    if (IN(PH_MOE2)) { ENTER(); ph_moe2_simple(F); } SEAM(PH_MOE2);
    if (IN(PH_FINAL)) { ENTER(); ph_final(F); }
#undef IN
#undef SEAM
}

extern "C" void kernel_launch(void* const* d_in, const int* in_sizes, int n_in, void* d_out, int out_size, void* d_ws, size_t ws_size, hipStream_t stream) {
    static int grid = 0;
    if (grid == 0) {
        if (n_in != 26 || out_size != T * DM || ws_size < WS_END) { fprintf(stderr, "kernel_launch: unexpected shapes (n_in %d out %d ws %zu)\n", n_in, out_size, ws_size); grid = -1; return; }
        int dev = 0, cus = 0, per_cu = 0;
        if (hipGetDevice(&dev) != hipSuccess || hipDeviceGetAttribute(&cus, hipDeviceAttributeMultiprocessorCount, dev) != hipSuccess) { grid = -1; return; }
        if (hipFuncSetAttribute((const void*)mk_fwd, hipFuncAttributeMaxDynamicSharedMemorySize, LDS_BYTES) != hipSuccess) { grid = -1; return; }
        if (hipOccupancyMaxActiveBlocksPerMultiprocessor(&per_cu, (const void*)mk_fwd, NTHREADS, LDS_BYTES) != hipSuccess || per_cu < 1) { fprintf(stderr, "kernel_launch: occupancy query says %d\n", per_cu); }
        (void)hipGetLastError();
        grid = cus;
    }
    if (grid < 0) return;
    (void)hipMemsetAsync((char*)d_ws + WS_CTL, 0, CTL_ZERO_BYTES, stream);
    Args a{};
    for (int i = 0; i < 26; ++i) a.in[i] = (const float*)d_in[i];
    a.out = (float*)d_out; a.ws = (unsigned char*)d_ws;
#if MK_ONE_LAUNCH
    a.ph_lo = 0; a.ph_hi = N_PHASES;
    hipLaunchKernelGGL(mk_fwd, dim3(grid), dim3(NTHREADS), LDS_BYTES, stream, a);
#else
    for (int p = 0; p < N_PHASES; ++p) { a.ph_lo = p; a.ph_hi = p + 1; hipLaunchKernelGGL(mk_fwd, dim3(grid), dim3(NTHREADS), LDS_BYTES, stream, a); }
#endif
}
```

```cpp
#include <hip/hip_runtime.h>
#include <cstdio>
#include <cstdint>

constexpr int DM = 2048, NB = 8, SEQ = 2048, T = NB * SEQ;
constexpr int HW = 1024;
constexpr int NH = 8, HD = 128;
constexpr int INC = 11264;
constexpr int NE = 32, EPG = 8, NG = 4, DE = 1024;
constexpr float EPS = 1e-6f;
constexpr float LAMBDA_INIT = 0.2f;
constexpr float QSCALE = 0.125f * 1.4426950408889634f;
constexpr int SLOT_MAX = 40960;

constexpr int NWAVES = 8, NTHREADS = 512;
enum { PH_PRO = 0, PH_MOD, PH_H1, PH_PROJ, PH_MIX, PH_YDA, PH_BRANCH, PH_WOUT, PH_POST, PH_MOE1, PH_MOE2, PH_FINAL, N_PHASES };
#ifndef EXPERT_T_IN_MIX
#define EXPERT_T_IN_MIX 1
#endif
#ifndef FAST_POST
#define FAST_POST 1
#endif
#ifndef PROJ_FP8
#define PROJ_FP8 1
#endif
#ifndef PROBE_DUP
#define PROBE_DUP -1
#endif
#ifndef FAST_ATTN
#define FAST_ATTN 1
#endif
#ifndef FAST_HGRN
#define FAST_HGRN 1
#endif
#ifndef FAST_GEMM
#define FAST_GEMM 1
#endif
#ifndef MK_ONE_LAUNCH
#define MK_ONE_LAUNCH 1
#endif

constexpr size_t MiB = 1u << 20;
constexpr size_t WS_CTL = 0, CTL_ZERO_BYTES = 1 * MiB;
constexpr size_t WS_MODP = 1 * MiB;
constexpr size_t WS_ROPE = 4 * MiB;
constexpr size_t WS_LB = 4 * MiB + 256 * 1024;
constexpr size_t WS_LAM = WS_LB + 8192;
constexpr size_t WS_TOKE = 5 * MiB;
constexpr size_t WS_TOKP = 5 * MiB + 256 * 1024;
constexpr size_t WS_LISTTOK = 6 * MiB;
constexpr size_t WS_LISTW = 8 * MiB;
constexpr size_t WS_P64 = 460 * MiB;
constexpr size_t WS_MODF = 10 * MiB;
constexpr size_t WS_WCAT = 11 * MiB;
constexpr size_t WS_WIN_T = 16 * MiB, WS_WBH_T = 60 * MiB, WS_WBD_T = 64 * MiB, WS_WOUT_T = 68 * MiB, WS_WGU_T = 76 * MiB, WS_WD_T = 332 * MiB;
constexpr size_t WS_TMPG = 76 * MiB;
constexpr size_t WS_H1 = 460 * MiB, WS_QHG = 524 * MiB, WS_LOGF = 556 * MiB, WS_VHG = 620 * MiB, WS_GHG = 652 * MiB;
constexpr size_t WS_QDA = 684 * MiB, WS_KDA = 716 * MiB, WS_VDA = 748 * MiB, WS_GATEH = 780 * MiB, WS_GATED = 844 * MiB;
constexpr size_t WS_YCAT = 908 * MiB;
constexpr size_t WS_YHG = WS_YCAT, WS_YDA = WS_YCAT + 2048, WS_O1 = 972 * MiB, WS_O2 = 1004 * MiB, WS_END = 1036 * MiB;
constexpr size_t WS_TMP = 460 * MiB;
constexpr size_t WS_MERGED = 588 * MiB;
constexpr size_t WS_U = 652 * MiB;
constexpr size_t WS_X1 = 460 * MiB;
constexpr size_t WS_H2 = 588 * MiB;
constexpr size_t WS_ACT = 716 * MiB;
constexpr size_t WS_YW = 796 * MiB;
constexpr int CW_TMO = 0, CW_CODE = 1, CW_BAR = 4096, CW_CNT = 8192  , CW_ATTQ = 9216, CW_TQ = 9216 + 128;

constexpr int RING_BYTES = 131072 + 8192;
constexpr int LDSCTL_OFF = RING_BYTES, MISC_OFF = LDSCTL_OFF + 320;
constexpr int LDS_BYTES = 147456;
static_assert(MISC_OFF + 128 <= LDS_BYTES, "LDS map");

#define GAS __attribute__((address_space(1)))
#define LAS __attribute__((address_space(3)))
typedef unsigned short bf16;
typedef float f32x4 __attribute__((ext_vector_type(4)));
typedef unsigned u32x4 __attribute__((ext_vector_type(4)));
typedef unsigned u32x2 __attribute__((ext_vector_type(2)));
typedef float f32x2_t __attribute__((ext_vector_type(2)));
typedef GAS unsigned gu32;
#define RLX_AGENT __ATOMIC_RELAXED, __HIP_MEMORY_SCOPE_AGENT

__device__ __forceinline__ float bf2f(unsigned h) { return __uint_as_float(h << 16); }
__device__ __forceinline__ unsigned f2bf(float f) { unsigned u = __float_as_uint(f); return (u + 0x7fffu + ((u >> 16) & 1u)) >> 16; }
__device__ __forceinline__ unsigned pk2(float lo, float hi) { unsigned r; asm("v_cvt_pk_bf16_f32 %0, %1, %2" : "=v"(r) : "v"(lo), "v"(hi)); return r; }
__device__ __forceinline__ float sigmoidf_(float v) { return __builtin_amdgcn_rcpf(1.0f + __builtin_amdgcn_exp2f(-1.4426950408889634f * v)); }
__device__ __forceinline__ float wave_sum(float v) {
#pragma unroll
    for (int o = 1; o < 64; o <<= 1) v += __shfl_xor(v, o);
    return v;
}

#define XB_TMO      128
#define XB_XCNT(j)  (256  + 64 * (j))
#define XB_XSUB(j)  (1280 + 64 * (j))
#define XB_XGEN(j)  (2304 + 64 * (j))
#define XB_TOP      3328
#define XB_TOPGEN   3392
#define XCD_BAR_WORDS 3456
#define XB_SPIN_CAP (1u << 22)
__device__ __forceinline__ unsigned xb_ld(unsigned* p)              { return __hip_atomic_load(p, __ATOMIC_RELAXED, __HIP_MEMORY_SCOPE_AGENT); }
__device__ __forceinline__ unsigned xb_add(unsigned* p, unsigned v) { return __hip_atomic_fetch_add(p, v, __ATOMIC_RELAXED, __HIP_MEMORY_SCOPE_AGENT); }
__device__ __forceinline__ unsigned xb_xcc_id() { return (unsigned)__builtin_amdgcn_s_getreg((3 << 11) | 20) & 0xFu; }
#define XB_SPIN(cond, bar) do { unsigned _sp = 0; while (cond) { __builtin_amdgcn_s_sleep(1); \
    if ((++_sp & 255u) == 0u) { if (xb_ld(&(bar)[XB_TMO])) break; if (_sp > XB_SPIN_CAP) { atomicAdd(&(bar)[XB_TMO], 1u); break; } } } } while (0)
struct XcdBarrier { unsigned* bar; unsigned x; volatile LAS unsigned* st; };
__device__ __forceinline__ XcdBarrier xcd_barrier_post(unsigned* bar, volatile LAS unsigned* st) {
    XcdBarrier b; b.bar = bar; b.x = xb_xcc_id(); b.st = st;
    if (threadIdx.x == 0) (void)xb_add(&bar[XB_XCNT(b.x)], 1u);
    return b;
}
__device__ __forceinline__ void xcd_barrier_complete(unsigned* bar, unsigned x, unsigned& nloc, unsigned& nx) {
    const unsigned G = gridDim.x * gridDim.y * gridDim.z;
    unsigned sum, cnt, mine, sp = 0u;
    for (;;) {
        sum = 0u; cnt = 0u; mine = 0u;
#pragma unroll
        for (unsigned j = 0; j < 16; ++j) { const unsigned c = xb_ld(&bar[XB_XCNT(j)]); sum += c; cnt += (c > 0u) ? 1u : 0u; mine = (j == x) ? c : mine; }
        if (sum == G) break;
        __builtin_amdgcn_s_sleep(1);
        if ((++sp & 255u) == 0u) { if (xb_ld(&bar[XB_TMO])) break; if (sp > XB_SPIN_CAP) { atomicAdd(&bar[XB_TMO], 1u); break; } }
    }
    nloc = mine > 0u ? mine : 1u; nx = cnt > 0u ? cnt : 1u;
}
__device__ __forceinline__ void xcd_barrier(const XcdBarrier& b) {
    asm volatile("s_waitcnt vmcnt(0)" ::: "memory");
    __syncthreads();
    if (threadIdx.x == 0) {
        unsigned* bar = b.bar;
        __builtin_amdgcn_s_waitcnt(0);
        unsigned nloc = b.st[0], nx = b.st[1];
        if (nloc == 0u) { xcd_barrier_complete(bar, b.x, nloc, nx); b.st[0] = nloc; b.st[1] = nx; }
        const unsigned old = xb_add(&bar[XB_XSUB(b.x)], 1u);
        const unsigned gen = old / nloc;
        if (old + 1u == (gen + 1u) * nloc) {
            __builtin_amdgcn_fence(__ATOMIC_RELEASE, "agent");
            asm volatile("s_waitcnt vmcnt(0)" ::: "memory");
            const unsigned og = xb_add(&bar[XB_TOP], 1u);
            const unsigned tg = og / nx;
            if (og + 1u == (tg + 1u) * nx) xb_add(&bar[XB_TOPGEN], 1u);
            else XB_SPIN(xb_ld(&bar[XB_TOPGEN]) == tg, bar);
            __builtin_amdgcn_fence(__ATOMIC_ACQUIRE, "agent");
            xb_add(&bar[XB_XGEN(b.x)], 1u);
            asm volatile("s_waitcnt vmcnt(0)" ::: "memory");
        } else {
            XB_SPIN(xb_ld(&bar[XB_XGEN(b.x)]) == gen, bar);
            __builtin_amdgcn_fence(__ATOMIC_ACQUIRE, "agent");
            asm volatile("s_waitcnt vmcnt(0)" ::: "memory");
        }
    }
    __syncthreads();
}

struct Frame {
    LAS unsigned char* lds;
    gu32* ctl;
    int tid, lane, wave, G, bid;
    unsigned char* ws;
    const float* x; const float* c; const float* w_ada; const float* b_ada;
    const float *pre_mix, *post_mix, *pre_ffn, *post_ffn;
    const float* w_in; const float* hg_lb; const float* hg_nw;
    const float *lq1, *lk1, *lq2, *lk2; const float* da_nw;
    const float *w_bhg, *w_bda, *w_out, *w_group, *b_group, *w_router, *b_router, *w_gate, *w_up, *w_down;
    float* out;
};
template <class Tp> __device__ __forceinline__ Tp* wsp(const Frame& F, size_t off) { return (Tp*)(F.ws + off); }

__device__ __forceinline__ void mod_vec(const Frame& F, LAS float* dst, int chunk, int batch) {
    const float* M = wsp<const float>(F, WS_MODF) + (batch * 6 + chunk) * DM;
    for (int j = F.tid; j < DM; j += NTHREADS) dst[j] = M[j];
}
__device__ __forceinline__ void ph_mod(Frame& F) {
    const int gt = F.bid * NTHREADS + F.tid, NGT = F.G * NTHREADS;
    const float* P = wsp<const float>(F, WS_P64); float* MF = wsp<float>(F, WS_MODF);
    for (int o = gt; o < NB * 6 * DM; o += NGT) {
        const int b = o / (6 * DM), col = o % (6 * DM);
        float s0 = 0.f, s1 = 0.f, s2 = 0.f, s3 = 0.f;
#pragma unroll 4
        for (int kc = 0; kc < 64; kc += 4) {
            s0 += P[(size_t)((kc + 0) * 8 + b) * (6 * DM) + col]; s1 += P[(size_t)((kc + 1) * 8 + b) * (6 * DM) + col];
            s2 += P[(size_t)((kc + 2) * 8 + b) * (6 * DM) + col]; s3 += P[(size_t)((kc + 3) * 8 + b) * (6 * DM) + col];
        }
        MF[o] = F.b_ada[col] + ((s0 + s1) + (s2 + s3));
    }
}

template <class Rows, class Epi>
__device__ __forceinline__ void sg_tile(LAS float* As, LAS float* Bs, const bf16* A, int lda, const Rows& rows, const float* B, int ldb, int n0, int K, const Epi& epi) {
    int tid = threadIdx.x; asm volatile("" : "+v"(tid));
    const int tx = tid & 15, ty = tid >> 4;
    float acc[4][8];
#pragma unroll
    for (int i = 0; i < 4; ++i)
#pragma unroll
        for (int j = 0; j < 8; ++j) acc[i][j] = 0.f;
    const int ar = tid >> 2, akq = tid & 3;
    const int arow = rows(ar);
    const bf16* ap = A + (size_t)(arow < 0 ? 0 : arow) * lda + akq * 4;
    const int bk = tid >> 5, bn = (tid & 31) * 4;
    const float* bp = B + (size_t)bk * ldb + n0 + bn;
    for (int k0 = 0; k0 < K; k0 += 16) {
        u32x2 av = *(const u32x2*)(ap + k0);
        const f32x4 bv = *(const f32x4*)(bp + (size_t)k0 * ldb);
        if (arow < 0) { av.x = 0u; av.y = 0u; }
        __syncthreads();
        As[(akq * 4 + 0) * 132 + ar] = bf2f(av.x & 0xffffu);
        As[(akq * 4 + 1) * 132 + ar] = bf2f(av.x >> 16);
        As[(akq * 4 + 2) * 132 + ar] = bf2f(av.y & 0xffffu);
        As[(akq * 4 + 3) * 132 + ar] = bf2f(av.y >> 16);
        *(LAS f32x4*)&Bs[bk * 132 + bn] = bv;
        __syncthreads();
#pragma unroll 2
        for (int kk = 0; kk < 16; ++kk) {
            const f32x4 a4 = *(const LAS f32x4*)&As[kk * 132 + ty * 4];
            const f32x4 b0 = *(const LAS f32x4*)&Bs[kk * 132 + tx * 8];
            const f32x4 b1 = *(const LAS f32x4*)&Bs[kk * 132 + tx * 8 + 4];
#pragma unroll
            for (int i = 0; i < 4; ++i) {
                acc[i][0] += a4[i] * b0[0]; acc[i][1] += a4[i] * b0[1]; acc[i][2] += a4[i] * b0[2]; acc[i][3] += a4[i] * b0[3];
                acc[i][4] += a4[i] * b1[0]; acc[i][5] += a4[i] * b1[1]; acc[i][6] += a4[i] * b1[2]; acc[i][7] += a4[i] * b1[3];
            }
        }
    }
#pragma unroll
    for (int i = 0; i < 4; ++i) epi(ty * 4 + i, n0 + tx * 8, acc[i]);
}
struct RowsDense { int m0; __device__ __forceinline__ int operator()(int r) const { return m0 + r; } };
struct RowsList { const int* list; int n; __device__ __forceinline__ int operator()(int r) const { return r < n ? list[r] : -1; } };

__device__ __forceinline__ void store8_bf16(bf16* p, const float (&v)[8]) {
    u32x4 w; w.x = pk2(v[0], v[1]); w.y = pk2(v[2], v[3]); w.z = pk2(v[4], v[5]); w.w = pk2(v[6], v[7]);
    *(u32x4*)p = w;
}

__device__ __forceinline__ void proj_store8(const Frame& F, int row, int col0, const float (&vin)[8], int pxor) {
    const int sec = col0 >> 10;
    float v[8];
#pragma unroll
    for (int i = 0; i < 8; ++i) v[i] = vin[i];
    if (sec == 0) {
#pragma unroll
        for (int i = 0; i < 8; ++i) v[i] = v[i] * sigmoidf_(v[i]);
        store8_bf16(wsp<bf16>(F, WS_QHG) + (size_t)row * HW + col0, v);
    } else if (sec == 1) {
        const int j = col0 - 1024; const float* lb = wsp<const float>(F, WS_LB) + j;
        float* o = wsp<float>(F, WS_LOGF) + (size_t)row * HW + j;
        f32x4 o0, o1;
#pragma unroll
        for (int i = 0; i < 8; ++i) { const float l = lb[i]; const float f = l + (1.0f - l) * sigmoidf_(v[i]); const float lf = __logf(f); if (i < 4) o0[i] = lf; else o1[i - 4] = lf; }
        *(f32x4*)o = o0; *(f32x4*)(o + 4) = o1;
    } else if (sec == 2) {
        store8_bf16(wsp<bf16>(F, WS_VHG) + (size_t)row * HW + (col0 - 2048), v);
    } else if (sec == 3) {
#pragma unroll
        for (int i = 0; i < 8; ++i) v[i] = sigmoidf_(v[i]);
        store8_bf16(wsp<bf16>(F, WS_GHG) + (size_t)row * HW + (col0 - 3072), v);
    } else if (sec == 4 || sec == 5) {
        const int d0 = col0 & 63;
        float pv[8];
#pragma unroll
        for (int i = 0; i < 8; ++i) pv[i] = __shfl_xor(v[i], pxor);
        if (d0 < 16) {
            const float* rt = wsp<const float>(F, WS_ROPE) + (size_t)(row & (SEQ - 1)) * 16;
            const f32x4 c0 = *(const f32x4*)rt, c1 = *(const f32x4*)(rt + 4), s0 = *(const f32x4*)(rt + 8), s1 = *(const f32x4*)(rt + 12);
            const float sg = (d0 == 0) ? -1.0f : 1.0f;
#pragma unroll
            for (int i = 0; i < 8; ++i) { const float cs = i < 4 ? c0[i] : c1[i - 4], sn = i < 4 ? s0[i] : s1[i - 4]; v[i] = v[i] * cs + sg * pv[i] * sn; }
        }
        if (sec == 4) {
#pragma unroll
            for (int i = 0; i < 8; ++i) v[i] *= QSCALE;
            store8_bf16(wsp<bf16>(F, WS_QDA) + (size_t)row * HW + (col0 - 4096), v);
        } else store8_bf16(wsp<bf16>(F, WS_KDA) + (size_t)row * HW + (col0 - 5120), v);
    } else if (sec == 6) {
        store8_bf16(wsp<bf16>(F, WS_VDA) + (size_t)row * HW + (col0 - 6144), v);
    } else {
#pragma unroll
        for (int i = 0; i < 8; ++i) v[i] = sigmoidf_(v[i]);
        if (sec < 9) store8_bf16(wsp<bf16>(F, WS_GATEH) + (size_t)row * DM + (col0 - 7168), v);
        else store8_bf16(wsp<bf16>(F, WS_GATED) + (size_t)row * DM + (col0 - 9216), v);
    }
}


constexpr float Y8S = 8.0f, Y8I = 1.0f / 8.0f;
constexpr float W8S = 64.0f, W8I = 1.0f / 64.0f;
__device__ __forceinline__ unsigned pk4_fp8(float a, float b, float c, float d) { const int p = __builtin_amdgcn_cvt_pk_fp8_f32(a, b, 0, false); return (unsigned)__builtin_amdgcn_cvt_pk_fp8_f32(c, d, p, true); }
__device__ __forceinline__ float clamp8(float v) { return __builtin_amdgcn_fmed3f(v, -448.0f, 448.0f); }
namespace fg {
typedef short bf16x8 __attribute__((ext_vector_type(8)));
constexpr int BM = 256, BK = 64, HALF = 128, HTB = HALF * BK * 2, STAGE_BYTES = 8 * HTB, NXCD = 8, WGM = 8;
__device__ __forceinline__ int lds_byte(int r, int c) { const int st = (r >> 4) * 2 + (c >> 5), rr = r & 15, cc = c & 31, ob = rr * 64 + cc * 2; return st * 1024 + (ob ^ (((ob >> 9) & 1) << 5)); }
__device__ __forceinline__ void stage_rc(int b, int& R, int& C) { const int st = b / 1024, sb = b % 1024, swz = sb ^ (((sb >> 9) & 1) << 5); R = (st >> 1) * 16 + swz / 64; C = (st & 1) * 32 + (swz % 64) / 2; }
__device__ __forceinline__ int perm32(int rho) { const int n = rho >> 4, i = rho & 15; return 8 * (i >> 2) + 4 * n + (i & 3); }
struct Unit { int pm, pn, e, nvalid, slot0; };
typedef int i32x8 __attribute__((ext_vector_type(8)));
typedef short s16x16 __attribute__((ext_vector_type(16)));
__device__ __forceinline__ i32x8 cat16(bf16x8 a, bf16x8 b) { const s16x16 v = __builtin_shufflevector(a, b, 0, 1, 2, 3, 4, 5, 6, 7, 8, 9, 10, 11, 12, 13, 14, 15); return __builtin_bit_cast(i32x8, v); }
__device__ __forceinline__ unsigned cvt_pk_bf16(float lo, float hi) { unsigned r; asm volatile("v_cvt_pk_bf16_f32 %0, %1, %2" : "=v"(r) : "v"(lo), "v"(hi)); return r; }

template <bool FP8_ = false> struct DenseOrderT {
    int nM, nN, nwg, G, c; const char* A; const char* Bt; int K;
    __device__ __forceinline__ void init(const void* A_, const void* Bt_, int M, int N, int K_, int G_, int c_) { A = (const char*)A_; Bt = (const char*)Bt_; K = K_; nM = M / BM; nN = N / BM; nwg = nM * nN; G = G_; c = c_; }
    __device__ __forceinline__ bool next(int i, Unit& u) const {
        const long L = (long)i * G + c; if (L >= nwg) return false;
        int wgid = (int)L; { const int q = nwg / NXCD, r = nwg % NXCD, xcd = wgid % NXCD, off = wgid / NXCD; wgid = (xcd < r ? xcd * (q + 1) : r * (q + 1) + (xcd - r) * q) + off; }
        const int nig = WGM * nN, gid = wgid / nig, fm = gid * WGM, gsz = (nM - fm) < WGM ? (nM - fm) : WGM;
        u.pm = fm + ((wgid % nig) % gsz); u.pn = (wgid % nig) / gsz; u.e = 0; u.nvalid = BM; u.slot0 = u.pm * BM; return true;
    }
    static constexpr bool GATHER = FP8_, FP8 = FP8_;
    __device__ __forceinline__ const char* a_ptr(const Unit& u) const { return GATHER ? A : A + (size_t)u.pm * BM * K * 2; }
    __device__ __forceinline__ int a_row(const Unit& u, int r) const { return u.pm * BM + r; }
    __device__ __forceinline__ const char* b_ptr(const Unit& u) const { return Bt + (size_t)u.pn * BM * K * 2; }
};

typedef DenseOrderT<false> DenseOrder;
template <class Epi, class Sched>
__device__ __forceinline__ void gemm_phase(LAS unsigned char* lds, const int K, const Sched& S, const Epi& E) {
    int tid = threadIdx.x; asm volatile("" : "+v"(tid));
    const int wid = __builtin_amdgcn_readfirstlane(tid >> 6), lane = tid & 63, wr = wid >> 2, wc = wid & 3, fr = lane & 15, fq = lane >> 4;
    const int nt = K / BK;
    constexpr bool GA = Sched::GATHER;
    int RA[2]; unsigned voffA[2], voffB[2];
#pragma unroll
    for (int i = 0; i < 2; ++i) { int R, C; stage_rc(tid * 16 + i * 8192, R, C); const int Rb = Epi::PERM ? ((R & ~31) + perm32(R & 31)) : R;
        RA[i] = R; voffA[i] = GA ? (unsigned)C * 2u : (unsigned)(R * K + C) * 2u; voffB[i] = (unsigned)(Rb * K + C) * 2u; }
    const size_t kstep = (size_t)(BK * 2);
    const size_t hstep = (size_t)HALF * K * 2;
    const unsigned ldsw = (unsigned)wid * 1024u;
    const int aoff = lds_byte(wr * 64 + fr, fq * 8), boff = lds_byte(wc * 32 + fr, fq * 8);
    const unsigned rowb = (unsigned)K * 2u;
#define PG8_SA(b, h) (((b) * 2 + (h)) * HTB)
#define PG8_SB(b, h) ((4 + (b) * 2 + (h)) * HTB)
#define PG8_STAGE(bufoff, gbase, voff) do { _Pragma("unroll") for (int _i = 0; _i < 2; ++_i) \
        __builtin_amdgcn_global_load_lds((const unsigned*)((const char*)(gbase) + (voff)[_i]), (LAS unsigned*)(lds + (bufoff) + ldsw + _i * 8192), 16, 0, 0); } while (0)
#define PG8_STAGE_A(bufoff, h, kb) do { if constexpr (GA) { PG8_STAGE(bufoff, cA + (kb), oc[h]); } else { PG8_STAGE(bufoff, cA + (kb) + (h) * hstep, voffA); } } while (0)
#define PG8_LDA(dst, b, h) do { if constexpr (Sched::FP8) { _Pragma("unroll") for (int m = 0; m < 4; ++m) dst##8[m] = cat16(*(const LAS bf16x8*)(lds + PG8_SA(b, h) + aoff + m * 2048), *(const LAS bf16x8*)(lds + PG8_SA(b, h) + aoff + m * 2048 + 1024)); } \
        else { _Pragma("unroll") for (int m = 0; m < 4; ++m) _Pragma("unroll") for (int k = 0; k < 2; ++k) dst[m][k] = *(const LAS bf16x8*)(lds + PG8_SA(b, h) + aoff + m * 2048 + k * 1024); } } while (0)
#define PG8_LDB(dst, b, h) do { if constexpr (Sched::FP8) { _Pragma("unroll") for (int n = 0; n < 2; ++n) dst##8[n] = cat16(*(const LAS bf16x8*)(lds + PG8_SB(b, h) + boff + n * 2048), *(const LAS bf16x8*)(lds + PG8_SB(b, h) + boff + n * 2048 + 1024)); } \
        else { _Pragma("unroll") for (int n = 0; n < 2; ++n) _Pragma("unroll") for (int k = 0; k < 2; ++k) dst[n][k] = *(const LAS bf16x8*)(lds + PG8_SB(b, h) + boff + n * 2048 + k * 1024); } } while (0)
#define PG8_MMA(ai, bj, At, Bt) do { __builtin_amdgcn_s_setprio(1); _Pragma("unroll") for (int m = 0; m < 4; ++m) _Pragma("unroll") for (int n = 0; n < 2; ++n) { \
        if constexpr (Sched::FP8) acc[ai][bj][m][n] = __builtin_amdgcn_mfma_scale_f32_16x16x128_f8f6f4(Bt##8[n], At##8[m], acc[ai][bj][m][n], 0, 0, 0, 0, 0, 0); \
        else { _Pragma("unroll") for (int k = 0; k < 2; ++k) acc[ai][bj][m][n] = __builtin_amdgcn_mfma_f32_16x16x32_bf16(Bt[n][k], At[m][k], acc[ai][bj][m][n], 0, 0, 0); } } \
        __builtin_amdgcn_s_setprio(0); } while (0)
#define PG8_WAIT_V(n) asm volatile("s_waitcnt vmcnt(" #n ")" ::: "memory")
#define PG8_WAIT_L(n) asm volatile("s_waitcnt lgkmcnt(" #n ")" ::: "memory")
#define PG8_BAR __builtin_amdgcn_s_barrier()
#define PG8_SCHED __builtin_amdgcn_sched_barrier(0)
#define PG8_AOFFS(dst, u) do { _Pragma("unroll") for (int _h = 0; _h < 2; ++_h) _Pragma("unroll") for (int _i = 0; _i < 2; ++_i) dst[_h][_i] = (unsigned)S.a_row(u, _h * HALF + RA[_i]) * rowb + voffA[_i]; } while (0)
    Unit cur, nxt; int ui = 0;
    if (!S.next(0, cur)) return;
    f32x4 acc[2][2][4][2];
#pragma unroll
    for (int a = 0; a < 2; ++a)
#pragma unroll
        for (int b = 0; b < 2; ++b)
#pragma unroll
            for (int m = 0; m < 4; ++m)
#pragma unroll
                for (int n = 0; n < 2; ++n) acc[a][b][m][n] = (f32x4){0.f, 0.f, 0.f, 0.f};
    bf16x8 At[4][2], B0[2][2], B1[2][2];
    i32x8 At8[4], B08[2], B18[2];
    unsigned oc[2][2] = {{0u, 0u}, {0u, 0u}}, on[2][2] = {{0u, 0u}, {0u, 0u}};
    const char* cA = S.a_ptr(cur); const char* cB = S.b_ptr(cur);
    if constexpr (GA) PG8_AOFFS(oc, cur);
    PG8_STAGE(PG8_SB(0, 0), cB, voffB); PG8_STAGE(PG8_SB(0, 1), cB + hstep, voffB); PG8_STAGE_A(PG8_SA(0, 0), 0, 0); PG8_STAGE_A(PG8_SA(0, 1), 1, 0);
    if (wr == 1) PG8_BAR;
    PG8_WAIT_V(2); PG8_BAR;
    PG8_STAGE(PG8_SB(1, 0), cB + kstep, voffB); PG8_STAGE_A(PG8_SA(1, 0), 0, kstep); PG8_STAGE(PG8_SB(1, 1), cB + hstep + kstep, voffB);
    PG8_WAIT_V(6); PG8_BAR;
    for (;;) {
        const bool has_next = S.next(ui + 1, nxt);
        const char* nA = cA; const char* nB = cB;
        if (has_next) { nA = S.a_ptr(nxt); nB = S.b_ptr(nxt); if constexpr (GA) PG8_AOFFS(on, nxt); }
        else if constexpr (GA) {
#pragma unroll
            for (int _h = 0; _h < 2; ++_h)
#pragma unroll
                for (int _i = 0; _i < 2; ++_i) on[_h][_i] = oc[_h][_i];
        }
#pragma unroll 1
        for (int t = 0; t < nt; t += 2) {
            const bool last = (t == nt - 2);
            if constexpr (Epi::MID) { if (t == (nt >> 1)) E.mid(acc, cur, wr, wc, fr, fq); }
            PG8_LDB(B0, 0, 0); PG8_LDB(B1, 0, 1); PG8_SCHED; PG8_LDA(At, 0, 0); PG8_STAGE_A(PG8_SA(1, 1), 1, (size_t)(t + 1) * kstep);
            if (last) {
                cA = nA; cB = nB;
                if constexpr (GA) {
#pragma unroll
                    for (int _h = 0; _h < 2; ++_h)
#pragma unroll
                        for (int _i = 0; _i < 2; ++_i) oc[_h][_i] = on[_h][_i];
                }
            }
            const size_t k2 = last ? (size_t)0 : (size_t)(t + 2) * kstep, k3 = k2 + kstep;
            PG8_WAIT_V(8); PG8_WAIT_L(0); PG8_BAR; PG8_MMA(0, 0, At, B0); PG8_MMA(0, 1, At, B1); PG8_BAR; PG8_SCHED;
            PG8_LDA(At, 0, 1); PG8_STAGE(PG8_SB(0, 0), cB + k2, voffB); PG8_STAGE(PG8_SB(0, 1), cB + k2 + hstep, voffB); PG8_STAGE_A(PG8_SA(0, 0), 0, k2);
            PG8_WAIT_V(8); PG8_WAIT_L(0); PG8_BAR; PG8_MMA(1, 0, At, B0); PG8_MMA(1, 1, At, B1); PG8_BAR; PG8_SCHED;
            PG8_LDB(B0, 1, 0); PG8_LDB(B1, 1, 1); PG8_SCHED; PG8_LDA(At, 1, 0); PG8_STAGE_A(PG8_SA(0, 1), 1, k2);
            PG8_WAIT_V(8); PG8_WAIT_L(0); PG8_BAR; PG8_MMA(0, 0, At, B0); PG8_MMA(0, 1, At, B1); PG8_BAR; PG8_SCHED;
            PG8_LDA(At, 1, 1); PG8_STAGE(PG8_SB(1, 0), cB + k3, voffB); PG8_STAGE(PG8_SB(1, 1), cB + k3 + hstep, voffB); PG8_STAGE_A(PG8_SA(1, 0), 0, k3);
            PG8_WAIT_V(8); PG8_WAIT_L(0); PG8_BAR; PG8_MMA(1, 0, At, B0); PG8_MMA(1, 1, At, B1); PG8_BAR; PG8_SCHED;
        }
        if (wr == 0) PG8_BAR;
        E(acc, cur, wr, wc, fr, fq);
        if (!has_next) break;
#pragma unroll
        for (int a = 0; a < 2; ++a)
#pragma unroll
            for (int b = 0; b < 2; ++b)
#pragma unroll
                for (int m = 0; m < 4; ++m)
#pragma unroll
                    for (int n = 0; n < 2; ++n) acc[a][b][m][n] = (f32x4){0.f, 0.f, 0.f, 0.f};
        cur = nxt; ++ui;
        if (wr == 1) PG8_BAR;
    }
    PG8_WAIT_V(0);
    PG8_BAR;
#undef PG8_SA
#undef PG8_SB
#undef PG8_STAGE
#undef PG8_STAGE_A
#undef PG8_LDA
#undef PG8_LDB
#undef PG8_MMA
#undef PG8_WAIT_V
#undef PG8_WAIT_L
#undef PG8_BAR
#undef PG8_SCHED
#undef PG8_AOFFS
}
}

template <bool F8 = false>
__device__ __forceinline__ void transpose_item(const float* W, int K, int N, bf16* WT, int k0, int n0, int drow, LAS float* scr, int lane, int ldt = 0, int kd0 = 0) {
    if (ldt == 0) ldt = K;
    float tv[32];
#pragma unroll
    for (int i = 0; i < 32; ++i) tv[i] = W[(size_t)(k0 + 2 * i + (lane >> 5)) * N + n0 + (lane & 31)];
#pragma unroll
    for (int i = 0; i < 32; ++i) scr[(2 * i + (lane >> 5)) * 33 + (lane & 31)] = tv[i];
    asm volatile("s_waitcnt lgkmcnt(0)" ::: "memory");
    const int c = lane & 7;
#pragma unroll
    for (int j = 0; j < 4; ++j) { const int n = (lane >> 3) + 8 * j; const LAS float* sp = scr + (8 * c) * 33 + n;
        if constexpr (F8) { u32x2 o; o.x = pk4_fp8(sp[0 * 33] * W8S, sp[1 * 33] * W8S, sp[2 * 33] * W8S, sp[3 * 33] * W8S); o.y = pk4_fp8(sp[4 * 33] * W8S, sp[5 * 33] * W8S, sp[6 * 33] * W8S, sp[7 * 33] * W8S);
            *(u32x2*)((unsigned char*)WT + (size_t)(drow + n) * ldt + kd0 + k0 + 8 * c) = o; }
        else { u32x4 o; o.x = pk2(sp[0 * 33], sp[1 * 33]); o.y = pk2(sp[2 * 33], sp[3 * 33]); o.z = pk2(sp[4 * 33], sp[5 * 33]); o.w = pk2(sp[6 * 33], sp[7 * 33]);
            *(u32x4*)(WT + (size_t)(drow + n) * ldt + kd0 + k0 + 8 * c) = o; } }
    asm volatile("s_waitcnt lgkmcnt(0)" ::: "memory");
}

__device__ __forceinline__ void transpose_item2(const float* W, int K, int N, bf16* WT, int k0, int n0a, int drowa, int n0b, int drowb, LAS float* scr, int lane) {
    float ta[32], tb[32];
#pragma unroll
    for (int i = 0; i < 32; ++i) ta[i] = W[(size_t)(k0 + 2 * i + (lane >> 5)) * N + n0a + (lane & 31)];
#pragma unroll
    for (int i = 0; i < 32; ++i) tb[i] = W[(size_t)(k0 + 2 * i + (lane >> 5)) * N + n0b + (lane & 31)];
    const int c = lane & 7;
#pragma unroll
    for (int i = 0; i < 32; ++i) scr[(2 * i + (lane >> 5)) * 33 + (lane & 31)] = ta[i];
    asm volatile("s_waitcnt lgkmcnt(0)" ::: "memory");
#pragma unroll
    for (int j = 0; j < 4; ++j) { const int n = (lane >> 3) + 8 * j; const LAS float* sp = scr + (8 * c) * 33 + n;
        u32x4 o; o.x = pk2(sp[0 * 33], sp[1 * 33]); o.y = pk2(sp[2 * 33], sp[3 * 33]); o.z = pk2(sp[4 * 33], sp[5 * 33]); o.w = pk2(sp[6 * 33], sp[7 * 33]);
        *(u32x4*)(WT + (size_t)(drowa + n) * K + k0 + 8 * c) = o; }
    asm volatile("s_waitcnt lgkmcnt(0)" ::: "memory");
#pragma unroll
    for (int i = 0; i < 32; ++i) scr[(2 * i + (lane >> 5)) * 33 + (lane & 31)] = tb[i];
    asm volatile("s_waitcnt lgkmcnt(0)" ::: "memory");
#pragma unroll
    for (int j = 0; j < 4; ++j) { const int n = (lane >> 3) + 8 * j; const LAS float* sp = scr + (8 * c) * 33 + n;
        u32x4 o; o.x = pk2(sp[0 * 33], sp[1 * 33]); o.y = pk2(sp[2 * 33], sp[3 * 33]); o.z = pk2(sp[4 * 33], sp[5 * 33]); o.w = pk2(sp[6 * 33], sp[7 * 33]);
        *(u32x4*)(WT + (size_t)(drowb + n) * K + k0 + 8 * c) = o; }
    asm volatile("s_waitcnt lgkmcnt(0)" ::: "memory");
}

__device__ __forceinline__ void ph_prologue(Frame& F) {
    const int gw = F.bid * NWAVES + F.wave, NGW = F.G * NWAVES;
    LAS float* SC = (LAS float*)(F.lds + 8 * 8704);
    for (int i = F.tid; i < NB * DM; i += NTHREADS) { const float cv = F.c[i]; SC[i] = cv * sigmoidf_(cv); }
    __syncthreads();
    float* P = wsp<float>(F, WS_P64);
    for (int it = gw; it < 48 * 64; it += NGW) {
        const int cb = it % 48, kc = it / 48;
        f32x4 acc[8];
#pragma unroll
        for (int b = 0; b < 8; ++b) acc[b] = (f32x4){0.f, 0.f, 0.f, 0.f};
        const float* wp = F.w_ada + (size_t)(kc * 32) * (6 * DM) + cb * 256 + F.lane * 4;
        const LAS float* cp = SC + kc * 32;
#pragma unroll 1
        for (int k0 = 0; k0 < 32; k0 += 8) {
            f32x4 w[8];
#pragma unroll
            for (int k = 0; k < 8; ++k) w[k] = *(const f32x4*)(wp + (size_t)(k0 + k) * (6 * DM));
#pragma unroll
            for (int k = 0; k < 8; ++k)
#pragma unroll
                for (int b = 0; b < 8; ++b) acc[b] += w[k] * cp[b * DM + k0 + k];
        }
#pragma unroll
        for (int b = 0; b < 8; ++b) *(f32x4*)(P + (size_t)(kc * 8 + b) * (6 * DM) + cb * 256 + F.lane * 4) = acc[b];
    }
    const int gt = F.bid * NTHREADS + F.tid, NGT = F.G * NTHREADS;
    float* rope = wsp<float>(F, WS_ROPE);
    for (int i = gt; i < SEQ * 8; i += NGT) {
        const int pos = i >> 3, j = i & 7;
        const float invf = powf(500000.0f, -(float)(2 * j) / 16.0f);
        const float ang = (float)pos * invf;
        float sn, cs; sincosf(ang, &sn, &cs);
        rope[pos * 16 + j] = cs; rope[pos * 16 + 8 + j] = sn;
    }
    bf16* wch = wsp<bf16>(F, WS_WCAT); bf16* wcl = wch + 48 * DM;
    for (int i = gt; i < DM * 48; i += NGT) { const int c = i / DM, k = i % DM; const float v = c < 4 ? F.w_group[k * 4 + c] : (c < 36 ? F.w_router[k * 32 + c - 4] : 0.f);
        const unsigned hi = f2bf(v); wch[i] = (bf16)hi; wcl[i] = (bf16)f2bf(v - bf2f(hi)); }
    float* lb = wsp<float>(F, WS_LB);
    for (int i = gt; i < HW; i += NGT) { const float p0 = F.hg_lb[i], p1 = F.hg_lb[HW + i]; lb[i] = 1.0f / (1.0f + __expf(p1 - p0)); }
    if (F.bid == 0 && F.wave == 0) {
        const float a = wave_sum(F.lq1[F.lane] * F.lk1[F.lane]), b = wave_sum(F.lq2[F.lane] * F.lk2[F.lane]);
        if (F.lane == 0) *wsp<float>(F, WS_LAM) = __expf(a) - __expf(b) + LAMBDA_INIT;
    }
}

__device__ __forceinline__ void ph_h1(Frame& F) {
    LAS float* Lsh = (LAS float*)F.lds; LAS float* Lsc = Lsh + DM;
    bf16* H1 = wsp<bf16>(F, WS_H1);
    for (int rb = F.bid; rb < T / 64; rb += F.G) {
        const int batch = (rb * 64) / SEQ;
        __syncthreads(); mod_vec(F, Lsh, 0, batch); mod_vec(F, Lsc, 1, batch); __syncthreads();
#pragma unroll 1
        for (int half = 0; half < 2; ++half) {
            const int row0 = rb * 64 + F.wave * 8 + half * 4;
            f32x4 v[4][8];
#pragma unroll
            for (int r = 0; r < 4; ++r)
#pragma unroll
                for (int j = 0; j < 8; ++j) v[r][j] = *(const f32x4*)(F.x + (size_t)(row0 + r) * DM + 4 * F.lane + 256 * j);
            f32x4 wv[8];
#pragma unroll
            for (int j = 0; j < 8; ++j) wv[j] = *(const f32x4*)(F.pre_mix + 4 * F.lane + 256 * j);
#pragma unroll
            for (int r = 0; r < 4; ++r) {
                float s = 0.f;
#pragma unroll
                for (int j = 0; j < 8; ++j) s += (v[r][j][0] * v[r][j][0] + v[r][j][1] * v[r][j][1]) + (v[r][j][2] * v[r][j][2] + v[r][j][3] * v[r][j][3]);
                const float rstd = 1.0f / sqrtf(wave_sum(s) * (1.0f / DM) + EPS);
#pragma unroll
                for (int j = 0; j < 8; ++j) {
                    const int c0 = 4 * F.lane + 256 * j;
                    const f32x4 w = wv[j];
                    const f32x4 sc = *(const LAS f32x4*)(Lsc + c0), sh = *(const LAS f32x4*)(Lsh + c0);
                    const f32x4 h = v[r][j] * rstd * w * (sc + 1.0f) + sh;
#if PROJ_FP8
                    *(unsigned*)((unsigned char*)H1 + (size_t)(row0 + r) * DM + c0) = pk4_fp8(clamp8(h[0]), clamp8(h[1]), clamp8(h[2]), clamp8(h[3]));
#else
                    u32x2 o; o.x = pk2(h[0], h[1]); o.y = pk2(h[2], h[3]);
                    *(u32x2*)(H1 + (size_t)(row0 + r) * DM + c0) = o;
#endif
                }
            }
        }
    }
}

struct EpiProj { const Frame* F; int m0; __device__ __forceinline__ void operator()(int r, int col0, const float (&v)[8]) const { proj_store8(*F, m0 + r, col0, v, 1); } };
__device__ __forceinline__ void ph_proj_simple(Frame& F) {
    LAS float* As = (LAS float*)F.lds; LAS float* Bs = As + 16 * 132;
    const int NT_ = INC / 128, MT_ = T / 128;
    for (int t = F.bid; t < NT_ * MT_; t += F.G) {
        const int mt = t / NT_, nt = t % NT_;
        RowsDense rows{mt * 128}; EpiProj epi{&F, mt * 128};
        sg_tile(As, Bs, wsp<const bf16>(F, WS_H1), DM, rows, F.w_in, INC, nt * 128, DM, epi);
    }
}

__device__ __forceinline__ void hgrn_chain_simple(Frame& F, int ch) {
    const int b = ch >> 3, h = ch & 7;
    LAS float* Qs = (LAS float*)F.lds;
    LAS float* Fs = Qs + 16 * 128;
    LAS float* Vs = Fs + 16 * 128;
    LAS float* Gs = Vs + 16 * 128;
    LAS float* Po = Gs + 16 * 128;
    LAS float* Red = Po + 2 * 4 * 128;
    const int v = F.tid & 127, kg = F.tid >> 7;
    float S[32];
#pragma unroll
    for (int i = 0; i < 32; ++i) S[i] = 0.f;
    const bf16* QHG = wsp<const bf16>(F, WS_QHG); const float* LOGF = wsp<const float>(F, WS_LOGF);
    const bf16* VHG = wsp<const bf16>(F, WS_VHG); const bf16* GHG = wsp<const bf16>(F, WS_GHG);
    bf16* YHG = wsp<bf16>(F, WS_YHG);
    const float nw = F.hg_nw[h * HD + v];
    const int lt = F.tid >> 5, lc = (F.tid & 31) * 4;
    for (int t0 = 0; t0 < SEQ; t0 += 16) {
        __syncthreads();
        {
            const size_t off = (size_t)(b * SEQ + t0 + lt) * HW + h * HD + lc;
            const u32x2 q = *(const u32x2*)(QHG + off), vv = *(const u32x2*)(VHG + off), g = *(const u32x2*)(GHG + off);
            const f32x4 lf = *(const f32x4*)(LOGF + off);
            LAS float* d = Qs + lt * 128 + lc; d[0] = bf2f(q.x & 0xffffu); d[1] = bf2f(q.x >> 16); d[2] = bf2f(q.y & 0xffffu); d[3] = bf2f(q.y >> 16);
            d = Vs + lt * 128 + lc; d[0] = bf2f(vv.x & 0xffffu); d[1] = bf2f(vv.x >> 16); d[2] = bf2f(vv.y & 0xffffu); d[3] = bf2f(vv.y >> 16);
            d = Gs + lt * 128 + lc; d[0] = bf2f(g.x & 0xffffu); d[1] = bf2f(g.x >> 16); d[2] = bf2f(g.y & 0xffffu); d[3] = bf2f(g.y >> 16);
            d = Fs + lt * 128 + lc; d[0] = __expf(lf[0]); d[1] = __expf(lf[1]); d[2] = __expf(lf[2]); d[3] = __expf(lf[3]);
        }
        __syncthreads();
        for (int tt = 0; tt < 16; ++tt) {
            const int p = tt & 1;
            const float vv = Vs[tt * 128 + v];
            float part = 0.f;
#pragma unroll
            for (int i = 0; i < 32; ++i) {
                const float f = Fs[tt * 128 + kg * 32 + i], q = Qs[tt * 128 + kg * 32 + i];
                S[i] = f * S[i] + (1.0f - f) * vv;
                part += q * S[i];
            }
            Po[(p * 4 + kg) * 128 + v] = part;
            __syncthreads();
            float o = 0.f;
            if (F.tid < 128) {
                o = (Po[(p * 4 + 0) * 128 + v] + Po[(p * 4 + 1) * 128 + v]) + (Po[(p * 4 + 2) * 128 + v] + Po[(p * 4 + 3) * 128 + v]);
                const float sq = wave_sum(o * o);
                if (F.lane == 0) Red[p * 2 + F.wave] = sq;
            }
            __syncthreads();
            if (F.tid < 128) {
                const float tot = Red[p * 2] + Red[p * 2 + 1];
                const float y = o * (1.0f / sqrtf(tot * (1.0f / HD) + EPS)) * nw * Gs[tt * 128 + v];
                YHG[(size_t)(b * SEQ + t0 + tt) * DM + h * HD + v] = (bf16)f2bf(y);
            }
        }
    }
}

__device__ __forceinline__ void attn_unit_simple(Frame& F, int b, int h, int c) {
    LAS float* Q1 = (LAS float*)F.lds; LAS float* Q2 = Q1 + 64 * 65; LAS float* K1 = Q2 + 64 * 65; LAS float* K2 = K1 + 64 * 65;
    LAS float* Vt = K2 + 64 * 65; LAS float* P1 = Vt + 64 * 132; LAS float* P2 = P1 + 64 * 65;
    const bf16* QDA = wsp<const bf16>(F, WS_QDA); const bf16* KDA = wsp<const bf16>(F, WS_KDA); const bf16* VDA = wsp<const bf16>(F, WS_VDA);
    const int r = F.tid >> 3, p = F.tid & 7;
    const int lr = F.tid >> 3, lc = (F.tid & 7) * 16;
    __syncthreads();
    {
        const bf16* src = QDA + (size_t)(b * SEQ + c * 64 + lr) * HW + h * HD + lc;
        const u32x4 a0 = *(const u32x4*)src, a1 = *(const u32x4*)(src + 8);
        LAS float* d = (lc < 64 ? Q1 + lr * 65 + lc : Q2 + lr * 65 + (lc - 64));
        const unsigned w[8] = {a0.x, a0.y, a0.z, a0.w, a1.x, a1.y, a1.z, a1.w};
#pragma unroll
        for (int i = 0; i < 8; ++i) { d[2 * i] = bf2f(w[i] & 0xffffu); d[2 * i + 1] = bf2f(w[i] >> 16); }
    }
    float m1 = -INFINITY, l1 = 0.f, m2 = -INFINITY, l2 = 0.f;
    float O1[16], O2[16];
#pragma unroll
    for (int i = 0; i < 16; ++i) { O1[i] = 0.f; O2[i] = 0.f; }
    for (int kt = 0; kt <= c; ++kt) {
        __syncthreads();
        {
            const size_t ro = (size_t)(b * SEQ + kt * 64 + lr) * HW + h * HD + lc;
            const u32x4 a0 = *(const u32x4*)(KDA + ro), a1 = *(const u32x4*)(KDA + ro + 8);
            const u32x4 b0 = *(const u32x4*)(VDA + ro), b1 = *(const u32x4*)(VDA + ro + 8);
            LAS float* d = (lc < 64 ? K1 + lr * 65 + lc : K2 + lr * 65 + (lc - 64));
            const unsigned w[8] = {a0.x, a0.y, a0.z, a0.w, a1.x, a1.y, a1.z, a1.w};
#pragma unroll
            for (int i = 0; i < 8; ++i) { d[2 * i] = bf2f(w[i] & 0xffffu); d[2 * i + 1] = bf2f(w[i] >> 16); }
            LAS float* dv = Vt + lr * 132 + lc;
            const unsigned wv[8] = {b0.x, b0.y, b0.z, b0.w, b1.x, b1.y, b1.z, b1.w};
#pragma unroll
            for (int i = 0; i < 8; ++i) { dv[2 * i] = bf2f(wv[i] & 0xffffu); dv[2 * i + 1] = bf2f(wv[i] >> 16); }
        }
        __syncthreads();
        float s1[8], s2[8];
#pragma unroll
        for (int j = 0; j < 8; ++j) { s1[j] = 0.f; s2[j] = 0.f; }
        for (int d = 0; d < 64; ++d) {
            const float q1 = Q1[r * 65 + d], q2 = Q2[r * 65 + d];
#pragma unroll
            for (int j = 0; j < 8; ++j) { s1[j] += q1 * K1[(p * 8 + j) * 65 + d]; s2[j] += q2 * K2[(p * 8 + j) * 65 + d]; }
        }
        float mx1 = s1[0], mx2 = s2[0];
#pragma unroll
        for (int j = 1; j < 8; ++j) { mx1 = fmaxf(mx1, s1[j]); mx2 = fmaxf(mx2, s2[j]); }
#pragma unroll
        for (int o = 1; o < 8; o <<= 1) { mx1 = fmaxf(mx1, __shfl_xor(mx1, o)); mx2 = fmaxf(mx2, __shfl_xor(mx2, o)); }
        const float mn1 = fmaxf(m1, mx1), mn2 = fmaxf(m2, mx2);
        const float al1 = exp2f(m1 - mn1), al2 = exp2f(m2 - mn2);
        float rs1 = 0.f, rs2 = 0.f;
#pragma unroll
        for (int j = 0; j < 8; ++j) { const float e1 = exp2f(s1[j] - mn1), e2 = exp2f(s2[j] - mn2); rs1 += e1; rs2 += e2; P1[r * 65 + p * 8 + j] = e1; P2[r * 65 + p * 8 + j] = e2; }
#pragma unroll
        for (int o = 1; o < 8; o <<= 1) { rs1 += __shfl_xor(rs1, o); rs2 += __shfl_xor(rs2, o); }
        l1 = l1 * al1 + rs1; l2 = l2 * al2 + rs2; m1 = mn1; m2 = mn2;
        __syncthreads();
#pragma unroll
        for (int i = 0; i < 16; ++i) { O1[i] *= al1; O2[i] *= al2; }
        for (int k = 0; k < 64; ++k) {
            const float p1 = P1[r * 65 + k], p2 = P2[r * 65 + k];
#pragma unroll
            for (int i4 = 0; i4 < 4; ++i4) {
                const f32x4 vv = *(const LAS f32x4*)&Vt[k * 132 + p * 16 + i4 * 4];
#pragma unroll
                for (int i = 0; i < 4; ++i) { O1[i4 * 4 + i] += p1 * vv[i]; O2[i4 * 4 + i] += p2 * vv[i]; }
            }
        }
    }
    const float i1 = 1.0f / l1, i2 = 1.0f / l2;
    float o1[8], o2[8];
    bf16* Ob1 = wsp<bf16>(F, WS_O1) + (size_t)(b * SEQ + c * 64 + r) * HW + h * HD + p * 16;
    bf16* Ob2 = wsp<bf16>(F, WS_O2) + (size_t)(b * SEQ + c * 64 + r) * HW + h * HD + p * 16;
#pragma unroll
    for (int hh = 0; hh < 2; ++hh) {
#pragma unroll
        for (int i = 0; i < 8; ++i) { o1[i] = O1[hh * 8 + i] * i1; o2[i] = O2[hh * 8 + i] * i2; }
        store8_bf16(Ob1 + hh * 8, o1); store8_bf16(Ob2 + hh * 8, o2);
    }
}

__device__ __forceinline__ void hgrn_chain_fast(Frame& F, int ch);
__device__ __forceinline__ void ph_mix_simple(Frame& F) {
#if FAST_HGRN
    for (int ch = F.bid; ch < NB * NH; ch += F.G) hgrn_chain_fast(F, ch);
#else
    for (int ch = F.bid; ch < NB * NH; ch += F.G) hgrn_chain_simple(F, ch);
#endif
    for (int u = F.bid; u < NB * NH * 32; u += F.G) {
        const int c = 31 - (u >> 6), bh = u & 63;
        attn_unit_simple(F, bh >> 3, bh & 7, c);
    }
}

__device__ __forceinline__ void ph_yda(Frame& F) {
    const int gw = F.bid * NWAVES + F.wave, NGW = F.G * NWAVES;
    const float lam = *wsp<const float>(F, WS_LAM);
    const bf16* O1 = wsp<const bf16>(F, WS_O1); const bf16* O2 = wsp<const bf16>(F, WS_O2); bf16* YDA = wsp<bf16>(F, WS_YDA);
    for (int row = gw; row < T; row += NGW) {
        const size_t off = (size_t)row * HW + F.lane * 16;
        const u32x4 a0 = *(const u32x4*)(O1 + off), a1 = *(const u32x4*)(O1 + off + 8), b0 = *(const u32x4*)(O2 + off), b1 = *(const u32x4*)(O2 + off + 8);
        const unsigned wa[8] = {a0.x, a0.y, a0.z, a0.w, a1.x, a1.y, a1.z, a1.w}, wb[8] = {b0.x, b0.y, b0.z, b0.w, b1.x, b1.y, b1.z, b1.w};
        float o[16]; float s = 0.f;
#pragma unroll
        for (int i = 0; i < 8; ++i) {
            o[2 * i] = bf2f(wa[i] & 0xffffu) - lam * bf2f(wb[i] & 0xffffu); o[2 * i + 1] = bf2f(wa[i] >> 16) - lam * bf2f(wb[i] >> 16);
            s += o[2 * i] * o[2 * i] + o[2 * i + 1] * o[2 * i + 1];
        }
        s += __shfl_xor(s, 1); s += __shfl_xor(s, 2); s += __shfl_xor(s, 4);
        const float rs = (1.0f / sqrtf(s * (1.0f / HD) + EPS)) * (1.0f - LAMBDA_INIT);
        float y[8];
#pragma unroll
        for (int hh = 0; hh < 2; ++hh) {
#pragma unroll
            for (int i = 0; i < 8; ++i) y[i] = o[hh * 8 + i] * rs * F.da_nw[F.lane * 16 + hh * 8 + i];
            store8_bf16(YDA + (size_t)row * DM + F.lane * 16 + hh * 8, y);
        }
    }
}

struct EpiBr1 { const Frame* F; int m0; __device__ __forceinline__ void operator()(int r, int col0, const float (&v)[8]) const {
    const size_t off = (size_t)(m0 + r) * DM + col0; const u32x4 g = *(const u32x4*)(wsp<const bf16>(*F, WS_GATEH) + off);
    float* o = wsp<float>(*F, WS_TMP) + off; const unsigned w[4] = {g.x, g.y, g.z, g.w};
    f32x4 o0, o1;
#pragma unroll
    for (int i = 0; i < 4; ++i) { const float a = v[2 * i] * bf2f(w[i] & 0xffffu), b = v[2 * i + 1] * bf2f(w[i] >> 16); if (i < 2) { o0[2 * i] = a; o0[2 * i + 1] = b; } else { o1[2 * i - 4] = a; o1[2 * i - 3] = b; } }
    *(f32x4*)o = o0; *(f32x4*)(o + 4) = o1; } };
struct EpiBr2 { const Frame* F; int m0; __device__ __forceinline__ void operator()(int r, int col0, const float (&v)[8]) const {
    const size_t off = (size_t)(m0 + r) * DM + col0; const u32x4 g = *(const u32x4*)(wsp<const bf16>(*F, WS_GATED) + off);
    const float* t = wsp<const float>(*F, WS_TMP) + off; const f32x4 t0 = *(const f32x4*)t, t1 = *(const f32x4*)(t + 4); const unsigned w[4] = {g.x, g.y, g.z, g.w};
    float o[8];
#pragma unroll
    for (int i = 0; i < 4; ++i) { o[2 * i] = (i < 2 ? t0[2 * i] : t1[2 * i - 4]) + v[2 * i] * bf2f(w[i] & 0xffffu); o[2 * i + 1] = (i < 2 ? t0[2 * i + 1] : t1[2 * i - 3]) + v[2 * i + 1] * bf2f(w[i] >> 16); }
    store8_bf16(wsp<bf16>(*F, WS_MERGED) + off, o); } };
__device__ __forceinline__ void ph_branch_simple(Frame& F) {
    LAS float* As = (LAS float*)F.lds; LAS float* Bs = As + 16 * 132;
    const int NT_ = DM / 128, MT_ = T / 128;
    for (int t = F.bid; t < NT_ * MT_; t += F.G) {
        const int mt = t / NT_, nt = t % NT_;
        RowsDense rows{mt * 128};
        EpiBr1 e1{&F, mt * 128}; sg_tile(As, Bs, wsp<const bf16>(F, WS_YHG), DM, rows, F.w_bhg, DM, nt * 128, HW, e1);
        EpiBr2 e2{&F, mt * 128}; sg_tile(As, Bs, wsp<const bf16>(F, WS_YDA), DM, rows, F.w_bda, DM, nt * 128, HW, e2);
    }
}
struct EpiU { const Frame* F; int m0; __device__ __forceinline__ void operator()(int r, int col0, const float (&v)[8]) const { store8_bf16(wsp<bf16>(*F, WS_U) + (size_t)(m0 + r) * DM + col0, v); } };
__device__ __forceinline__ void ph_wout_simple(Frame& F) {
    LAS float* As = (LAS float*)F.lds; LAS float* Bs = As + 16 * 132;
    const int NT_ = DM / 128, MT_ = T / 128;
    for (int t = F.bid; t < NT_ * MT_; t += F.G) {
        const int mt = t / NT_, nt = t % NT_;
        RowsDense rows{mt * 128}; EpiU e{&F, mt * 128};
        sg_tile(As, Bs, wsp<const bf16>(F, WS_MERGED), DM, rows, F.w_out, DM, nt * 128, DM, e);
    }
}

__device__ __forceinline__ void ph_post(Frame& F) {
    LAS float* Lgt = (LAS float*)F.lds; LAS float* Lsh = Lgt + DM; LAS float* Lsc = Lsh + DM;
    LAS float* Lh = Lsc + DM + F.wave * DM;
    const bf16* U = wsp<const bf16>(F, WS_U); bf16* X1 = wsp<bf16>(F, WS_X1); bf16* H2 = wsp<bf16>(F, WS_H2);
    int* TOKE = wsp<int>(F, WS_TOKE); int* TOKP = wsp<int>(F, WS_TOKP); int* LT = wsp<int>(F, WS_LISTTOK); float* LW = wsp<float>(F, WS_LISTW);
    int curb = -1;
    for (int rb = F.bid; rb < T / 8; rb += F.G) {
        const int batch = rb / (SEQ / 8);
        if (batch != curb) { __syncthreads(); mod_vec(F, Lgt, 2, batch); mod_vec(F, Lsh, 3, batch); mod_vec(F, Lsc, 4, batch); __syncthreads(); curb = batch; }
        const int row = rb * 8 + F.wave;
        f32x4 u[8]; float s = 0.f;
#pragma unroll
        for (int j = 0; j < 8; ++j) {
            const u32x2 w = *(const u32x2*)(U + (size_t)row * DM + 4 * F.lane + 256 * j);
            u[j] = (f32x4){bf2f(w.x & 0xffffu), bf2f(w.x >> 16), bf2f(w.y & 0xffffu), bf2f(w.y >> 16)};
            s += (u[j][0] * u[j][0] + u[j][1] * u[j][1]) + (u[j][2] * u[j][2] + u[j][3] * u[j][3]);
        }
        const float r1 = 1.0f / sqrtf(wave_sum(s) * (1.0f / DM) + EPS);
        float s2 = 0.f;
#pragma unroll
        for (int j = 0; j < 8; ++j) {
            const int c0 = 4 * F.lane + 256 * j;
            const f32x4 xv = *(const f32x4*)(F.x + (size_t)row * DM + c0), w = *(const f32x4*)(F.post_mix + c0), g = *(const LAS f32x4*)(Lgt + c0);
            u[j] = xv + g * (u[j] * r1 * w);
            { u32x2 xo; xo.x = pk2(u[j][0], u[j][1]); xo.y = pk2(u[j][2], u[j][3]); *(u32x2*)(X1 + (size_t)row * DM + c0) = xo; }
            s2 += (u[j][0] * u[j][0] + u[j][1] * u[j][1]) + (u[j][2] * u[j][2] + u[j][3] * u[j][3]);
        }
        const float r2 = 1.0f / sqrtf(wave_sum(s2) * (1.0f / DM) + EPS);
#pragma unroll
        for (int j = 0; j < 8; ++j) {
            const int c0 = 4 * F.lane + 256 * j;
            const f32x4 w = *(const f32x4*)(F.pre_ffn + c0), sc = *(const LAS f32x4*)(Lsc + c0), sh = *(const LAS f32x4*)(Lsh + c0);
            u[j] = u[j] * r2 * w * (sc + 1.0f) + sh;
            u32x2 o; o.x = pk2(u[j][0], u[j][1]); o.y = pk2(u[j][2], u[j][3]);
            *(u32x2*)(H2 + (size_t)row * DM + c0) = o;
            *(LAS f32x4*)(Lh + c0) = u[j];
        }
        float elog, glog;
        {
            const int j = F.lane & 31, kh = F.lane >> 5;
            const float* wr = F.w_router + (size_t)(kh * 1024) * 32 + j; const LAS float* hp = Lh + kh * 1024;
            float a0 = 0.f, a1 = 0.f;
#pragma unroll 8
            for (int k = 0; k < 1024; k += 2) { a0 += hp[k] * wr[(size_t)k * 32]; a1 += hp[k + 1] * wr[(size_t)(k + 1) * 32]; }
            float a = a0 + a1; a += __shfl_xor(a, 32);
            elog = a + F.b_router[j];
            const int g = F.lane & 3, kp = F.lane >> 2;
            const float* wg = F.w_group + (size_t)(kp * 128) * 4 + g; const LAS float* hq = Lh + kp * 128;
            float c0 = 0.f;
#pragma unroll 8
            for (int k = 0; k < 128; ++k) c0 += hq[k] * wg[(size_t)k * 4];
            c0 += __shfl_xor(c0, 4); c0 += __shfl_xor(c0, 8); c0 += __shfl_xor(c0, 16); c0 += __shfl_xor(c0, 32);
            glog = c0 + F.b_group[g];
        }
        float lg[4];
#pragma unroll
        for (int i = 0; i < 4; ++i) lg[i] = __shfl(glog, i);
        int gi = 0; float gm = lg[0];
#pragma unroll
        for (int i = 1; i < 4; ++i) if (lg[i] > gm) { gm = lg[i]; gi = i; }
        float gden = 0.f;
#pragma unroll
        for (int i = 0; i < 4; ++i) gden += __expf(lg[i] - gm);
        const float gw_ = 1.0f / gden;
        float ev[8];
#pragma unroll
        for (int i = 0; i < 8; ++i) ev[i] = __shfl(elog, gi * 8 + i);
        int i0 = 0; float v0 = ev[0];
#pragma unroll
        for (int i = 1; i < 8; ++i) if (ev[i] > v0) { v0 = ev[i]; i0 = i; }
        int i1 = -1; float v1 = -INFINITY;
#pragma unroll
        for (int i = 0; i < 8; ++i) if (i != i0 && ev[i] > v1) { v1 = ev[i]; i1 = i; }
        const float e1 = __expf(v1 - v0); const float w0 = gw_ / (1.0f + e1), w1 = gw_ * e1 / (1.0f + e1);
        if (F.lane == 0) {
            const int ea = gi * 8 + i0, eb = gi * 8 + i1;
            const int pa = (int)__hip_atomic_fetch_add((unsigned*)(F.ctl + CW_CNT + 16 * ea), 1u, RLX_AGENT);
            const int pb = (int)__hip_atomic_fetch_add((unsigned*)(F.ctl + CW_CNT + 16 * eb), 1u, RLX_AGENT);
            TOKE[row * 2] = ea; TOKE[row * 2 + 1] = eb; TOKP[row * 2] = pa; TOKP[row * 2 + 1] = pb;
            LT[ea * 16384 + pa] = row; LW[ea * 16384 + pa] = w0; LT[eb * 16384 + pb] = row; LW[eb * 16384 + pb] = w1;
        }
    }
#undef POST_LOAD
}


__device__ __forceinline__ void ph_post_fast(Frame& F) {
    LAS float* Hs = (LAS float*)F.lds;
    LAS float* Ps = Hs;
    LAS float* Lg = (LAS float*)(F.lds + 131200);
    const bf16* U = wsp<const bf16>(F, WS_U); bf16* X1 = wsp<bf16>(F, WS_X1); unsigned char* H2 = wsp<unsigned char>(F, WS_H2);
    const float* MODF = wsp<const float>(F, WS_MODF);
    int* TOKE = wsp<int>(F, WS_TOKE); int* TOKP = wsp<int>(F, WS_TOKP); int* LT = wsp<int>(F, WS_LISTTOK); float* LW = wsp<float>(F, WS_LISTW);
    const int l15 = F.lane & 15, kq = F.lane >> 4;
    f32x4 xv2[2][8];
#define POST_LOAD(gg) do { _Pragma("unroll") for (int rr = 0; rr < 2; ++rr) _Pragma("unroll") for (int j = 0; j < 8; ++j) { \
        const size_t off = (size_t)((gg) * 16 + F.wave * 2 + rr) * DM + 4 * F.lane + 256 * j; xv2[rr][j] = *(const f32x4*)(F.x + off); } } while (0)
    if (F.bid < T / 16) POST_LOAD(F.bid);
    for (int g = F.bid; g < T / 16; g += F.G) {
        const int batch = (g * 16) / SEQ;
        const float* Mgt = MODF + (batch * 6 + 2) * DM; const float* Msh = MODF + (batch * 6 + 3) * DM; const float* Msc = MODF + (batch * 6 + 4) * DM;
        __syncthreads();
        {
#pragma unroll 1
            for (int rr = 0; rr < 2; ++rr) {
                int ln = F.lane; asm volatile("" : "+v"(ln));
                const int rl = F.wave * 2 + rr, row = g * 16 + rl;
                f32x4 u[8]; float sq = 0.f;
                {
                    u32x2 uw[8];
#pragma unroll
                    for (int j = 0; j < 8; ++j) uw[j] = *(const u32x2*)(U + (size_t)row * DM + 4 * ln + 256 * j);
#pragma unroll
                    for (int j = 0; j < 8; ++j) {
                        u[j] = (f32x4){bf2f(uw[j].x & 0xffffu), bf2f(uw[j].x >> 16), bf2f(uw[j].y & 0xffffu), bf2f(uw[j].y >> 16)};
                        sq += (u[j][0] * u[j][0] + u[j][1] * u[j][1]) + (u[j][2] * u[j][2] + u[j][3] * u[j][3]);
                    }
                }
                const float r1 = 1.0f / sqrtf(wave_sum(sq) * (1.0f / DM) + EPS);
                float s2 = 0.f;
                {
                    f32x4 w1[8], g1[8];
#pragma unroll
                    for (int j = 0; j < 8; ++j) { const int c0 = 4 * ln + 256 * j; w1[j] = *(const f32x4*)(F.post_mix + c0); g1[j] = *(const f32x4*)(Mgt + c0); }
#pragma unroll
                    for (int j = 0; j < 8; ++j) {
                        const int c0 = 4 * ln + 256 * j;
                        u[j] = (rr == 0 ? xv2[0][j] : xv2[1][j]) + g1[j] * (u[j] * r1 * w1[j]);
                        { u32x2 xo; xo.x = pk2(u[j][0], u[j][1]); xo.y = pk2(u[j][2], u[j][3]); *(u32x2*)(X1 + (size_t)row * DM + c0) = xo; }
                        s2 += (u[j][0] * u[j][0] + u[j][1] * u[j][1]) + (u[j][2] * u[j][2] + u[j][3] * u[j][3]);
                    }
                }
                const float r2 = 1.0f / sqrtf(wave_sum(s2) * (1.0f / DM) + EPS);
                asm volatile("" ::: "memory");
                {
                    f32x4 w2[8], sc2[8], sh2[8];
#pragma unroll
                    for (int j = 0; j < 8; ++j) { const int c0 = 4 * ln + 256 * j; w2[j] = *(const f32x4*)(F.pre_ffn + c0); sc2[j] = *(const f32x4*)(Msc + c0); sh2[j] = *(const f32x4*)(Msh + c0); }
#pragma unroll
                    for (int j = 0; j < 8; ++j) {
                        const int c0 = 4 * ln + 256 * j;
                        const f32x4 hv = u[j] * r2 * w2[j] * (sc2[j] + 1.0f) + sh2[j];
                        *(unsigned*)(H2 + (size_t)row * DM + c0) = pk4_fp8(clamp8(hv[0]), clamp8(hv[1]), clamp8(hv[2]), clamp8(hv[3]));
                        LAS float* hp = Hs + rl * 2050 + c0;
                        *(LAS f32x2_t*)hp = (f32x2_t){hv[0], hv[1]}; *(LAS f32x2_t*)(hp + 2) = (f32x2_t){hv[2], hv[3]};
                    }
                }
                asm volatile("" ::: "memory");
            }
        }
        asm volatile("" ::: "memory");
        if (g + F.G < T / 16) POST_LOAD(g + F.G);
        __syncthreads();
        f32x4 acc[3];
#pragma unroll
        for (int n = 0; n < 3; ++n) acc[n] = (f32x4){0.f, 0.f, 0.f, 0.f};
        {
            typedef short bf16x8_t __attribute__((ext_vector_type(8)));
            const LAS float* ap = Hs + l15 * 2050 + 256 * F.wave + 8 * kq;
            const __amdgpu_buffer_rsrc_t wrs = __builtin_amdgcn_make_buffer_rsrc((void*)wsp<bf16>(F, WS_WCAT), 0, 2 * 48 * DM * 2, 0x00020000);
            const int wvo = (l15 * DM + 256 * F.wave + 8 * kq) * 2;
            bf16x8_t bh[2][2][3], bl[2][2][3];
#define RT_LOADB(buf, sp) do { _Pragma("unroll") for (int s2 = 0; s2 < 2; ++s2) _Pragma("unroll") for (int n = 0; n < 3; ++n) { \
                bh[buf][s2][n] = __builtin_bit_cast(bf16x8_t, __builtin_amdgcn_raw_buffer_load_b128(wrs, wvo, n * 16 * DM * 2 + 64 * (2 * (sp) + s2), 0)); \
                bl[buf][s2][n] = __builtin_bit_cast(bf16x8_t, __builtin_amdgcn_raw_buffer_load_b128(wrs, wvo, 48 * DM * 2 + n * 16 * DM * 2 + 64 * (2 * (sp) + s2), 0)); } } while (0)
            RT_LOADB(0, 0);
#pragma unroll
            for (int sp = 0; sp < 4; ++sp) {
                if (sp + 1 < 4) { if ((sp & 1) == 0) RT_LOADB(1, sp + 1); else RT_LOADB(0, sp + 1); }
#pragma unroll
                for (int s2 = 0; s2 < 2; ++s2) {
                    const int st = 2 * sp + s2;
                    float xv[8];
#pragma unroll
                    for (int q = 0; q < 4; ++q) { const f32x2_t t2 = *(const LAS f32x2_t*)(ap + 32 * st + 2 * q); xv[2 * q] = t2[0]; xv[2 * q + 1] = t2[1]; }
                    u32x4 ah, al;
#pragma unroll
                    for (int q = 0; q < 4; ++q) {
                        const unsigned h = pk2(xv[2 * q], xv[2 * q + 1]);
                        const unsigned l = pk2(xv[2 * q] - bf2f(h & 0xffffu), xv[2 * q + 1] - bf2f(h >> 16));
                        ah[q] = h; al[q] = l;
                    }
                    const bf16x8_t ahi = __builtin_bit_cast(bf16x8_t, ah), alo = __builtin_bit_cast(bf16x8_t, al);
#pragma unroll
                    for (int n = 0; n < 3; ++n) {
                        const bf16x8_t wh = (sp & 1) ? bh[1][s2][n] : bh[0][s2][n], wl = (sp & 1) ? bl[1][s2][n] : bl[0][s2][n];
                        acc[n] = __builtin_amdgcn_mfma_f32_16x16x32_bf16(ahi, wh, acc[n], 0, 0, 0);
                        acc[n] = __builtin_amdgcn_mfma_f32_16x16x32_bf16(alo, wh, acc[n], 0, 0, 0);
                        acc[n] = __builtin_amdgcn_mfma_f32_16x16x32_bf16(ahi, wl, acc[n], 0, 0, 0);
                    }
                }
                asm volatile("" ::: "memory");
            }
#undef RT_LOADB
        }
        __syncthreads();
#pragma unroll
        for (int n = 0; n < 3; ++n)
#pragma unroll
            for (int r = 0; r < 4; ++r) Ps[(F.wave * 16 + 4 * kq + r) * 48 + 16 * n + l15] = acc[n][r];
        __syncthreads();
        for (int o = F.tid; o < 768; o += NTHREADS) {
            float sacc = 0.f;
#pragma unroll
            for (int w8 = 0; w8 < 8; ++w8) sacc += Ps[w8 * 768 + o];
            const int col = o % 48;
            Lg[o] = sacc + (col < 4 ? F.b_group[col] : (col < 36 ? F.b_router[col - 4] : 0.f));
        }
        __syncthreads();
        if (F.lane < 2) {
            const int rl = F.wave * 2 + F.lane, row = g * 16 + rl; const LAS float* lg = Lg + rl * 48;
            int gi = 0; float gm = lg[0];
#pragma unroll
            for (int i = 1; i < 4; ++i) { const float v = lg[i]; if (v > gm) { gm = v; gi = i; } }
            float gden = 0.f;
#pragma unroll
            for (int i = 0; i < 4; ++i) gden += __expf(lg[i] - gm);
            const float gw_ = 1.0f / gden;
            const LAS float* ev = lg + 4 + gi * 8;
            int i0 = 0; float v0 = ev[0];
#pragma unroll
            for (int i = 1; i < 8; ++i) { const float v = ev[i]; if (v > v0) { v0 = v; i0 = i; } }
            int i1 = -1; float v1 = -INFINITY;
#pragma unroll
            for (int i = 0; i < 8; ++i) { const float v = ev[i]; if (i != i0 && v > v1) { v1 = v; i1 = i; } }
            const float e1 = __expf(v1 - v0); const float w0 = gw_ / (1.0f + e1), w1 = gw_ * e1 / (1.0f + e1);
            const int ea = gi * 8 + i0, eb = gi * 8 + i1;
            const int pa = (int)__hip_atomic_fetch_add((unsigned*)(F.ctl + CW_CNT + 16 * ea), 1u, RLX_AGENT);
            const int pb = (int)__hip_atomic_fetch_add((unsigned*)(F.ctl + CW_CNT + 16 * eb), 1u, RLX_AGENT);
            TOKE[row * 2] = ea; TOKE[row * 2 + 1] = eb; TOKP[row * 2] = pa; TOKP[row * 2 + 1] = pb;
            LT[ea * 16384 + pa] = row; LW[ea * 16384 + pa] = w0; LT[eb * 16384 + pb] = row; LW[eb * 16384 + pb] = w1;
        }
    }
}
__device__ __forceinline__ void expert_tables(Frame& F, LAS int* tab, int tile_rows) {
    if (F.tid == 0) {
        int ps = 0, ts = 0;
        for (int e = 0; e < NE; ++e) {
            const int c = (int)__hip_atomic_load((unsigned*)(F.ctl + CW_CNT + 16 * e), RLX_AGENT);
            tab[e] = c; tab[32 + e] = ps; tab[72 + e] = ts;
            ps += (c + 255) / 256 * 256; ts += (c + tile_rows - 1) / tile_rows;
        }
        tab[32 + NE] = ps; tab[72 + NE] = ts;
    }
    __syncthreads();
}

struct EpiG { const Frame* F; int slot0, n; __device__ __forceinline__ void operator()(int r, int col0, const float (&v)[8]) const {
    if (r >= n) return; float* o = wsp<float>(*F, WS_TMPG) + (size_t)(slot0 + r) * DE + col0;
    f32x4 o0, o1;
#pragma unroll
    for (int i = 0; i < 8; ++i) { const float s = v[i] * sigmoidf_(v[i]); if (i < 4) o0[i] = s; else o1[i - 4] = s; }
    *(f32x4*)o = o0; *(f32x4*)(o + 4) = o1; } };
struct EpiUp { const Frame* F; int slot0, n; __device__ __forceinline__ void operator()(int r, int col0, const float (&v)[8]) const {
    if (r >= n) return; const float* t = wsp<const float>(*F, WS_TMPG) + (size_t)(slot0 + r) * DE + col0; const f32x4 t0 = *(const f32x4*)t, t1 = *(const f32x4*)(t + 4);
    float o[8];
#pragma unroll
    for (int i = 0; i < 8; ++i) o[i] = (i < 4 ? t0[i] : t1[i - 4]) * v[i];
    store8_bf16(wsp<bf16>(*F, WS_ACT) + (size_t)(slot0 + r) * DE + col0, o); } };
__device__ __forceinline__ void ph_moe1_simple(Frame& F) {
    LAS float* As = (LAS float*)F.lds; LAS float* Bs = As + 16 * 132; LAS int* tab = (LAS int*)(Bs + 16 * 132);
    expert_tables(F, tab, 128);
    const int NT_ = DE / 128, ntl = tab[72 + NE] * NT_;
    for (int t = F.bid; t < ntl; t += F.G) {
        const int mtg = t / NT_, nt = t % NT_;
        int e = 0;
#pragma unroll 1
        for (int q = 1; q < NE; ++q) if (tab[72 + q] <= mtg) e = q;
        const int mt = mtg - tab[72 + e], n = min(128, tab[e] - mt * 128), slot0 = tab[32 + e] + mt * 128;
        RowsList rows{wsp<const int>(F, WS_LISTTOK) + e * 16384 + mt * 128, n};
        EpiG eg{&F, slot0, n}; sg_tile(As, Bs, wsp<const bf16>(F, WS_H2), DM, rows, F.w_gate + (size_t)e * DM * DE, DE, nt * 128, DM, eg);
        EpiUp eu{&F, slot0, n}; sg_tile(As, Bs, wsp<const bf16>(F, WS_H2), DM, rows, F.w_up + (size_t)e * DM * DE, DE, nt * 128, DM, eu);
    }
}
struct EpiDown { const Frame* F; int slot0, n; const float* lw; __device__ __forceinline__ void operator()(int r, int col0, const float (&v)[8]) const {
    if (r >= n) return; const float w = lw[r]; float o[8];
#pragma unroll
    for (int i = 0; i < 8; ++i) o[i] = v[i] * w;
    store8_bf16(wsp<bf16>(*F, WS_YW) + (size_t)(slot0 + r) * DM + col0, o); } };
__device__ __forceinline__ void ph_moe2_simple(Frame& F) {
    LAS float* As = (LAS float*)F.lds; LAS float* Bs = As + 16 * 132; LAS int* tab = (LAS int*)(Bs + 16 * 132);
    expert_tables(F, tab, 128);
    const int NT_ = DM / 128, ntl = tab[72 + NE] * NT_;
    for (int t = F.bid; t < ntl; t += F.G) {
        const int mtg = t / NT_, nt = t % NT_;
        int e = 0;
#pragma unroll 1
        for (int q = 1; q < NE; ++q) if (tab[72 + q] <= mtg) e = q;
        const int mt = mtg - tab[72 + e], n = min(128, tab[e] - mt * 128), slot0 = tab[32 + e] + mt * 128;
        RowsDense rows{slot0};
        EpiDown ed{&F, slot0, n, wsp<const float>(F, WS_LISTW) + e * 16384 + mt * 128};
        sg_tile(As, Bs, wsp<const bf16>(F, WS_ACT), DE, rows, F.w_down + (size_t)e * DE * DM, DM, nt * 128, DE, ed);
    }
}

__device__ __forceinline__ void ph_final(Frame& F) {
    LAS int* tab = (LAS int*)F.lds;
    expert_tables(F, tab, 128);
    const bf16* X1 = wsp<const bf16>(F, WS_X1); const unsigned char* YW = wsp<const unsigned char>(F, WS_YW); const float* MODF = wsp<const float>(F, WS_MODF);
    const int* TOKE = wsp<const int>(F, WS_TOKE); const int* TOKP = wsp<const int>(F, WS_TOKP); const float* LW = wsp<const float>(F, WS_LISTW);
    const int gw = F.bid * NWAVES + F.wave, NGW = F.G * NWAVES;
    for (int rp = gw; rp < T / 2; rp += NGW) {
        const int row0 = rp * 2;
        int ln = F.lane; asm volatile("" : "+v"(ln));
        const float* Mgt = MODF + ((row0 / SEQ) * 6 + 5) * DM;
        int sl[2][2]; float rw[2][2];
#pragma unroll
        for (int r = 0; r < 2; ++r)
#pragma unroll
            for (int q = 0; q < 2; ++q) { const int e_ = TOKE[(row0 + r) * 2 + q], p_ = TOKP[(row0 + r) * 2 + q]; sl[r][q] = tab[32 + e_] + p_; rw[r][q] = LW[e_ * 16384 + p_] * Y8I; }
        unsigned ya[2][8], yb[2][8]; u32x2 xr[2][8];
#pragma unroll
        for (int r = 0; r < 2; ++r)
#pragma unroll
            for (int j = 0; j < 8; ++j) { const int c0 = 4 * ln + 256 * j; ya[r][j] = *(const unsigned*)(YW + (size_t)sl[r][0] * DM + c0); yb[r][j] = *(const unsigned*)(YW + (size_t)sl[r][1] * DM + c0);
                xr[r][j] = *(const u32x2*)(X1 + (size_t)(row0 + r) * DM + c0); }
        f32x4 wv[8], gv[8];
#pragma unroll
        for (int j = 0; j < 8; ++j) { const int c0 = 4 * ln + 256 * j; wv[j] = *(const f32x4*)(F.post_ffn + c0); gv[j] = *(const f32x4*)(Mgt + c0); }
#pragma unroll
        for (int r = 0; r < 2; ++r) {
            f32x4 y[8]; float s = 0.f;
#pragma unroll
            for (int j = 0; j < 8; ++j) {
                const f32x2_t a0 = __builtin_amdgcn_cvt_pk_f32_fp8((int)ya[r][j], false), a1 = __builtin_amdgcn_cvt_pk_f32_fp8((int)ya[r][j], true);
                const f32x2_t b0 = __builtin_amdgcn_cvt_pk_f32_fp8((int)yb[r][j], false), b1 = __builtin_amdgcn_cvt_pk_f32_fp8((int)yb[r][j], true);
                y[j] = (f32x4){a0[0] * rw[r][0] + b0[0] * rw[r][1], a0[1] * rw[r][0] + b0[1] * rw[r][1], a1[0] * rw[r][0] + b1[0] * rw[r][1], a1[1] * rw[r][0] + b1[1] * rw[r][1]};
                s += (y[j][0] * y[j][0] + y[j][1] * y[j][1]) + (y[j][2] * y[j][2] + y[j][3] * y[j][3]);
            }
            const float rn = 1.0f / sqrtf(wave_sum(s) * (1.0f / DM) + EPS);
#pragma unroll
            for (int j = 0; j < 8; ++j) {
                const int c0 = 4 * ln + 256 * j;
                const f32x4 xv = (f32x4){bf2f(xr[r][j].x & 0xffffu), bf2f(xr[r][j].x >> 16), bf2f(xr[r][j].y & 0xffffu), bf2f(xr[r][j].y >> 16)};
                *(f32x4*)(F.out + (size_t)(row0 + r) * DM + c0) = xv + gv[j] * (y[j] * rn * wv[j]);
            }
        }
    }
}


#define T_LOAD32(tv, RS, N, k0, n0) do { const int vo_ = ((8 * (lane >> 3)) * (N) + (n0) + 4 * (lane & 7)) * 4; \
        _Pragma("unroll") for (int i = 0; i < 8; ++i) tv[i] = __builtin_bit_cast(f32x4, __builtin_amdgcn_raw_buffer_load_b128(RS, vo_, ((k0) + i) * (N) * 4, 2)); } while (0)
#define T_STORE32F8(tv, WT, K, k0, drow) do { _Pragma("unroll") for (int j = 0; j < 4; ++j) { \
        u32x2 o_; o_.x = pk4_fp8(tv[0][j] * W8S, tv[1][j] * W8S, tv[2][j] * W8S, tv[3][j] * W8S); o_.y = pk4_fp8(tv[4][j] * W8S, tv[5][j] * W8S, tv[6][j] * W8S, tv[7][j] * W8S); \
        *(u32x2*)((WT) + (size_t)((drow) + 4 * (lane & 7) + j) * (K) + (k0) + 8 * (lane >> 3)) = o_; } } while (0)
#define T_STORE32(tv, WT, K, k0, drow) do { _Pragma("unroll") for (int j = 0; j < 4; ++j) { \
        u32x4 o_; o_.x = pk2(tv[0][j], tv[1][j]); o_.y = pk2(tv[2][j], tv[3][j]); o_.z = pk2(tv[4][j], tv[5][j]); o_.w = pk2(tv[6][j], tv[7][j]); \
        *(u32x4*)((WT) + (size_t)((drow) + 4 * (lane & 7) + j) * (K) + (k0) + 8 * (lane >> 3)) = o_; } } while (0)
namespace hg {
typedef short bf16x8 __attribute__((ext_vector_type(8)));
typedef short bf16x4 __attribute__((ext_vector_type(4)));
constexpr int QE_OFF = 0, KE_OFF = 17408, KDT_OFF = 34816, VT_OFF = 53248, AM_OFF = 71680, OB_OFF = 80896, SEG_OFF = 114688, DV_OFF = 118784;
constexpr int QROW = 272, TROW = 144, OROW = 528;
__device__ __forceinline__ bf16x8 cat8(bf16x4 a, bf16x4 b) { return (bf16x8){a[0], a[1], a[2], a[3], b[0], b[1], b[2], b[3]}; }
}
__device__ __forceinline__ void hgrn_chain_fast(Frame& F, int ch) {
    using namespace hg;
    const int b = ch >> 3, h = ch & 7;
    const int lane = F.lane, w = F.wave, tid = F.tid;
    LAS unsigned char* L = F.lds;
    const int l15 = lane & 15, kq = lane >> 4;
    const float* LOGF = wsp<const float>(F, WS_LOGF); const bf16* QHG = wsp<const bf16>(F, WS_QHG); const bf16* VHG = wsp<const bf16>(F, WS_VHG); const bf16* GHG = wsp<const bf16>(F, WS_GHG);
    bf16* YHG = wsp<bf16>(F, WS_YHG);
    const size_t rowbase = (size_t)(b * SEQ) * HW + h * HD;
    f32x4 S[8];
#pragma unroll
    for (int i = 0; i < 8; ++i) S[i] = (f32x4){0.f, 0.f, 0.f, 0.f};
    float lf[8][2]; unsigned qv[8], vv[8]; u32x4 gq[2];
    const int nt_ = tid >> 3, nvg = tid & 7;
#define HG_LOAD(c) do { _Pragma("unroll") for (int i = 0; i < 8; ++i) { const size_t off = rowbase + (size_t)((c) * 64 + 8 * w + i) * HW + 2 * lane; \
        const u32x2 t2 = *(const u32x2*)(LOGF + off); lf[i][0] = __uint_as_float(t2.x); lf[i][1] = __uint_as_float(t2.y); qv[i] = *(const unsigned*)(QHG + off); vv[i] = *(const unsigned*)(VHG + off); } \
        { const bf16* gp = GHG + rowbase + (size_t)((c) * 64 + nt_) * HW + 16 * nvg; gq[0] = *(const u32x4*)gp; gq[1] = *(const u32x4*)(gp + 8); } } while (0)
    f32x4 nwv[4];
#pragma unroll
    for (int i = 0; i < 4; ++i) nwv[i] = *(const f32x4*)(F.hg_nw + h * HD + 16 * nvg + 4 * i);
    HG_LOAD(0);
    __syncthreads();
    for (int c = 0; c < SEQ / 64; ++c) {
        float sum0 = lf[0][0], sum1 = lf[0][1];
#pragma unroll
        for (int i = 1; i < 8; ++i) { sum0 += lf[i][0]; sum1 += lf[i][1]; }
        *(LAS f32x2_t*)(L + SEG_OFF + (w * 128 + 2 * lane) * 4) = (f32x2_t){sum0, sum1};
        __syncthreads();
        float base0 = 0.f, base1 = 0.f, tot0 = 0.f, tot1 = 0.f;
#pragma unroll
        for (int s_ = 0; s_ < 8; ++s_) { const f32x2_t sv = *(const LAS f32x2_t*)(L + SEG_OFF + (s_ * 128 + 2 * lane) * 4); tot0 += sv[0]; tot1 += sv[1]; if (s_ < w) { base0 += sv[0]; base1 += sv[1]; } }
        const float eb0 = __expf(tot0), eb1 = __expf(tot1);
        float E0 = __expf(base0), E1 = __expf(base1);
        unsigned kd0[4], kd1[4], vt0[4], vt1[4];
#pragma unroll
        for (int i = 0; i < 8; ++i) {
            const float f0 = __expf(lf[i][0]), f1 = __expf(lf[i][1]);
            E0 *= f0; E1 *= f1;
            const float q0 = bf2f(qv[i] & 0xffffu), q1 = bf2f(qv[i] >> 16);
            const float qe0 = q0 * E0, qe1 = q1 * E1;
            const float ke0 = (1.0f - f0) * __builtin_amdgcn_rcpf(E0), ke1 = (1.0f - f1) * __builtin_amdgcn_rcpf(E1);
            const float d0 = ke0 * eb0, d1 = ke1 * eb1;
            *(LAS unsigned*)(L + QE_OFF + (8 * w + i) * QROW + 4 * lane) = pk2(qe0, qe1);
            *(LAS unsigned*)(L + KE_OFF + (8 * w + i) * QROW + 4 * lane) = pk2(ke0, ke1);
            const unsigned dd0 = f2bf(d0), dd1 = f2bf(d1);
            if (i & 1) { kd0[i >> 1] |= dd0 << 16; kd1[i >> 1] |= dd1 << 16; vt0[i >> 1] |= (vv[i] & 0xffffu) << 16; vt1[i >> 1] |= (vv[i] >> 16) << 16; }
            else { kd0[i >> 1] = dd0; kd1[i >> 1] = dd1; vt0[i >> 1] = vv[i] & 0xffffu; vt1[i >> 1] = vv[i] >> 16; }
        }
        *(LAS u32x4*)(L + KDT_OFF + (2 * lane) * TROW + 16 * w) = (u32x4){kd0[0], kd0[1], kd0[2], kd0[3]};
        *(LAS u32x4*)(L + KDT_OFF + (2 * lane + 1) * TROW + 16 * w) = (u32x4){kd1[0], kd1[1], kd1[2], kd1[3]};
        *(LAS u32x4*)(L + VT_OFF + (2 * lane) * TROW + 16 * w) = (u32x4){vt0[0], vt0[1], vt0[2], vt0[3]};
        *(LAS u32x4*)(L + VT_OFF + (2 * lane + 1) * TROW + 16 * w) = (u32x4){vt1[0], vt1[1], vt1[2], vt1[3]};
        if (w == 0) *(LAS f32x2_t*)(L + DV_OFF + 8 * lane) = (f32x2_t){eb0, eb1};
        u32x4 gcur[2] = {gq[0], gq[1]};
        if (c + 1 < SEQ / 64) HG_LOAD(c + 1);
        f32x4 twa[8], twb[8];
        const bool tjob = ((w + c) & 1) == 0;
        const int tid_ = (ch * (SEQ / 64) + c) * 4 + (w >> 1), te = tid_ >> 8, tkp = 4 + ((tid_ & 255) >> 6), tnb = tid_ & 63;
        const __amdgpu_buffer_rsrc_t trs = __builtin_amdgcn_make_buffer_rsrc((void*)(F.w_down + (size_t)te * DE * DM), 0, DM * DE * 4, 0x00020000);
        if (tjob) { const int vo_ = ((16 * (lane >> 3)) * DM + tnb * 32 + 4 * (lane & 7)) * 4;
#pragma unroll
            for (int i = 0; i < 8; ++i) twa[i] = __builtin_bit_cast(f32x4, __builtin_amdgcn_raw_buffer_load_b128(trs, vo_, (tkp * 128 + i) * DM * 4, 2));
#pragma unroll
            for (int i = 0; i < 8; ++i) twb[i] = __builtin_bit_cast(f32x4, __builtin_amdgcn_raw_buffer_load_b128(trs, vo_, (tkp * 128 + 8 + i) * DM * 4, 2)); }
        __syncthreads();
        {
            const int ti = w >> 1;
#pragma unroll
            for (int sj = 0; sj < 2; ++sj) {
                const int si = 2 * (w & 1) + sj;
                f32x4 a = (f32x4){0.f, 0.f, 0.f, 0.f};
                if (si <= ti) {
#pragma unroll
                    for (int j = 0; j < 4; ++j) {
                        const bf16x8 ka = *(const LAS bf16x8*)(L + KE_OFF + (16 * si + l15) * QROW + (32 * j + 8 * kq) * 2);
                        const bf16x8 qb = *(const LAS bf16x8*)(L + QE_OFF + (16 * ti + l15) * QROW + (32 * j + 8 * kq) * 2);
                        a = __builtin_amdgcn_mfma_f32_16x16x32_bf16(ka, qb, a, 0, 0, 0);
                    }
                    const int t = 16 * ti + l15, s0 = 16 * si + 4 * kq;
#pragma unroll
                    for (int r = 0; r < 4; ++r) if (s0 + r > t) a[r] = 0.f;
                }
                *(LAS u32x2*)(L + AM_OFF + (16 * ti + l15) * TROW + (16 * si + 4 * kq) * 2) = (u32x2){pk2(a[0], a[1]), pk2(a[2], a[3])};
            }
        }
        __syncthreads();
        {
            bf16x8 vf[2];
#pragma unroll
            for (int j = 0; j < 2; ++j) vf[j] = *(const LAS bf16x8*)(L + VT_OFF + (16 * w + l15) * TROW + (32 * j + 8 * kq) * 2);
            bf16x8 sb[4];
#pragma unroll
            for (int j = 0; j < 4; ++j) { const u32x4 t4 = (u32x4){pk2(S[2 * j][0], S[2 * j][1]), pk2(S[2 * j][2], S[2 * j][3]), pk2(S[2 * j + 1][0], S[2 * j + 1][1]), pk2(S[2 * j + 1][2], S[2 * j + 1][3])}; sb[j] = __builtin_bit_cast(bf16x8, t4); }
#pragma unroll
            for (int ti = 0; ti < 4; ++ti) {
                f32x4 o = (f32x4){0.f, 0.f, 0.f, 0.f};
#pragma unroll
                for (int j = 0; j < 2; ++j) { const bf16x8 am = *(const LAS bf16x8*)(L + AM_OFF + (16 * ti + l15) * TROW + (32 * j + 8 * kq) * 2); o = __builtin_amdgcn_mfma_f32_16x16x32_bf16(am, vf[j], o, 0, 0, 0); }
#pragma unroll
                for (int j = 0; j < 4; ++j) {
                    const bf16x4 lo = *(const LAS bf16x4*)(L + QE_OFF + (16 * ti + l15) * QROW + (32 * j + 4 * kq) * 2);
                    const bf16x4 hi = *(const LAS bf16x4*)(L + QE_OFF + (16 * ti + l15) * QROW + (32 * j + 16 + 4 * kq) * 2);
                    o = __builtin_amdgcn_mfma_f32_16x16x32_bf16(cat8(lo, hi), sb[j], o, 0, 0, 0);
                }
#pragma unroll
                for (int r = 0; r < 4; ++r) *(LAS float*)(L + OB_OFF + (16 * ti + 4 * kq + r) * OROW + (16 * w + l15) * 4) = o[r];
            }
#pragma unroll
            for (int kt = 0; kt < 8; ++kt) {
                const f32x4 dv = *(const LAS f32x4*)(L + DV_OFF + (16 * kt + 4 * kq) * 4);
                f32x4 cacc = S[kt] * dv;
#pragma unroll
                for (int j = 0; j < 2; ++j) { const bf16x8 kd = *(const LAS bf16x8*)(L + KDT_OFF + (16 * kt + l15) * TROW + (32 * j + 8 * kq) * 2); cacc = __builtin_amdgcn_mfma_f32_16x16x32_bf16(kd, vf[j], cacc, 0, 0, 0); }
                S[kt] = cacc;
            }
        }
        __syncthreads();
        {
            f32x4 o4[4]; float ss = 0.f;
#pragma unroll
            for (int i = 0; i < 4; ++i) { o4[i] = *(const LAS f32x4*)(L + OB_OFF + nt_ * OROW + (16 * nvg + 4 * i) * 4); ss += (o4[i][0] * o4[i][0] + o4[i][1] * o4[i][1]) + (o4[i][2] * o4[i][2] + o4[i][3] * o4[i][3]); }
            ss += __shfl_xor(ss, 1); ss += __shfl_xor(ss, 2); ss += __shfl_xor(ss, 4);
            const float rstd = 1.0f / sqrtf(ss * (1.0f / HD) + EPS);
            float y[8];
            bf16* yp = YHG + (size_t)(b * SEQ + c * 64 + nt_) * DM + h * HD + 16 * nvg;
#pragma unroll
            for (int hh = 0; hh < 2; ++hh) {
                const f32x4 n0 = nwv[2 * hh], n1 = nwv[2 * hh + 1];
                const u32x4 g = gcur[hh];
                y[0] = o4[2 * hh][0] * rstd * n0[0] * bf2f(g.x & 0xffffu); y[1] = o4[2 * hh][1] * rstd * n0[1] * bf2f(g.x >> 16);
                y[2] = o4[2 * hh][2] * rstd * n0[2] * bf2f(g.y & 0xffffu); y[3] = o4[2 * hh][3] * rstd * n0[3] * bf2f(g.y >> 16);
                y[4] = o4[2 * hh + 1][0] * rstd * n1[0] * bf2f(g.z & 0xffffu); y[5] = o4[2 * hh + 1][1] * rstd * n1[1] * bf2f(g.z >> 16);
                y[6] = o4[2 * hh + 1][2] * rstd * n1[2] * bf2f(g.w & 0xffffu); y[7] = o4[2 * hh + 1][3] * rstd * n1[3] * bf2f(g.w >> 16);
                store8_bf16(yp + hh * 8, y);
            }
        }
        if (tjob) { unsigned char* wt_ = wsp<unsigned char>(F, WS_WD_T) + (size_t)te * DM * DE;
#pragma unroll
            for (int j = 0; j < 4; ++j) { u32x4 o_;
                o_.x = pk4_fp8(twa[0][j] * W8S, twa[1][j] * W8S, twa[2][j] * W8S, twa[3][j] * W8S); o_.y = pk4_fp8(twa[4][j] * W8S, twa[5][j] * W8S, twa[6][j] * W8S, twa[7][j] * W8S);
                o_.z = pk4_fp8(twb[0][j] * W8S, twb[1][j] * W8S, twb[2][j] * W8S, twb[3][j] * W8S); o_.w = pk4_fp8(twb[4][j] * W8S, twb[5][j] * W8S, twb[6][j] * W8S, twb[7][j] * W8S);
                *(u32x4*)(wt_ + (size_t)(tnb * 32 + 4 * (lane & 7) + j) * DE + tkp * 128 + 16 * (lane >> 3)) = o_; } }
    }
#undef HG_LOAD
    __syncthreads();
}


#include <hip/hip_bf16.h>
#include <cmath>
namespace attn_body {
using bf16=__hip_bfloat16;
using bf16x8=__attribute__((ext_vector_type(8)))short;
using s16x4=__attribute__((ext_vector_type(4)))short;
using f32x16=__attribute__((ext_vector_type(16)))float;
using u32x4=__attribute__((ext_vector_type(4)))unsigned;
constexpr int SEQ=2048,D=64,DM=1024;
constexpr int NW=8,QBLK=32,QB=QBLK*NW,KVBLK=64,NQB=SEQ/QB;
constexpr int ATTN_PITCH=DM, ATTN_UNIT_ROWS=QB;
__device__ __forceinline__ int crow(int r,int hi){return (r&3)+8*(r>>2)+4*hi;}
#define SBAR() __builtin_amdgcn_sched_barrier(0)
__device__ __forceinline__ void cmask(f32x16&p0,f32x16&p1,int jb,int qrel,int hi){
  const float NEG=-INFINITY;
  if(64*jb>(qrel|63)){
  #pragma unroll
  for(int r=0;r<16;++r){p0[r]=NEG;p1[r]=NEG;} }
}

constexpr int NSLOT=3, SLOTB=8192;
constexpr int LDS_K=0, LDS_V=NSLOT*SLOTB, LDS_WS=2*NSLOT*SLOTB, LDS_OST=LDS_WS+NW*64*4, LDS_BYTES=LDS_OST+NW*4096;
constexpr float C2=0.125f*1.4426950408889634f;
__device__ __forceinline__ void glds16(const void*gsrc,unsigned lds_dst){unsigned keep;
  asm volatile("s_mov_b32 %0, m0\n\ts_mov_b32 m0, %2\n\ts_nop 0\n\tglobal_load_lds_dwordx4 %1, off\n\ts_mov_b32 m0, %0":"=&s"(keep):"v"(gsrc),"s"(lds_dst):"memory");}
__device__ __forceinline__ float max3f(float a,float b,float c){float r;asm("v_max3_f32 %0, %1, %2, %3":"=v"(r):"v"(a),"v"(b),"v"(c));return r;}
__device__ __forceinline__ float max2f(float a,float b){float r;asm("v_max_f32_e32 %0, %1, %2":"=v"(r):"v"(a),"v"(b));return r;}
__device__ __forceinline__ float fadd_s(float a,float b){float r;asm("v_add_f32_e32 %0, %1, %2":"=v"(r):"v"(a),"v"(b));return r;}
__device__ __forceinline__ float fsub_s(float a,float b){float r;asm("v_sub_f32_e32 %0, %1, %2":"=v"(r):"v"(a),"v"(b));return r;}
typedef float f32x2_t __attribute__((ext_vector_type(2))); typedef __bf16 bf16x2_t __attribute__((ext_vector_type(2)));
__device__ __forceinline__ unsigned cvtpk_s(float lo,float hi){f32x2_t v={lo,hi};bf16x2_t b=__builtin_convertvector(v,bf16x2_t);return __builtin_bit_cast(unsigned,b);}
#define WAIT_BAR(N) asm volatile("s_waitcnt vmcnt(" #N ") lgkmcnt(0)\n\ts_barrier":::"memory")

__device__ __forceinline__ void qkt(f32x16&p0,f32x16&p1,const char*Kslot,const bf16x8*qr,const f32x16&negm,int r32,int hi){
  const char*kb=Kslot+hi*1024+r32*16;
  #pragma unroll
  for(int d0=0;d0<4;++d0){
    const bf16x8 b0=*reinterpret_cast<const bf16x8*>(kb+d0*2048);
    const bf16x8 b1=*reinterpret_cast<const bf16x8*>(kb+d0*2048+512);
    if(d0==0){p0=__builtin_amdgcn_mfma_f32_32x32x16_bf16(b0,qr[0],negm,0,0,0);p1=__builtin_amdgcn_mfma_f32_32x32x16_bf16(b1,qr[0],negm,0,0,0);}
    else{p0=__builtin_amdgcn_mfma_f32_32x32x16_bf16(b0,qr[d0],p0,0,0,0);p1=__builtin_amdgcn_mfma_f32_32x32x16_bf16(b1,qr[d0],p1,0,0,0);}}
}
typedef __attribute__((address_space(3))) const char* lds_cptr;
typedef short v4i16_t __attribute__((ext_vector_type(4)));
__device__ __forceinline__ void kload8(bf16x8*kf,lds_cptr kp){
  kf[0]=*(const __attribute__((address_space(3))) bf16x8*)(kp);      kf[1]=*(const __attribute__((address_space(3))) bf16x8*)(kp+512);
  kf[2]=*(const __attribute__((address_space(3))) bf16x8*)(kp+2048); kf[3]=*(const __attribute__((address_space(3))) bf16x8*)(kp+2560);
  kf[4]=*(const __attribute__((address_space(3))) bf16x8*)(kp+4096); kf[5]=*(const __attribute__((address_space(3))) bf16x8*)(kp+4608);
  kf[6]=*(const __attribute__((address_space(3))) bf16x8*)(kp+6144); kf[7]=*(const __attribute__((address_space(3))) bf16x8*)(kp+6656);
}
__device__ __forceinline__ void kload2(bf16x8*kf,lds_cptr kp,int j){ kf[2*j]=*(const __attribute__((address_space(3))) bf16x8*)(kp+j*2048); kf[2*j+1]=*(const __attribute__((address_space(3))) bf16x8*)(kp+j*2048+512); }
__device__ __forceinline__ s16x4 vtr(lds_cptr p){ return __builtin_bit_cast(s16x4,__builtin_amdgcn_ds_read_tr16_b64_v4i16((__attribute__((address_space(3))) v4i16_t*)p)); }
__device__ __forceinline__ float rowmax(const f32x16&p0,const f32x16&p1){
  float a=max3f(p0[0],p0[1],p1[0]),b=max3f(p0[2],p0[3],p1[1]);a=max3f(a,p1[2],p1[3]);
  #pragma unroll
  for(int r=4;r<16;r+=4){a=max3f(a,p0[r],p0[r+1]);b=max3f(b,p0[r+2],p0[r+3]);a=max3f(a,p1[r],p1[r+1]);b=max3f(b,p1[r+2],p1[r+3]);}
  const float m=max2f(a,b);
  auto rr=__builtin_amdgcn_permlane32_swap(__float_as_uint(m),__float_as_uint(m),false,false);
  return max2f(__uint_as_float(rr[0]),__uint_as_float(rr[1]));
}
__device__ __forceinline__ void pv(f32x16*o,int vb,bf16x8 pa0,bf16x8 pa1,bf16x8 pa2,bf16x8 pa3){
  #pragma unroll
  for(int d0=0;d0<2;++d0){s16x4 lo[4],hi[4];
    #pragma unroll
    for(int ks=0;ks<4;++ks){
      asm volatile("ds_read_b64_tr_b16 %0,%1 offset:%c2":"=&v"(lo[ks]):"v"(vb),"i"(d0*4096+ks*1024):"memory");
      asm volatile("ds_read_b64_tr_b16 %0,%1 offset:%c2":"=&v"(hi[ks]):"v"(vb),"i"(d0*4096+ks*1024+512):"memory");}
    asm volatile("s_waitcnt lgkmcnt(0)":::"memory");SBAR();
    #define PK(k) (bf16x8){lo[k][0],lo[k][1],lo[k][2],lo[k][3],hi[k][0],hi[k][1],hi[k][2],hi[k][3]}
    o[d0]=__builtin_amdgcn_mfma_f32_32x32x16_bf16(pa0,PK(0),o[d0],0,0,0);
    o[d0]=__builtin_amdgcn_mfma_f32_32x32x16_bf16(pa1,PK(1),o[d0],0,0,0);
    o[d0]=__builtin_amdgcn_mfma_f32_32x32x16_bf16(pa2,PK(2),o[d0],0,0,0);
    o[d0]=__builtin_amdgcn_mfma_f32_32x32x16_bf16(pa3,PK(3),o[d0],0,0,0);
    #undef PK
  }
}

#ifndef ATTN_STORE16
#define ATTN_STORE16(p,v) (*(u32x4*)(p)=(v))
#endif
template<int THRL> __device__ __forceinline__ void attn_unit(int b,int h,int hv,int qb,const bf16*Q,const bf16*__restrict__ K,const bf16*__restrict__ V,bf16*O,char*shm){
  const int tid=threadIdx.x,lane=tid&63,r32=lane&31,hi=lane>>5; const int wid=__builtin_amdgcn_readfirstlane(tid>>6);
  const long rowbase=(long)b*SEQ; const int q0=qb*QB;
  const bf16*Qw=Q+(rowbase+q0+wid*QBLK)*DM+h*D;
  const bf16*Kh=K+rowbase*DM+h*D,*Vh=V+rowbase*DM+hv*D;
  const unsigned lds0=(unsigned)(uintptr_t)shm;
  float*wsf=(float*)(shm+LDS_WS)+wid*64;
  const bf16*ksrc=Kh+(long)lane*DM+wid*8;
  const bf16*vsrc=Vh+(long)(16*(wid&3)+(lane>>2))*DM+(wid>>2)*32+(lane&3)*8;
  const unsigned kdst=lds0+LDS_K+wid*1024, vdst=lds0+LDS_V+wid*1024;
  #define DMA_K(t,slot) glds16(ksrc+(long)(t)*KVBLK*DM,(unsigned)__builtin_amdgcn_readfirstlane(kdst+(slot)))
  #define DMA_V(t,slot) glds16(vsrc+(long)(t)*KVBLK*DM,(unsigned)__builtin_amdgcn_readfirstlane(vdst+(slot)))
  const int vb0=(int)(lds0+LDS_V)+((lane>>4)&1)*32+(lane&3)*8+(4*hi+((lane&15)>>2))*64;
  const char*Kbase=shm+LDS_K; bf16x8 kf[8];
  const lds_cptr shm3=(lds_cptr)shm; const lds_cptr kp0=shm3+LDS_K+hi*1024+r32*16; const lds_cptr vp0=shm3+LDS_V+((lane>>4)&1)*32+(lane&3)*8+(4*hi+((lane&15)>>2))*64;
  const int NT=(q0+QB)/KVBLK;
  DMA_K(0,0);DMA_V(0,0);DMA_K(1,SLOTB);
  bf16x8 qr[4];
  #pragma unroll
  for(int d0=0;d0<4;++d0)qr[d0]=*reinterpret_cast<const bf16x8*>(&Qw[(long)r32*DM+d0*16+hi*8]);
  float mhat=0.f,l_reg=0.f;f32x16 o[2];o[0]=f32x16{};o[1]=f32x16{};f32x16 negm=f32x16{};asm volatile("":"+v"(negm));
  const int qrel=wid*QBLK+r32;
  #define CMASK(P0,P1,t) do{int jb_=(t)-(NT-4); if(jb_>=0)cmask(P0,P1,jb_,qrel,hi);}while(0)
  bool resc=false;
  #define START(P0,P1) do{ const float rm=rowmax(P0,P1); resc=false; \
    { const float dl=rm; mhat=fadd_s(mhat,dl); \
      _Pragma("unroll") for(int r=0;r<16;++r){P0[r]=fsub_s(P0[r],dl);P1[r]=fsub_s(P1[r],dl);} \
      _Pragma("unroll") for(int r=0;r<16;++r)negm[r]=-mhat; asm volatile("":"+v"(negm)); } \
    _Pragma("unroll") for(int r=0;r<16;++r)P0[r]=__builtin_amdgcn_exp2f(P0[r]); }while(0)
  #define RESC() do{ if(resc){ asm volatile("s_waitcnt lgkmcnt(0)":::"memory"); \
      _Pragma("unroll") for(int d_=0;d_<2;++d_) _Pragma("unroll") for(int r=0;r<16;++r)o[d_][r]*=wsf[crow(r,hi)]; } }while(0)
  f32x16 pA0,pA1,pB0,pB1;
  int sl_prev=0,sl_cur=0,sl_next=SLOTB;
  #define ROT() do{sl_prev=sl_cur;sl_cur=sl_next;sl_next=(sl_next==(NSLOT-1)*SLOTB)?0:sl_next+SLOTB;}while(0)
  DMA_K(2,2*SLOTB);
  WAIT_BAR(3);
  qkt(pA0,pA1,Kbase,qr,negm,r32,hi);asm volatile("s_nop 15\n\ts_nop 7":"+v"(pA0),"+v"(pA1));CMASK(pA0,pA1,0);
  START(pA0,pA1);
  _Pragma("unroll") for(int r=0;r<16;++r)pA1[r]=__builtin_amdgcn_exp2f(pA1[r]);
  WAIT_BAR(0);
  DMA_K(3,0);DMA_V(1,SLOTB);
  ROT();
  kload8(kf,kp0+sl_cur);
  WAIT_BAR(2);
  s16x4 vlo[8],vhi[8]; u32x4 pw0,pw1,pw2,pw3;
  #define PKW(P,B) cvtpk_s(P[B],P[B+1])
  #define PAF(k) __builtin_bit_cast(bf16x8,pw##k)
  #define VFR(i) (bf16x8){vlo[i][0],vlo[i][1],vlo[i][2],vlo[i][3],vhi[i][0],vhi[i][1],vhi[i][2],vhi[i][3]}
  #define PIN(x) asm volatile("":"+v"(x))
  #define MX3(a,b,c) __builtin_fmaxf(__builtin_fmaxf((a),(b)),(c))
  #define GAPA(MF,A0,A1,A2,A3,W0,W1,PW) do{ MF; sacc+=A0; sacc+=A1; sacc+=A2; sacc+=A3; PIN(sacc); W0; W1; PIN(PW); SBAR(); }while(0)
  #define EX(v) __builtin_amdgcn_exp2f(v)
  #define GAPB(MF,X,B) do{ MF; X[B]=EX(X[B]); X[B+1]=EX(X[B+1]); X[B+2]=EX(X[B+2]); X[B+3]=EX(X[B+3]); PIN(X); SBAR(); }while(0)
  #define VRD(i) do{ vlo[i]=vtr(vp_+(((i)>>2)*4096+((i)&3)*1024)); vhi[i]=vtr(vp_+(((i)>>2)*4096+((i)&3)*1024+512)); }while(0)
  #define KRD(G,j) do{ if(G){ kload2(kf,kp0+sl_next,j); SBAR(); } }while(0)
  #define STEP(C0,C1,P0,P1,t,GK,GV,GL) do{ SBAR(); \
    const lds_cptr vp_=vp0+sl_prev; \
    VRD(0); SBAR(); float sacc=(P0[0]+P0[1]); \
    GAPA(C0=__builtin_amdgcn_mfma_f32_32x32x16_bf16(kf[0],qr[0],negm,0,0,0), P0[2],P0[3],P0[4],P0[5],     pw0[0]=PKW(P0,0), pw0[1]=PKW(P0,2), pw0); \
    VRD(4); SBAR(); GAPA(C1=__builtin_amdgcn_mfma_f32_32x32x16_bf16(kf[1],qr[0],negm,0,0,0), P0[6],P0[7],P0[8],P0[9],     pw0[2]=PKW(P0,4), pw0[3]=PKW(P0,6), pw0); \
    VRD(1); SBAR(); GAPA(C0=__builtin_amdgcn_mfma_f32_32x32x16_bf16(kf[2],qr[1],C0,0,0,0),   P0[10],P0[11],P0[12],P0[13], pw1[0]=PKW(P0,8), pw1[1]=PKW(P0,10), pw1); \
    VRD(5); SBAR(); GAPA(C1=__builtin_amdgcn_mfma_f32_32x32x16_bf16(kf[3],qr[1],C1,0,0,0),   P0[14],P0[15],P1[0],P1[1],   pw1[2]=PKW(P0,12),pw1[3]=PKW(P0,14), pw1); \
    VRD(2); SBAR(); GAPA(C0=__builtin_amdgcn_mfma_f32_32x32x16_bf16(kf[4],qr[2],C0,0,0,0),   P1[2],P1[3],P1[4],P1[5],     pw2[0]=PKW(P1,0), pw2[1]=PKW(P1,2), pw2); \
    VRD(6); SBAR(); GAPA(C1=__builtin_amdgcn_mfma_f32_32x32x16_bf16(kf[5],qr[2],C1,0,0,0),   P1[6],P1[7],P1[8],P1[9],     pw2[2]=PKW(P1,4), pw2[3]=PKW(P1,6), pw2); \
    VRD(3); SBAR(); GAPA(C0=__builtin_amdgcn_mfma_f32_32x32x16_bf16(kf[6],qr[3],C0,0,0,0),   P1[10],P1[11],P1[12],P1[13], pw3[0]=PKW(P1,8), pw3[1]=PKW(P1,10), pw3); \
    VRD(7); SBAR(); GAPA(C1=__builtin_amdgcn_mfma_f32_32x32x16_bf16(kf[7],qr[3],C1,0,0,0),   P1[14],P1[15],0.f,0.f,       pw3[2]=PKW(P1,12),pw3[3]=PKW(P1,14), pw3); \
    l_reg+=sacc; \
    if(GK){DMA_K((t)+3,sl_cur);} if(GV){DMA_V((t)+1,sl_next);} \
    CMASK(C0,C1,t); \
    { float a=MX3(C0[0],C0[1],C1[0]),b=MX3(C0[2],C0[3],C1[1]); a=MX3(a,C1[2],C1[3]); \
      _Pragma("unroll") for(int r=4;r<16;r+=4){a=MX3(a,C0[r],C0[r+1]);b=MX3(b,C0[r+2],C0[r+3]);a=MX3(a,C1[r],C1[r+1]);b=MX3(b,C1[r+2],C1[r+3]);} \
      float rm=__builtin_fmaxf(a,b); { auto rr=__builtin_amdgcn_permlane32_swap(__float_as_uint(rm),__float_as_uint(rm),false,false); rm=__builtin_fmaxf(__uint_as_float(rr[0]),__uint_as_float(rr[1])); } \
      resc=false; \
      if(__builtin_expect(__any(rm>(float)THRL),0)){ const float dl=__builtin_fmaxf(rm,0.f); mhat+=dl; \
        _Pragma("unroll") for(int r=0;r<16;++r){C0[r]-=dl;C1[r]-=dl;} \
        _Pragma("unroll") for(int r=0;r<16;++r)negm[r]=-mhat; asm volatile("":"+v"(negm)); \
        const float f=__builtin_amdgcn_exp2f(-dl); l_reg*=f; if(hi==0)wsf[r32]=f; resc=true; } } \
    SBAR(); \
    GAPB(o[0]=__builtin_amdgcn_mfma_f32_32x32x16_bf16(PAF(0),VFR(0),o[0],0,0,0), C0,0); \
    GAPB(o[1]=__builtin_amdgcn_mfma_f32_32x32x16_bf16(PAF(0),VFR(4),o[1],0,0,0), C0,4); \
    KRD(GL,0); GAPB(o[0]=__builtin_amdgcn_mfma_f32_32x32x16_bf16(PAF(1),VFR(1),o[0],0,0,0), C0,8); \
    KRD(GL,1); GAPB(o[1]=__builtin_amdgcn_mfma_f32_32x32x16_bf16(PAF(1),VFR(5),o[1],0,0,0), C0,12); \
    KRD(GL,2); GAPB(o[0]=__builtin_amdgcn_mfma_f32_32x32x16_bf16(PAF(2),VFR(2),o[0],0,0,0), C1,0); \
    KRD(GL,3); GAPB(o[1]=__builtin_amdgcn_mfma_f32_32x32x16_bf16(PAF(2),VFR(6),o[1],0,0,0), C1,4); \
    GAPB(o[0]=__builtin_amdgcn_mfma_f32_32x32x16_bf16(PAF(3),VFR(3),o[0],0,0,0), C1,8); \
    GAPB(o[1]=__builtin_amdgcn_mfma_f32_32x32x16_bf16(PAF(3),VFR(7),o[1],0,0,0), C1,12); \
    }while(0)
  int t=1;
  #undef CMASK
  #define CMASK(P0,P1,t) do{}while(0)
  for(;t+5<NT;t+=2){
    STEP(pB0,pB1,pA0,pA1,t,true,true,true);     WAIT_BAR(2); RESC(); ROT();
    STEP(pA0,pA1,pB0,pB1,t+1,true,true,true);   WAIT_BAR(2); RESC(); ROT();
  }
  #undef CMASK
  #define CMASK(P0,P1,t) do{int jb_=(t)-(NT-4); if(jb_>=0)cmask(P0,P1,jb_,qrel,hi);}while(0)
  #define ENDW(tt) do{ if((tt)+3<NT){WAIT_BAR(2);} else if((tt)+2<NT){WAIT_BAR(1);} else {WAIT_BAR(0);} }while(0)
  for(;t+1<NT;t+=2){
    STEP(pB0,pB1,pA0,pA1,t,(t+3<NT),(t+1<NT),(t+1<NT));       ENDW(t);   RESC(); ROT();
    STEP(pA0,pA1,pB0,pB1,t+1,(t+4<NT),(t+2<NT),(t+2<NT));     ENDW(t+1); RESC(); ROT();
  }
  STEP(pB0,pB1,pA0,pA1,NT-1,false,false,false); RESC();
  { float sacc=pB0[0]+pB0[1]; _Pragma("unroll") for(int r=2;r<16;++r)sacc+=pB0[r]; _Pragma("unroll") for(int r=0;r<16;++r)sacc+=pB1[r]; l_reg+=sacc;
    pw0=(u32x4){PKW(pB0,0),PKW(pB0,2),PKW(pB0,4),PKW(pB0,6)};pw1=(u32x4){PKW(pB0,8),PKW(pB0,10),PKW(pB0,12),PKW(pB0,14)};pw2=(u32x4){PKW(pB1,0),PKW(pB1,2),PKW(pB1,4),PKW(pB1,6)};pw3=(u32x4){PKW(pB1,8),PKW(pB1,10),PKW(pB1,12),PKW(pB1,14)};
    SBAR(); pv(o,vb0+sl_cur,PAF(0),PAF(1),PAF(2),PAF(3)); }
  #undef PKW
  #undef PAF
  #undef VFR
  #undef PIN
  #undef MX3
  #undef GAPA
  #undef GAPB
  #undef EX
  #undef VRD
  #undef KRD
  #undef STEP
  #undef ENDW
  {auto rr=__builtin_amdgcn_permlane32_swap(__float_as_uint(l_reg),__float_as_uint(l_reg),false,false);l_reg=__uint_as_float(rr[0])+__uint_as_float(rr[1]);}
  if(hi==0)wsf[32+r32]=l_reg;asm volatile("s_waitcnt lgkmcnt(0)":::"memory");
  float rli[16];
  #pragma unroll
  for(int r=0;r<16;++r)rli[r]=__builtin_amdgcn_rcpf(wsf[32+crow(r,hi)]);
  bf16*Ow=O+(rowbase+q0+wid*QBLK)*DM+hv*D;
  { bf16*stg=(bf16*)(shm+LDS_OST)+wid*2048;
    #pragma unroll
    for(int r=0;r<16;++r){const int orow=crow(r,hi);
      #pragma unroll
      for(int d0=0;d0<2;++d0)stg[orow*64+d0*32+r32]=__float2bfloat16(o[d0][r]*rli[r]);}
    asm volatile("s_waitcnt lgkmcnt(0)":::"memory");
    #pragma unroll
    for(int i=0;i<4;++i){const int row=i*8+(lane>>3),ch=lane&7; const u32x4 v=*(const u32x4*)(stg+row*64+ch*8); ATTN_STORE16(Ow+(long)row*DM+ch*8,v);} }
  asm volatile("s_waitcnt lgkmcnt(0)\n\ts_barrier":::"memory");
  #undef DMA_K
  #undef DMA_V
  #undef CMASK
  #undef START
  #undef RESC
  #undef ROT
}
constexpr int ATTN_LDS_BYTES=LDS_BYTES;
#undef SBAR
#undef WAIT_BAR
}

#define ACC8(v, A_, ai, bj, m) float v[8] = {A_[ai][bj][m][0][0], A_[ai][bj][m][0][1], A_[ai][bj][m][0][2], A_[ai][bj][m][0][3], A_[ai][bj][m][1][0], A_[ai][bj][m][1][1], A_[ai][bj][m][1][2], A_[ai][bj][m][1][3]}
struct EpiProjFast { static constexpr bool PERM = true, MID = false; const Frame* F;
    static constexpr float PSC = PROJ_FP8 ? W8I : 1.0f;
    __device__ __forceinline__ void operator()(const f32x4 (&acc)[2][2][4][2], const fg::Unit& u, int wr, int wc, int fr, int fq) const {
        const int row0 = u.pm * 256 + wr * 64 + fr, col0 = u.pn * 256 + wc * 32 + 8 * fq;
        const int sec = u.pn >> 2;
        if (sec == 1) {
            const float* lb = wsp<const float>(*F, WS_LB) + (col0 - 1024);
            f32x4 l4[2][2];
#pragma unroll
            for (int bj = 0; bj < 2; ++bj) { l4[bj][0] = *(const f32x4*)(lb + bj * 128); l4[bj][1] = *(const f32x4*)(lb + bj * 128 + 4); }
#pragma unroll
            for (int ai = 0; ai < 2; ++ai)
#pragma unroll
                for (int m = 0; m < 4; ++m)
#pragma unroll
                    for (int bj = 0; bj < 2; ++bj) {
                        f32x4 o[2];
#pragma unroll
                        for (int n = 0; n < 2; ++n)
#pragma unroll
                            for (int i = 0; i < 4; ++i) { const float l = l4[bj][n][i]; o[n][i] = __logf(l + (1.0f - l) * sigmoidf_(acc[ai][bj][m][n][i] * PSC)); }
                        float* op = wsp<float>(*F, WS_LOGF) + (size_t)(row0 + ai * 128 + m * 16) * HW + (col0 - 1024) + bj * 128;
                        *(f32x4*)op = o[0]; *(f32x4*)(op + 4) = o[1];
                    }
        } else if (sec == 4 || sec == 5) {
            const bool ropel = ((wc & 1) == 0) && (fq < 2);
            const float sg = (fq == 0) ? -1.0f : 1.0f;
            bf16* dst = wsp<bf16>(*F, sec == 4 ? WS_QDA : WS_KDA); const int cb = col0 - (sec == 4 ? 4096 : 5120);
            const float scl = (sec == 4 ? QSCALE : 1.0f) * PSC;
#pragma unroll
            for (int am = 0; am < 4; ++am) {
                const int ai = am >> 1, mb = (am & 1) * 2;
                f32x4 rt[2][4];
#pragma unroll
                for (int mm = 0; mm < 2; ++mm) { const float* rp = wsp<const float>(*F, WS_ROPE) + (size_t)((row0 + ai * 128 + (mb + mm) * 16) & (SEQ - 1)) * 16;
#pragma unroll
                    for (int q = 0; q < 4; ++q) rt[mm][q] = *(const f32x4*)(rp + 4 * q); }
#pragma unroll
                for (int mm = 0; mm < 2; ++mm)
#pragma unroll
                    for (int bj = 0; bj < 2; ++bj) {
                        const int m = mb + mm;
                        ACC8(v, acc, ai, bj, m);
                        float pv[8];
#pragma unroll
                        for (int i = 0; i < 8; ++i) pv[i] = __shfl_xor(v[i], 16);
#pragma unroll
                        for (int i = 0; i < 8; ++i) { const float cs = ropel ? rt[mm][i >> 2][i & 3] : 1.0f, sn = ropel ? sg * rt[mm][2 + (i >> 2)][i & 3] : 0.0f; v[i] = v[i] * cs + pv[i] * sn; }
#pragma unroll
                        for (int i = 0; i < 8; ++i) v[i] *= scl;
                        store8_bf16(dst + (size_t)(row0 + ai * 128 + m * 16) * HW + cb + bj * 128, v);
                    }
            }
        } else {
#pragma unroll
            for (int ai = 0; ai < 2; ++ai)
#pragma unroll
                for (int m = 0; m < 4; ++m)
#pragma unroll
                    for (int bj = 0; bj < 2; ++bj) { ACC8(v, acc, ai, bj, m);
#pragma unroll
                        for (int i = 0; i < 8; ++i) v[i] *= PSC;
                        proj_store8(*F, row0 + ai * 128 + m * 16, col0 + bj * 128, v, 16); }
        }
    } };
__device__ __forceinline__ void ph_proj_fast(Frame& F) {
#if PROJ_FP8
    fg::DenseOrderT<true> S; S.init(wsp<const bf16>(F, WS_H1), wsp<const bf16>(F, WS_WIN_T), T, INC, DM / 2, F.G, F.bid);
    EpiProjFast E{&F};
    fg::gemm_phase(F.lds, DM / 2, S, E);
#else
    fg::DenseOrder S; S.init(wsp<const bf16>(F, WS_H1), wsp<const bf16>(F, WS_WIN_T), T, INC, DM, F.G, F.bid);
    EpiProjFast E{&F};
    fg::gemm_phase(F.lds, DM, S, E);
#endif
}
struct EpiBranchFast { static constexpr bool PERM = true, MID = true; const Frame* F;
    __device__ __forceinline__ void mid(f32x4 (&acc)[2][2][4][2], const fg::Unit& u, int wr, int wc, int fr, int fq) const {
        int row0 = u.pm * 256 + wr * 64 + fr, col0 = u.pn * 256 + wc * 32 + 8 * fq;
        asm volatile("" : "+v"(row0), "+v"(col0));
        const bf16* GH = wsp<const bf16>(*F, WS_GATEH); const bf16* GD = wsp<const bf16>(*F, WS_GATED);
#pragma unroll
        for (int ai = 0; ai < 2; ++ai) {
            u32x4 gh2[2][4], gd2[2][4];
#pragma unroll
            for (int bj = 0; bj < 2; ++bj)
#pragma unroll
                for (int m = 0; m < 4; ++m) { const size_t off = (size_t)(row0 + ai * 128 + m * 16) * DM + col0 + bj * 128; gh2[bj][m] = *(const u32x4*)(GH + off); gd2[bj][m] = *(const u32x4*)(GD + off); }
#pragma unroll
            for (int bj = 0; bj < 2; ++bj) {
#pragma unroll
                for (int m = 0; m < 4; ++m) {
                    const unsigned hh[4] = {gh2[bj][m].x, gh2[bj][m].y, gh2[bj][m].z, gh2[bj][m].w}, dd[4] = {gd2[bj][m].x, gd2[bj][m].y, gd2[bj][m].z, gd2[bj][m].w};
#pragma unroll
                    for (int i = 0; i < 4; ++i) {
                        const float r0 = bf2f(hh[i] & 0xffffu) * __builtin_amdgcn_rcpf(fmaxf(bf2f(dd[i] & 0xffffu), 1e-30f));
                        const float r1 = bf2f(hh[i] >> 16) * __builtin_amdgcn_rcpf(fmaxf(bf2f(dd[i] >> 16), 1e-30f));
                        acc[ai][bj][m][i >> 1][(i & 1) * 2] *= r0; acc[ai][bj][m][i >> 1][(i & 1) * 2 + 1] *= r1;
                    }
                }
            }
            asm volatile("" ::: "memory");
        }
    }
    __device__ __forceinline__ void operator()(const f32x4 (&acc)[2][2][4][2], const fg::Unit& u, int wr, int wc, int fr, int fq) const {
        const int row0 = u.pm * 256 + wr * 64 + fr, col0 = u.pn * 256 + wc * 32 + 8 * fq;
        const bf16* GD = wsp<const bf16>(*F, WS_GATED);
        u32x4 gda[2][4][2];
#pragma unroll
        for (int ai = 0; ai < 2; ++ai)
#pragma unroll
            for (int m = 0; m < 4; ++m)
#pragma unroll
                for (int bj = 0; bj < 2; ++bj) gda[ai][m][bj] = *(const u32x4*)(GD + (size_t)(row0 + ai * 128 + m * 16) * DM + col0 + bj * 128);
#pragma unroll
        for (int ai = 0; ai < 2; ++ai) {
#pragma unroll
            for (int m = 0; m < 4; ++m)
#pragma unroll
                for (int bj = 0; bj < 2; ++bj) {
                    const u32x4 g = gda[ai][m][bj]; const f32x4 a0 = acc[ai][bj][m][0], a1 = acc[ai][bj][m][1];
                    float o[8] = {a0[0] * bf2f(g.x & 0xffffu), a0[1] * bf2f(g.x >> 16), a0[2] * bf2f(g.y & 0xffffu), a0[3] * bf2f(g.y >> 16),
                                  a1[0] * bf2f(g.z & 0xffffu), a1[1] * bf2f(g.z >> 16), a1[2] * bf2f(g.w & 0xffffu), a1[3] * bf2f(g.w >> 16)};
                    store8_bf16(wsp<bf16>(*F, WS_MERGED) + (size_t)(row0 + ai * 128 + m * 16) * DM + col0 + bj * 128, o);
                }
        }
    } };
__device__ __forceinline__ void ph_branch_fast(Frame& F) {
    fg::DenseOrder S; S.init(wsp<const bf16>(F, WS_YCAT), wsp<const bf16>(F, WS_WBH_T), T, DM, DM, F.G, F.bid);
    EpiBranchFast E{&F};
    fg::gemm_phase(F.lds, DM, S, E);
}
struct EpiUFast { static constexpr bool PERM = true, MID = false; const Frame* F;
    __device__ __forceinline__ void operator()(const f32x4 (&acc)[2][2][4][2], const fg::Unit& u, int wr, int wc, int fr, int fq) const {
        const int row0 = u.pm * 256 + wr * 64 + fr, col0 = u.pn * 256 + wc * 32 + 8 * fq;
#pragma unroll
        for (int ai = 0; ai < 2; ++ai)
#pragma unroll
            for (int m = 0; m < 4; ++m)
#pragma unroll
                for (int bj = 0; bj < 2; ++bj) { ACC8(v, acc, ai, bj, m); store8_bf16(wsp<bf16>(*F, WS_U) + (size_t)(row0 + ai * 128 + m * 16) * DM + col0 + bj * 128, v); }
    } };
__device__ __forceinline__ void ph_wout_fast(Frame& F) {
    fg::DenseOrder S; S.init(wsp<const bf16>(F, WS_MERGED), wsp<const bf16>(F, WS_WOUT_T), T, DM, DM, F.G, F.bid);
    EpiUFast E{&F};
    fg::gemm_phase(F.lds, DM, S, E);
}
struct Args;
typedef const __attribute__((address_space(4))) Args* CArgs;
constexpr int TU_L = 2, TU_M = 40 - TU_L;
constexpr int N_TU_LATE = NE * TU_L, N_TU_MIX = NE * TU_M;
__device__ __forceinline__ void t_unit(CArgs A, int e, int r);
__device__ __forceinline__ int q_claim(CArgs A, int ctr);
template <bool GATHER_, bool IDENT_ = false> struct MoeOrder {
    static constexpr bool GATHER = GATHER_, FP8 = true;
    const LAS int* tab; int G, c; const char* A; const char* Bt; int K; size_t bstride; const int* list;
    __device__ __forceinline__ bool next(int i, fg::Unit& u) const {
        const int q = i * (G >> 3) + (c >> 3), x = c & 7;
        const int mtg = 2 * (q >> 1) + (x >> 2), pn = 2 * (x & 3) + (q & 1);
        if (mtg >= tab[72 + NE]) return false;
        int e = 0;
#pragma unroll 1
        for (int k = 1; k < NE; ++k) if (tab[72 + k] <= mtg) e = k;
        const int mt = mtg - tab[72 + e];
        u.pm = mt; u.pn = pn; u.e = e; u.nvalid = min(256, tab[e] - mt * 256); u.slot0 = tab[32 + e] + mt * 256; return true;
    }
    __device__ __forceinline__ const char* a_ptr(const fg::Unit& u) const { return GATHER ? A : A + (size_t)u.slot0 * K * 2; }
    __device__ __forceinline__ int a_row(const fg::Unit& u, int r) const { if constexpr (IDENT_) return u.slot0 + r; else return r < u.nvalid ? list[u.e * 16384 + u.pm * 256 + r] : 0; }
    __device__ __forceinline__ const char* b_ptr(const fg::Unit& u) const { return Bt + (size_t)u.e * bstride + (size_t)u.pn * 256 * K * 2; }
};
struct EpiMoe1Fast { static constexpr bool PERM = true, MID = false; const Frame* F;
    __device__ __forceinline__ void operator()(const f32x4 (&acc)[2][2][4][2], const fg::Unit& u, int wr, int wc, int fr, int fq) const {
        const int col0 = u.pn * 128 + wc * 32 + 8 * fq;
#pragma unroll
        for (int ai = 0; ai < 2; ++ai)
#pragma unroll
            for (int m = 0; m < 4; ++m) {
                const int r = ai * 128 + wr * 64 + m * 16 + fr;
                ACC8(g, acc, ai, 0, m); ACC8(up, acc, ai, 1, m);
                float o[8];
#pragma unroll
                for (int i = 0; i < 8; ++i) { const float gs = g[i] * W8I; o[i] = clamp8(gs * sigmoidf_(gs) * (up[i] * W8I)); }
                if (r < u.nvalid) { u32x2 p; p.x = pk4_fp8(o[0], o[1], o[2], o[3]); p.y = pk4_fp8(o[4], o[5], o[6], o[7]); *(u32x2*)(wsp<unsigned char>(*F, WS_ACT) + (size_t)(u.slot0 + r) * DE + col0) = p; }
            }
    } };
struct EpiMoe2Fast { static constexpr bool PERM = true, MID = false; const Frame* F;
    __device__ __forceinline__ void operator()(const f32x4 (&acc)[2][2][4][2], const fg::Unit& u, int wr, int wc, int fr, int fq) const {
        const int col0 = u.pn * 256 + wc * 32 + 8 * fq;
        unsigned char* YW8 = wsp<unsigned char>(*F, WS_YW);
#pragma unroll
        for (int ai = 0; ai < 2; ++ai)
#pragma unroll
            for (int m = 0; m < 4; ++m) {
                const int r = ai * 128 + wr * 64 + m * 16 + fr;
                const bool ok = r < u.nvalid;
#pragma unroll
                for (int bj = 0; bj < 2; ++bj) { ACC8(v, acc, ai, bj, m);
#pragma unroll
                    for (int i = 0; i < 8; ++i) v[i] = clamp8(v[i] * (W8I * Y8S));
                    if (ok) { u32x2 p; p.x = pk4_fp8(v[0], v[1], v[2], v[3]); p.y = pk4_fp8(v[4], v[5], v[6], v[7]); *(u32x2*)(YW8 + (size_t)(u.slot0 + r) * DM + col0 + bj * 128) = p; } }
            }
    } };
__device__ __forceinline__ void ph_moe1_fast(Frame& F, CArgs A) {
    LAS int* tab = (LAS int*)(F.lds + 131072);
    expert_tables(F, tab, 256);
    MoeOrder<true> S{tab, F.G, F.bid, (const char*)wsp<const bf16>(F, WS_H2), (const char*)wsp<const bf16>(F, WS_WGU_T), DM / 2, (size_t)2048 * DM, wsp<const int>(F, WS_LISTTOK)};
    EpiMoe1Fast E{&F};
    fg::gemm_phase(F.lds, DM / 2, S, E);
    for (;;) {
        const int j = q_claim(A, CW_TQ + 64);
        if (j >= N_TU_LATE) break;
        t_unit(A, j / TU_L, 32 + j % TU_L);
    }
}
__device__ __forceinline__ void ph_moe2_fast(Frame& F) {
    LAS int* tab = (LAS int*)(F.lds + 131072);
    expert_tables(F, tab, 256);
    MoeOrder<true, true> S{tab, F.G, F.bid, (const char*)wsp<const bf16>(F, WS_ACT), (const char*)wsp<const bf16>(F, WS_WD_T), DE / 2, (size_t)DM * DE, nullptr};
    EpiMoe2Fast E{&F};
    fg::gemm_phase(F.lds, DE / 2, S, E);
}

struct Args { const float* in[26]; float* out; unsigned char* ws; int ph_lo, ph_hi; };
__device__ __forceinline__ void t_unit(CArgs A, int e, int r) {
    asm volatile("" : "+s"(A));
    int t_ = threadIdx.x; asm volatile("" : "+v"(t_));
    const int lane = t_ & 63, wave = __builtin_amdgcn_readfirstlane(t_ >> 6);
    unsigned char* ws = A->ws;
    f32x4 t0[8], t1[8], t2[8], t3[8];
#define T_LOADP(ta, tb, RS, N, k0, n0) do { const int vo_ = ((16 * (lane >> 3)) * (N) + (n0) + 4 * (lane & 7)) * 4; \
        _Pragma("unroll") for (int i = 0; i < 8; ++i) ta[i] = __builtin_bit_cast(f32x4, __builtin_amdgcn_raw_buffer_load_b128(RS, vo_, ((k0) + i) * (N) * 4, 2)); \
        _Pragma("unroll") for (int i = 0; i < 8; ++i) tb[i] = __builtin_bit_cast(f32x4, __builtin_amdgcn_raw_buffer_load_b128(RS, vo_, ((k0) + 8 + i) * (N) * 4, 2)); } while (0)
#define T_STOREP8(ta, tb, WT, K, k0, drow) do { _Pragma("unroll") for (int j = 0; j < 4; ++j) { u32x4 o_; \
        o_.x = pk4_fp8(ta[0][j] * W8S, ta[1][j] * W8S, ta[2][j] * W8S, ta[3][j] * W8S); o_.y = pk4_fp8(ta[4][j] * W8S, ta[5][j] * W8S, ta[6][j] * W8S, ta[7][j] * W8S); \
        o_.z = pk4_fp8(tb[0][j] * W8S, tb[1][j] * W8S, tb[2][j] * W8S, tb[3][j] * W8S); o_.w = pk4_fp8(tb[4][j] * W8S, tb[5][j] * W8S, tb[6][j] * W8S, tb[7][j] * W8S); \
        *(u32x4*)((WT) + (size_t)((drow) + 4 * (lane & 7) + j) * (K) + (k0) + 16 * (lane >> 3)) = o_; } } while (0)
#define T_WAVE(W, N, WT, K, k0, n0, dr) do { \
        T_LOADP(t0, t1, W, N, k0, n0); T_LOADP(t2, t3, W, N, k0, (n0) + 32); \
        T_STOREP8(t0, t1, WT, K, k0, dr); T_LOADP(t0, t1, W, N, k0, (n0) + 64); \
        T_STOREP8(t2, t3, WT, K, k0, (dr) + 32); T_LOADP(t2, t3, W, N, k0, (n0) + 96); \
        T_STOREP8(t0, t1, WT, K, k0, (dr) + 64); T_STOREP8(t2, t3, WT, K, k0, (dr) + 96); } while (0)
    if (r < 32) {
        const int up = r >> 4, k0 = (r & 15) * 128;
        const float* Wp = (up ? A->in[24] : A->in[23]) + (size_t)e * DM * DE; unsigned char* WT = ws + WS_WGU_T + (size_t)e * 2048 * DM;
        const __amdgpu_buffer_rsrc_t W = __builtin_amdgcn_make_buffer_rsrc((void*)Wp, 0, DM * DE * 4, 0x00020000);
        const int n0 = wave * 128, dr = wave * 256 + up * 128;
        T_WAVE(W, DE, WT, DM, k0, n0, dr);
    } else {
        const int rr = r - 32, k0 = (rr >> 1) * 128, n0 = (rr & 1) * 1024 + wave * 128;
        const float* Wp = A->in[25] + (size_t)e * DE * DM; unsigned char* WT = ws + WS_WD_T + (size_t)e * DM * DE;
        const __amdgpu_buffer_rsrc_t W = __builtin_amdgcn_make_buffer_rsrc((void*)Wp, 0, DM * DE * 4, 0x00020000);
        T_WAVE(W, DM, WT, DE, k0, n0, n0);
    }
#undef T_WAVE
#undef T_LOADP
#undef T_STOREP8
}
__device__ __forceinline__ int q_claim(CArgs A, int ctr) {
    volatile LAS int* qslot = (volatile LAS int*)((LAS unsigned char*)0 + MISC_OFF + 64);
    __syncthreads();
    if (threadIdx.x == 0) *qslot = (int)__hip_atomic_fetch_add((unsigned*)(A->ws + WS_CTL) + ctr, 1u, RLX_AGENT);
    __syncthreads();
    return __builtin_amdgcn_readfirstlane(*qslot);
}
__device__ __forceinline__ int attn_claim(CArgs A, int base) {
    volatile LAS int* qslot = (volatile LAS int*)((LAS unsigned char*)0 + MISC_OFF + 64);
    __syncthreads();
    if (threadIdx.x == 0) {
        unsigned* q = (unsigned*)(A->ws + WS_CTL) + base;
        const unsigned x = xb_xcc_id() & 7u;
        int res = -1;
        unsigned j = __hip_atomic_fetch_add(q + 16 * x, 1u, RLX_AGENT);
        if (j < 256u) res = (int)(x * 256u + j);
        else {
            unsigned c[8];
#pragma unroll
            for (int k = 0; k < 8; ++k) c[k] = __hip_atomic_load(q + 16 * k, RLX_AGENT);
#pragma unroll 1
            for (unsigned k = 1; k < 8 && res < 0; ++k) { const unsigned s2 = (x + k) & 7u; bool live = false;
#pragma unroll
                for (int k2 = 0; k2 < 8; ++k2) live = live || ((unsigned)k2 == s2 && c[k2] < 256u);
                if (!live) continue;
                j = __hip_atomic_fetch_add(q + 16 * s2, 1u, RLX_AGENT);
                if (j < 256u) res = (int)(s2 * 256u + j); }
        }
        *qslot = res;
    }
    __syncthreads();
    return __builtin_amdgcn_readfirstlane(*qslot);
}
__device__ __forceinline__ void ph_mix_fast(Frame& F, CArgs A, char* lds_generic, int coff = 0) {
    constexpr float TPC = 1.25f * (float)N_TU_MIX / 55168.0f;
    float credit = (float)(F.bid & 3) * 0.5f; bool a_done = false, t_done = false;
    for (int ch = F.bid; ch < NB * NH; ch += F.G) { hgrn_chain_fast(F, ch); credit += 60.0f * TPC; }
    while (!(a_done && t_done)) {
        while (!t_done && (credit >= 1.0f || a_done)) {
            const int t = q_claim(A, CW_TQ + coff);
            if (t >= N_TU_MIX) { t_done = true; break; }
            { const int e = t / TU_M, rm = t % TU_M; t_unit(A, e, rm < 32 ? rm : rm + TU_L); } credit -= 1.0f;
        }
        if (!a_done) {
            const int a = attn_claim(A, coff ? 12288 : CW_ATTQ);
            if (a < 0) { a_done = true; continue; }
            const int sq = a >> 8, jq = a & 255, wq = jq & 63, pr = sq * 8 + 2 * (jq >> 6) + ((wq >> 2) & 1);
            const int qb = 7 - (wq >> 3), b = pr >> 3, h = pr & 7, m = (wq >> 1) & 1, vhalf = wq & 1;
            unsigned char* ws = A->ws;
            attn_body::attn_unit<8>(b, 2 * h + m, 2 * h + vhalf, qb, (const attn_body::bf16*)(ws + WS_QDA), (const attn_body::bf16*)(ws + WS_KDA), (const attn_body::bf16*)(ws + WS_VDA),
                                    (attn_body::bf16*)(ws + (m ? WS_O2 : WS_O1)), lds_generic);
            credit += (float)(4 * qb + 7) * TPC;
        }
    }
    __syncthreads();
}
__device__ __forceinline__ void ph_transposes(Frame& F) {
    LAS float* scr = (LAS float*)(F.lds + F.wave * 8704);
    const int gw = F.bid * NWAVES + F.wave, NGW = F.G * NWAVES;
    constexpr int I_IN = 32 * 352, I_BH = 16 * 64, I_OUT = 32 * 64, I_GE = 32 * 32, I_DE = 16 * 64;
    constexpr int NITEMS = I_IN + 2 * I_BH + I_OUT + (EXPERT_T_IN_MIX ? 0 : NE * (2 * I_GE + I_DE));
    for (int it = gw; it < NITEMS; it += NGW) {
        int r = it;
        if (r < I_IN) { const int kb = r / 352, nb = r % 352; transpose_item<PROJ_FP8 != 0>(F.w_in, DM, INC, wsp<bf16>(F, WS_WIN_T), kb * 64, nb * 32, nb * 32, scr, F.lane); continue; } r -= I_IN;
        if (r < I_BH) { const int kb = r / 64, nb = r % 64; transpose_item(F.w_bhg, HW, DM, wsp<bf16>(F, WS_WBH_T), kb * 64, nb * 32, nb * 32, scr, F.lane, DM, 0); continue; } r -= I_BH;
        if (r < I_BH) { const int kb = r / 64, nb = r % 64; transpose_item(F.w_bda, HW, DM, wsp<bf16>(F, WS_WBH_T), kb * 64, nb * 32, nb * 32, scr, F.lane, DM, HW); continue; } r -= I_BH;
        if (r < I_OUT) { const int kb = r / 64, nb = r % 64; transpose_item(F.w_out, DM, DM, wsp<bf16>(F, WS_WOUT_T), kb * 64, nb * 32, nb * 32, scr, F.lane); continue; } r -= I_OUT;
        const int e = r / (2 * I_GE + I_DE); r -= e * (2 * I_GE + I_DE);
        if (r < 2 * I_GE) { const int up = r >= I_GE ? 1 : 0; r -= up * I_GE; const int kb = r / 32, nb = r % 32;
            transpose_item((up ? F.w_up : F.w_gate) + (size_t)e * DM * DE, DM, DE, wsp<bf16>(F, WS_WGU_T) + (size_t)e * 2048 * DM, kb * 64, nb * 32, (nb >> 2) * 256 + up * 128 + (nb & 3) * 32, scr, F.lane); continue; }
        r -= 2 * I_GE;
        { const int kb = r / 64, nb = r % 64; transpose_item(F.w_down + (size_t)e * DE * DM, DE, DM, wsp<bf16>(F, WS_WD_T) + (size_t)e * DM * DE, kb * 64, nb * 32, nb * 32, scr, F.lane); }
    }
}

__global__ void __launch_bounds__(NTHREADS, 2) mk_fwd(Args args) {
    extern __shared__ __attribute__((aligned(16))) unsigned char lds[];
    Frame F;
    CArgs A = (CArgs)__builtin_amdgcn_kernarg_segment_ptr();
    F.lds = (LAS unsigned char*)lds;
    F.G = gridDim.x; F.bid = blockIdx.x;
#define ENTER() do { asm volatile("" : "+s"(A)); int t_ = threadIdx.x; asm volatile("" : "+v"(t_)); F.tid = t_; F.lane = t_ & 63; F.wave = __builtin_amdgcn_readfirstlane(t_ >> 6); \
    F.ws = A->ws; F.ctl = (gu32*)(F.ws + WS_CTL); F.out = A->out; \
    F.x = A->in[0]; F.c = A->in[1]; F.w_ada = A->in[2]; F.b_ada = A->in[3]; F.pre_mix = A->in[4]; F.post_mix = A->in[5]; F.pre_ffn = A->in[6]; F.post_ffn = A->in[7]; \
    F.w_in = A->in[8]; F.hg_lb = A->in[9]; F.hg_nw = A->in[10]; F.lq1 = A->in[11]; F.lk1 = A->in[12]; F.lq2 = A->in[13]; F.lk2 = A->in[14]; F.da_nw = A->in[15]; \
    F.w_bhg = A->in[16]; F.w_bda = A->in[17]; F.w_out = A->in[18]; F.w_group = A->in[19]; F.b_group = A->in[20]; F.w_router = A->in[21]; F.b_router = A->in[22]; \
    F.w_gate = A->in[23]; F.w_up = A->in[24]; F.w_down = A->in[25]; } while (0)
    ENTER();
    volatile LAS unsigned* MISC = (volatile LAS unsigned*)(F.lds + MISC_OFF);
    for (int u = F.tid; u < (LDS_BYTES - LDSCTL_OFF) / 4; u += NTHREADS) ((LAS unsigned*)(F.lds + LDSCTL_OFF))[u] = 0u;
    __syncthreads();
    const int lo = A->ph_lo, hi = A->ph_hi;
    XcdBarrier bar; bar.bar = (unsigned*)(F.ctl + CW_BAR); bar.x = 0; bar.st = nullptr;
    if (hi - lo > 1) bar = xcd_barrier_post((unsigned*)(F.ctl + CW_BAR), MISC + 8);
#define IN(k) (lo <= (k) && (k) < hi)
#define SEAM(k) do { if (IN(k) && IN((k) + 1)) xcd_barrier(bar); } while (0)
    if (IN(PH_PRO)) { ENTER(); ph_prologue(F); }
    if (PROBE_DUP == 100) { xcd_barrier(bar); ENTER(); ph_prologue(F); xcd_barrier(bar); }
#if FAST_GEMM
    if (IN(PH_PRO)) { ENTER(); ph_transposes(F); }
    if (PROBE_DUP == PH_PRO) { xcd_barrier(bar); ENTER(); ph_transposes(F); }
#endif
    SEAM(PH_PRO);
    if (IN(PH_MOD)) { ENTER(); ph_mod(F); } SEAM(PH_MOD);
    if (IN(PH_H1)) { ENTER(); ph_h1(F); }
    if (PROBE_DUP == PH_H1) { xcd_barrier(bar); ENTER(); ph_h1(F); }
    SEAM(PH_H1);
#if FAST_GEMM
    if (IN(PH_PROJ)) { ENTER(); ph_proj_fast(F); }
    if (PROBE_DUP == PH_PROJ) { xcd_barrier(bar); ENTER(); ph_proj_fast(F); }
    SEAM(PH_PROJ);
#else
    if (IN(PH_PROJ)) { ENTER(); ph_proj_simple(F); } SEAM(PH_PROJ);
#endif
#if FAST_ATTN
    if (IN(PH_MIX)) { ENTER(); ph_mix_fast(F, A, (char*)lds); }
    if (PROBE_DUP == PH_MIX) { xcd_barrier(bar); ENTER(); ph_mix_fast(F, A, (char*)lds, 32); }
    SEAM(PH_MIX);
#else
    if (IN(PH_MIX)) { ENTER(); ph_mix_simple(F); } SEAM(PH_MIX);
#endif
    if (IN(PH_YDA)) { ENTER(); ph_yda(F); }
    if (PROBE_DUP == PH_YDA) { xcd_barrier(bar); ENTER(); ph_yda(F); }
    SEAM(PH_YDA);
#if FAST_GEMM
    if (IN(PH_BRANCH)) { ENTER(); ph_branch_fast(F); }
    if (PROBE_DUP == PH_BRANCH) { xcd_barrier(bar); ENTER(); ph_branch_fast(F); }
    SEAM(PH_BRANCH);
#else
    if (IN(PH_BRANCH)) { ENTER(); ph_branch_simple(F); } SEAM(PH_BRANCH);
#endif
#if FAST_GEMM
    if (IN(PH_WOUT)) { ENTER(); ph_wout_fast(F); }
    if (PROBE_DUP == PH_WOUT) { xcd_barrier(bar); ENTER(); ph_wout_fast(F); }
    SEAM(PH_WOUT);
#else
    if (IN(PH_WOUT)) { ENTER(); ph_wout_simple(F); } SEAM(PH_WOUT);
#endif
#if FAST_POST
    if (IN(PH_POST)) { ENTER(); ph_post_fast(F); } SEAM(PH_POST);
#else
    if (IN(PH_POST)) { ENTER(); ph_post(F); } SEAM(PH_POST);
#endif
#if FAST_GEMM
    if (IN(PH_MOE1)) { ENTER(); ph_moe1_fast(F, A); }
    if (PROBE_DUP == PH_MOE1) { xcd_barrier(bar); ENTER(); ph_moe1_fast(F, A); }
    SEAM(PH_MOE1);
#else
    if (IN(PH_MOE1)) { ENTER(); ph_moe1_simple(F); } SEAM(PH_MOE1);
#endif
#if FAST_GEMM
    if (IN(PH_MOE2)) { ENTER(); ph_moe2_fast(F); }
    if (PROBE_DUP == PH_MOE2) { xcd_barrier(bar); ENTER(); ph_moe2_fast(F); }
    SEAM(PH_MOE2);
#else
    if (IN(PH_MOE2)) { ENTER(); ph_moe2_simple(F); } SEAM(PH_MOE2);
#endif
    if (IN(PH_FINAL)) { ENTER(); ph_final(F); }
    if (PROBE_DUP == PH_FINAL) { xcd_barrier(bar); ENTER(); ph_final(F); }
#undef IN
#undef SEAM
}

extern "C" void kernel_launch(void* const* d_in, const int* in_sizes, int n_in, void* d_out, int out_size, void* d_ws, size_t ws_size, hipStream_t stream) {
    static int grid = 0;
    if (grid == 0) {
        if (n_in != 26 || out_size != T * DM || ws_size < WS_END) { fprintf(stderr, "kernel_launch: unexpected shapes (n_in %d out %d ws %zu)\n", n_in, out_size, ws_size); grid = -1; return; }
        int dev = 0, cus = 0, per_cu = 0;
        if (hipGetDevice(&dev) != hipSuccess || hipDeviceGetAttribute(&cus, hipDeviceAttributeMultiprocessorCount, dev) != hipSuccess) { grid = -1; return; }
        if (hipFuncSetAttribute((const void*)mk_fwd, hipFuncAttributeMaxDynamicSharedMemorySize, LDS_BYTES) != hipSuccess) { grid = -1; return; }
        if (hipOccupancyMaxActiveBlocksPerMultiprocessor(&per_cu, (const void*)mk_fwd, NTHREADS, LDS_BYTES) != hipSuccess || per_cu < 1) { fprintf(stderr, "kernel_launch: occupancy query says %d\n", per_cu); }
        (void)hipGetLastError();
        grid = cus;
    }
    if (grid < 0) return;
    (void)hipMemsetAsync((char*)d_ws + WS_CTL, 0, CTL_ZERO_BYTES, stream);
    Args a{};
    for (int i = 0; i < 26; ++i) a.in[i] = (const float*)d_in[i];
    a.out = (float*)d_out; a.ws = (unsigned char*)d_ws;
#if MK_ONE_LAUNCH
    a.ph_lo = 0; a.ph_hi = N_PHASES;
    hipLaunchKernelGGL(mk_fwd, dim3(grid), dim3(NTHREADS), LDS_BYTES, stream, a);
#else
    for (int p = 0; p < N_PHASES; ++p) { a.ph_lo = p; a.ph_hi = p + 1; hipLaunchKernelGGL(mk_fwd, dim3(grid), dim3(NTHREADS), LDS_BYTES, stream, a); }
#endif
}
```

```cpp
#include <hip/hip_runtime.h>
#include <cstdio>
#include <cstdint>

constexpr int DM = 2048, NB = 8, SEQ = 2048, T = NB * SEQ;
constexpr int HW = 1024;
constexpr int NH = 8, HD = 128;
constexpr int INC = 11264;
constexpr int NE = 32, EPG = 8, NG = 4, DE = 1024;
constexpr float EPS = 1e-6f;
constexpr float LAMBDA_INIT = 0.2f;
constexpr float QSCALE = 0.125f * 1.4426950408889634f;
constexpr int SLOT_MAX = 40960;

constexpr int NWAVES = 8, NTHREADS = 512;
enum { PH_PRO = 0, PH_MOD, PH_H1, PH_PROJ, PH_MIX, PH_YDA, PH_BRANCH, PH_WOUT, PH_POST, PH_MOE1, PH_MOE2, PH_FINAL, N_PHASES };
#ifndef EXPERT_T_IN_MIX
#define EXPERT_T_IN_MIX 1
#endif
#ifndef FAST_POST
#define FAST_POST 1
#endif
#ifndef PROJ_FP8
#define PROJ_FP8 1
#endif
#ifndef PROBE_DUP
#define PROBE_DUP -1
#endif
#ifndef FAST_ATTN
#define FAST_ATTN 1
#endif
#ifndef FAST_HGRN
#define FAST_HGRN 1
#endif
#ifndef FAST_GEMM
#define FAST_GEMM 1
#endif
#ifndef MK_ONE_LAUNCH
#define MK_ONE_LAUNCH 1
#endif

constexpr size_t MiB = 1u << 20;
constexpr size_t WS_CTL = 0, CTL_ZERO_BYTES = 1 * MiB;
constexpr size_t WS_MODP = 1 * MiB;
constexpr size_t WS_ROPE = 4 * MiB;
constexpr size_t WS_LB = 4 * MiB + 256 * 1024;
constexpr size_t WS_LAM = WS_LB + 8192;
constexpr size_t WS_TOKE = 5 * MiB;
constexpr size_t WS_TOKP = 5 * MiB + 256 * 1024;
constexpr size_t WS_LISTTOK = 6 * MiB;
constexpr size_t WS_LISTW = 8 * MiB;
constexpr size_t WS_P64 = 460 * MiB;
constexpr size_t WS_MODF = 10 * MiB;
constexpr size_t WS_WCAT = 11 * MiB;
constexpr size_t WS_WIN_T = 16 * MiB, WS_WBH_T = 60 * MiB, WS_WBD_T = 64 * MiB, WS_WOUT_T = 68 * MiB, WS_WGU_T = 76 * MiB, WS_WD_T = 332 * MiB;
constexpr size_t WS_TMPG = 76 * MiB;
constexpr size_t WS_H1 = 460 * MiB, WS_QHG = 524 * MiB, WS_LOGF = 556 * MiB, WS_VHG = 620 * MiB, WS_GHG = 652 * MiB;
constexpr size_t WS_QDA = 684 * MiB, WS_KDA = 716 * MiB, WS_VDA = 748 * MiB, WS_GATEH = 780 * MiB, WS_GATED = 844 * MiB;
constexpr size_t WS_YCAT = 908 * MiB;
constexpr size_t WS_YHG = WS_YCAT, WS_YDA = WS_YCAT + 2048, WS_O1 = 972 * MiB, WS_O2 = 1004 * MiB, WS_END = 1036 * MiB;
constexpr size_t WS_TMP = 460 * MiB;
constexpr size_t WS_MERGED = 588 * MiB;
constexpr size_t WS_U = 652 * MiB;
constexpr size_t WS_X1 = 460 * MiB;
constexpr size_t WS_H2 = 588 * MiB;
constexpr size_t WS_ACT = 716 * MiB;
constexpr size_t WS_YW = 796 * MiB;
constexpr int CW_TMO = 0, CW_CODE = 1, CW_BAR = 4096, CW_CNT = 8192  , CW_ATTQ = 9216, CW_TQ = 9216 + 128;

constexpr int RING_BYTES = 131072 + 8192;
constexpr int LDSCTL_OFF = RING_BYTES, MISC_OFF = LDSCTL_OFF + 320;
constexpr int LDS_BYTES = 147456;
static_assert(MISC_OFF + 128 <= LDS_BYTES, "LDS map");

#define GAS __attribute__((address_space(1)))
#define LAS __attribute__((address_space(3)))
typedef unsigned short bf16;
typedef float f32x4 __attribute__((ext_vector_type(4)));
typedef unsigned u32x4 __attribute__((ext_vector_type(4)));
typedef unsigned u32x2 __attribute__((ext_vector_type(2)));
typedef float f32x2_t __attribute__((ext_vector_type(2)));
typedef GAS unsigned gu32;
#define RLX_AGENT __ATOMIC_RELAXED, __HIP_MEMORY_SCOPE_AGENT

__device__ __forceinline__ float bf2f(unsigned h) { return __uint_as_float(h << 16); }
__device__ __forceinline__ unsigned f2bf(float f) { unsigned u = __float_as_uint(f); return (u + 0x7fffu + ((u >> 16) & 1u)) >> 16; }
__device__ __forceinline__ unsigned pk2(float lo, float hi) { unsigned r; asm("v_cvt_pk_bf16_f32 %0, %1, %2" : "=v"(r) : "v"(lo), "v"(hi)); return r; }
__device__ __forceinline__ float sigmoidf_(float v) { return __builtin_amdgcn_rcpf(1.0f + __builtin_amdgcn_exp2f(-1.4426950408889634f * v)); }
__device__ __forceinline__ float wave_sum(float v) {
#pragma unroll
    for (int o = 1; o < 64; o <<= 1) v += __shfl_xor(v, o);
    return v;
}

#define XB_TMO      128
#define XB_XCNT(j)  (256  + 64 * (j))
#define XB_XSUB(j)  (1280 + 64 * (j))
#define XB_XGEN(j)  (2304 + 64 * (j))
#define XB_TOP      3328
#define XB_TOPGEN   3392
#define XCD_BAR_WORDS 3456
#define XB_SPIN_CAP (1u << 22)
__device__ __forceinline__ unsigned xb_ld(unsigned* p)              { return __hip_atomic_load(p, __ATOMIC_RELAXED, __HIP_MEMORY_SCOPE_AGENT); }
__device__ __forceinline__ unsigned xb_add(unsigned* p, unsigned v) { return __hip_atomic_fetch_add(p, v, __ATOMIC_RELAXED, __HIP_MEMORY_SCOPE_AGENT); }
__device__ __forceinline__ unsigned xb_xcc_id() { return (unsigned)__builtin_amdgcn_s_getreg((3 << 11) | 20) & 0xFu; }
#define XB_SPIN(cond, bar) do { unsigned _sp = 0; while (cond) { __builtin_amdgcn_s_sleep(1); \
    if ((++_sp & 255u) == 0u) { if (xb_ld(&(bar)[XB_TMO])) break; if (_sp > XB_SPIN_CAP) { atomicAdd(&(bar)[XB_TMO], 1u); break; } } } } while (0)
struct XcdBarrier { unsigned* bar; unsigned x; volatile LAS unsigned* st; };
__device__ __forceinline__ XcdBarrier xcd_barrier_post(unsigned* bar, volatile LAS unsigned* st) {
    XcdBarrier b; b.bar = bar; b.x = xb_xcc_id(); b.st = st;
    if (threadIdx.x == 0) (void)xb_add(&bar[XB_XCNT(b.x)], 1u);
    return b;
}
__device__ __forceinline__ void xcd_barrier_complete(unsigned* bar, unsigned x, unsigned& nloc, unsigned& nx) {
    const unsigned G = gridDim.x * gridDim.y * gridDim.z;
    unsigned sum, cnt, mine, sp = 0u;
    for (;;) {
        sum = 0u; cnt = 0u; mine = 0u;
#pragma unroll
        for (unsigned j = 0; j < 16; ++j) { const unsigned c = xb_ld(&bar[XB_XCNT(j)]); sum += c; cnt += (c > 0u) ? 1u : 0u; mine = (j == x) ? c : mine; }
        if (sum == G) break;
        __builtin_amdgcn_s_sleep(1);
        if ((++sp & 255u) == 0u) { if (xb_ld(&bar[XB_TMO])) break; if (sp > XB_SPIN_CAP) { atomicAdd(&bar[XB_TMO], 1u); break; } }
    }
    nloc = mine > 0u ? mine : 1u; nx = cnt > 0u ? cnt : 1u;
}
__device__ __forceinline__ void xcd_barrier(const XcdBarrier& b) {
    asm volatile("s_waitcnt vmcnt(0)" ::: "memory");
    __syncthreads();
    if (threadIdx.x == 0) {
        unsigned* bar = b.bar;
        __builtin_amdgcn_s_waitcnt(0);
        unsigned nloc = b.st[0], nx = b.st[1];
        if (nloc == 0u) { xcd_barrier_complete(bar, b.x, nloc, nx); b.st[0] = nloc; b.st[1] = nx; }
        const unsigned old = xb_add(&bar[XB_XSUB(b.x)], 1u);
        const unsigned gen = old / nloc;
        if (old + 1u == (gen + 1u) * nloc) {
            __builtin_amdgcn_fence(__ATOMIC_RELEASE, "agent");
            asm volatile("s_waitcnt vmcnt(0)" ::: "memory");
            const unsigned og = xb_add(&bar[XB_TOP], 1u);
            const unsigned tg = og / nx;
            if (og + 1u == (tg + 1u) * nx) xb_add(&bar[XB_TOPGEN], 1u);
            else XB_SPIN(xb_ld(&bar[XB_TOPGEN]) == tg, bar);
            __builtin_amdgcn_fence(__ATOMIC_ACQUIRE, "agent");
            xb_add(&bar[XB_XGEN(b.x)], 1u);
            asm volatile("s_waitcnt vmcnt(0)" ::: "memory");
        } else {
            XB_SPIN(xb_ld(&bar[XB_XGEN(b.x)]) == gen, bar);
            __builtin_amdgcn_fence(__ATOMIC_ACQUIRE, "agent");
            asm volatile("s_waitcnt vmcnt(0)" ::: "memory");
        }
    }
    __syncthreads();
}

struct Frame {
    LAS unsigned char* lds;
    gu32* ctl;
    int tid, lane, wave, G, bid;
    unsigned char* ws;
    const float* x; const float* c; const float* w_ada; const float* b_ada;
    const float *pre_mix, *post_mix, *pre_ffn, *post_ffn;
    const float* w_in; const float* hg_lb; const float* hg_nw;
    const float *lq1, *lk1, *lq2, *lk2; const float* da_nw;
    const float *w_bhg, *w_bda, *w_out, *w_group, *b_group, *w_router, *b_router, *w_gate, *w_up, *w_down;
    float* out;
};
template <class Tp> __device__ __forceinline__ Tp* wsp(const Frame& F, size_t off) { return (Tp*)(F.ws + off); }

__device__ __forceinline__ void mod_vec(const Frame& F, LAS float* dst, int chunk, int batch) {
    const float* M = wsp<const float>(F, WS_MODF) + (batch * 6 + chunk) * DM;
    for (int j = F.tid; j < DM; j += NTHREADS) dst[j] = M[j];
}
__device__ __forceinline__ void ph_mod(Frame& F) {
    const int gt = F.bid * NTHREADS + F.tid, NGT = F.G * NTHREADS;
    const float* P = wsp<const float>(F, WS_P64); float* MF = wsp<float>(F, WS_MODF);
    for (int o = gt; o < NB * 6 * DM; o += NGT) {
        const int b = o / (6 * DM), col = o % (6 * DM);
        float s0 = 0.f, s1 = 0.f, s2 = 0.f, s3 = 0.f;
#pragma unroll 4
        for (int kc = 0; kc < 64; kc += 4) {
            s0 += P[(size_t)((kc + 0) * 8 + b) * (6 * DM) + col]; s1 += P[(size_t)((kc + 1) * 8 + b) * (6 * DM) + col];
            s2 += P[(size_t)((kc + 2) * 8 + b) * (6 * DM) + col]; s3 += P[(size_t)((kc + 3) * 8 + b) * (6 * DM) + col];
        }
        MF[o] = F.b_ada[col] + ((s0 + s1) + (s2 + s3));
    }
}

template <class Rows, class Epi>
__device__ __forceinline__ void sg_tile(LAS float* As, LAS float* Bs, const bf16* A, int lda, const Rows& rows, const float* B, int ldb, int n0, int K, const Epi& epi) {
    int tid = threadIdx.x; asm volatile("" : "+v"(tid));
    const int tx = tid & 15, ty = tid >> 4;
    float acc[4][8];
#pragma unroll
    for (int i = 0; i < 4; ++i)
#pragma unroll
        for (int j = 0; j < 8; ++j) acc[i][j] = 0.f;
    const int ar = tid >> 2, akq = tid & 3;
    const int arow = rows(ar);
    const bf16* ap = A + (size_t)(arow < 0 ? 0 : arow) * lda + akq * 4;
    const int bk = tid >> 5, bn = (tid & 31) * 4;
    const float* bp = B + (size_t)bk * ldb + n0 + bn;
    for (int k0 = 0; k0 < K; k0 += 16) {
        u32x2 av = *(const u32x2*)(ap + k0);
        const f32x4 bv = *(const f32x4*)(bp + (size_t)k0 * ldb);
        if (arow < 0) { av.x = 0u; av.y = 0u; }
        __syncthreads();
        As[(akq * 4 + 0) * 132 + ar] = bf2f(av.x & 0xffffu);
        As[(akq * 4 + 1) * 132 + ar] = bf2f(av.x >> 16);
        As[(akq * 4 + 2) * 132 + ar] = bf2f(av.y & 0xffffu);
        As[(akq * 4 + 3) * 132 + ar] = bf2f(av.y >> 16);
        *(LAS f32x4*)&Bs[bk * 132 + bn] = bv;
        __syncthreads();
#pragma unroll 2
        for (int kk = 0; kk < 16; ++kk) {
            const f32x4 a4 = *(const LAS f32x4*)&As[kk * 132 + ty * 4];
            const f32x4 b0 = *(const LAS f32x4*)&Bs[kk * 132 + tx * 8];
            const f32x4 b1 = *(const LAS f32x4*)&Bs[kk * 132 + tx * 8 + 4];
#pragma unroll
            for (int i = 0; i < 4; ++i) {
                acc[i][0] += a4[i] * b0[0]; acc[i][1] += a4[i] * b0[1]; acc[i][2] += a4[i] * b0[2]; acc[i][3] += a4[i] * b0[3];
                acc[i][4] += a4[i] * b1[0]; acc[i][5] += a4[i] * b1[1]; acc[i][6] += a4[i] * b1[2]; acc[i][7] += a4[i] * b1[3];
            }
        }
    }
#pragma unroll
    for (int i = 0; i < 4; ++i) epi(ty * 4 + i, n0 + tx * 8, acc[i]);
}
struct RowsDense { int m0; __device__ __forceinline__ int operator()(int r) const { return m0 + r; } };
struct RowsList { const int* list; int n; __device__ __forceinline__ int operator()(int r) const { return r < n ? list[r] : -1; } };

__device__ __forceinline__ void store8_bf16(bf16* p, const float (&v)[8]) {
    u32x4 w; w.x = pk2(v[0], v[1]); w.y = pk2(v[2], v[3]); w.z = pk2(v[4], v[5]); w.w = pk2(v[6], v[7]);
    *(u32x4*)p = w;
}

__device__ __forceinline__ void proj_store8(const Frame& F, int row, int col0, const float (&vin)[8], int pxor) {
    const int sec = col0 >> 10;
    float v[8];
#pragma unroll
    for (int i = 0; i < 8; ++i) v[i] = vin[i];
    if (sec == 0) {
#pragma unroll
        for (int i = 0; i < 8; ++i) v[i] = v[i] * sigmoidf_(v[i]);
        store8_bf16(wsp<bf16>(F, WS_QHG) + (size_t)row * HW + col0, v);
    } else if (sec == 1) {
        const int j = col0 - 1024; const float* lb = wsp<const float>(F, WS_LB) + j;
        float* o = wsp<float>(F, WS_LOGF) + (size_t)row * HW + j;
        f32x4 o0, o1;
#pragma unroll
        for (int i = 0; i < 8; ++i) { const float l = lb[i]; const float f = l + (1.0f - l) * sigmoidf_(v[i]); const float lf = __logf(f); if (i < 4) o0[i] = lf; else o1[i - 4] = lf; }
        *(f32x4*)o = o0; *(f32x4*)(o + 4) = o1;
    } else if (sec == 2) {
        store8_bf16(wsp<bf16>(F, WS_VHG) + (size_t)row * HW + (col0 - 2048), v);
    } else if (sec == 3) {
#pragma unroll
        for (int i = 0; i < 8; ++i) v[i] = sigmoidf_(v[i]);
        store8_bf16(wsp<bf16>(F, WS_GHG) + (size_t)row * HW + (col0 - 3072), v);
    } else if (sec == 4 || sec == 5) {
        const int d0 = col0 & 63;
        float pv[8];
#pragma unroll
        for (int i = 0; i < 8; ++i) pv[i] = __shfl_xor(v[i], pxor);
        if (d0 < 16) {
            const float* rt = wsp<const float>(F, WS_ROPE) + (size_t)(row & (SEQ - 1)) * 16;
            const f32x4 c0 = *(const f32x4*)rt, c1 = *(const f32x4*)(rt + 4), s0 = *(const f32x4*)(rt + 8), s1 = *(const f32x4*)(rt + 12);
            const float sg = (d0 == 0) ? -1.0f : 1.0f;
#pragma unroll
            for (int i = 0; i < 8; ++i) { const float cs = i < 4 ? c0[i] : c1[i - 4], sn = i < 4 ? s0[i] : s1[i - 4]; v[i] = v[i] * cs + sg * pv[i] * sn; }
        }
        if (sec == 4) {
#pragma unroll
            for (int i = 0; i < 8; ++i) v[i] *= QSCALE;
            store8_bf16(wsp<bf16>(F, WS_QDA) + (size_t)row * HW + (col0 - 4096), v);
        } else store8_bf16(wsp<bf16>(F, WS_KDA) + (size_t)row * HW + (col0 - 5120), v);
    } else if (sec == 6) {
        store8_bf16(wsp<bf16>(F, WS_VDA) + (size_t)row * HW + (col0 - 6144), v);
    } else {
#pragma unroll
        for (int i = 0; i < 8; ++i) v[i] = sigmoidf_(v[i]);
        if (sec < 9) store8_bf16(wsp<bf16>(F, WS_GATEH) + (size_t)row * DM + (col0 - 7168), v);
        else store8_bf16(wsp<bf16>(F, WS_GATED) + (size_t)row * DM + (col0 - 9216), v);
    }
}


constexpr float Y8S = 8.0f, Y8I = 1.0f / 8.0f;
constexpr float W8S = 64.0f, W8I = 1.0f / 64.0f;
__device__ __forceinline__ unsigned pk4_fp8(float a, float b, float c, float d) { const int p = __builtin_amdgcn_cvt_pk_fp8_f32(a, b, 0, false); return (unsigned)__builtin_amdgcn_cvt_pk_fp8_f32(c, d, p, true); }
__device__ __forceinline__ float clamp8(float v) { return __builtin_amdgcn_fmed3f(v, -448.0f, 448.0f); }
namespace fg {
typedef short bf16x8 __attribute__((ext_vector_type(8)));
constexpr int BM = 256, BK = 64, HALF = 128, HTB = HALF * BK * 2, STAGE_BYTES = 8 * HTB, NXCD = 8, WGM = 8;
__device__ __forceinline__ int lds_byte(int r, int c) { const int st = (r >> 4) * 2 + (c >> 5), rr = r & 15, cc = c & 31, ob = rr * 64 + cc * 2; return st * 1024 + (ob ^ (((ob >> 9) & 1) << 5)); }
__device__ __forceinline__ void stage_rc(int b, int& R, int& C) { const int st = b / 1024, sb = b % 1024, swz = sb ^ (((sb >> 9) & 1) << 5); R = (st >> 1) * 16 + swz / 64; C = (st & 1) * 32 + (swz % 64) / 2; }
__device__ __forceinline__ int perm32(int rho) { const int n = rho >> 4, i = rho & 15; return 8 * (i >> 2) + 4 * n + (i & 3); }
struct Unit { int pm, pn, e, nvalid, slot0; };
typedef int i32x8 __attribute__((ext_vector_type(8)));
typedef short s16x16 __attribute__((ext_vector_type(16)));
__device__ __forceinline__ i32x8 cat16(bf16x8 a, bf16x8 b) { const s16x16 v = __builtin_shufflevector(a, b, 0, 1, 2, 3, 4, 5, 6, 7, 8, 9, 10, 11, 12, 13, 14, 15); return __builtin_bit_cast(i32x8, v); }
__device__ __forceinline__ unsigned cvt_pk_bf16(float lo, float hi) { unsigned r; asm volatile("v_cvt_pk_bf16_f32 %0, %1, %2" : "=v"(r) : "v"(lo), "v"(hi)); return r; }

template <bool FP8_ = false> struct DenseOrderT {
    int nM, nN, nwg, G, c; const char* A; const char* Bt; int K;
    __device__ __forceinline__ void init(const void* A_, const void* Bt_, int M, int N, int K_, int G_, int c_) { A = (const char*)A_; Bt = (const char*)Bt_; K = K_; nM = M / BM; nN = N / BM; nwg = nM * nN; G = G_; c = c_; }
    __device__ __forceinline__ bool next(int i, Unit& u) const {
        const long L = (long)i * G + c; if (L >= nwg) return false;
        int wgid = (int)L; { const int q = nwg / NXCD, r = nwg % NXCD, xcd = wgid % NXCD, off = wgid / NXCD; wgid = (xcd < r ? xcd * (q + 1) : r * (q + 1) + (xcd - r) * q) + off; }
        const int nig = WGM * nN, gid = wgid / nig, fm = gid * WGM, gsz = (nM - fm) < WGM ? (nM - fm) : WGM;
        u.pm = fm + ((wgid % nig) % gsz); u.pn = (wgid % nig) / gsz; u.e = 0; u.nvalid = BM; u.slot0 = u.pm * BM; return true;
    }
    static constexpr bool GATHER = FP8_, FP8 = FP8_;
    __device__ __forceinline__ const char* a_ptr(const Unit& u) const { return GATHER ? A : A + (size_t)u.pm * BM * K * 2; }
    __device__ __forceinline__ int a_row(const Unit& u, int r) const { return u.pm * BM + r; }
    __device__ __forceinline__ const char* b_ptr(const Unit& u) const { return Bt + (size_t)u.pn * BM * K * 2; }
};

typedef DenseOrderT<false> DenseOrder;
template <class Epi, class Sched>
__device__ __forceinline__ void gemm_phase(LAS unsigned char* lds, const int K, const Sched& S, const Epi& E) {
    int tid = threadIdx.x; asm volatile("" : "+v"(tid));
    const int wid = __builtin_amdgcn_readfirstlane(tid >> 6), lane = tid & 63, wr = wid >> 2, wc = wid & 3, fr = lane & 15, fq = lane >> 4;
    const int nt = K / BK;
    constexpr bool GA = Sched::GATHER;
    int RA[2]; unsigned voffA[2], voffB[2];
#pragma unroll
    for (int i = 0; i < 2; ++i) { int R, C; stage_rc(tid * 16 + i * 8192, R, C); const int Rb = Epi::PERM ? ((R & ~31) + perm32(R & 31)) : R;
        RA[i] = R; voffA[i] = GA ? (unsigned)C * 2u : (unsigned)(R * K + C) * 2u; voffB[i] = (unsigned)(Rb * K + C) * 2u; }
    const size_t kstep = (size_t)(BK * 2);
    const size_t hstep = (size_t)HALF * K * 2;
    const unsigned ldsw = (unsigned)wid * 1024u;
    const int aoff = lds_byte(wr * 64 + fr, fq * 8), boff = lds_byte(wc * 32 + fr, fq * 8);
    const unsigned rowb = (unsigned)K * 2u;
#define PG8_SA(b, h) (((b) * 2 + (h)) * HTB)
#define PG8_SB(b, h) ((4 + (b) * 2 + (h)) * HTB)
#define PG8_STAGE(bufoff, gbase, voff) do { _Pragma("unroll") for (int _i = 0; _i < 2; ++_i) \
        __builtin_amdgcn_global_load_lds((const unsigned*)((const char*)(gbase) + (voff)[_i]), (LAS unsigned*)(lds + (bufoff) + ldsw + _i * 8192), 16, 0, 0); } while (0)
#define PG8_STAGE_A(bufoff, h, kb) do { if constexpr (GA) { PG8_STAGE(bufoff, cA + (kb), oc[h]); } else { PG8_STAGE(bufoff, cA + (kb) + (h) * hstep, voffA); } } while (0)
#define PG8_LDA(dst, b, h) do { if constexpr (Sched::FP8) { _Pragma("unroll") for (int m = 0; m < 4; ++m) dst##8[m] = cat16(*(const LAS bf16x8*)(lds + PG8_SA(b, h) + aoff + m * 2048), *(const LAS bf16x8*)(lds + PG8_SA(b, h) + aoff + m * 2048 + 1024)); } \
        else { _Pragma("unroll") for (int m = 0; m < 4; ++m) _Pragma("unroll") for (int k = 0; k < 2; ++k) dst[m][k] = *(const LAS bf16x8*)(lds + PG8_SA(b, h) + aoff + m * 2048 + k * 1024); } } while (0)
#define PG8_LDB(dst, b, h) do { if constexpr (Sched::FP8) { _Pragma("unroll") for (int n = 0; n < 2; ++n) dst##8[n] = cat16(*(const LAS bf16x8*)(lds + PG8_SB(b, h) + boff + n * 2048), *(const LAS bf16x8*)(lds + PG8_SB(b, h) + boff + n * 2048 + 1024)); } \
        else { _Pragma("unroll") for (int n = 0; n < 2; ++n) _Pragma("unroll") for (int k = 0; k < 2; ++k) dst[n][k] = *(const LAS bf16x8*)(lds + PG8_SB(b, h) + boff + n * 2048 + k * 1024); } } while (0)
#define PG8_MMA(ai, bj, At, Bt) do { __builtin_amdgcn_s_setprio(1); _Pragma("unroll") for (int m = 0; m < 4; ++m) _Pragma("unroll") for (int n = 0; n < 2; ++n) { \
        if constexpr (Sched::FP8) acc[ai][bj][m][n] = __builtin_amdgcn_mfma_scale_f32_16x16x128_f8f6f4(Bt##8[n], At##8[m], acc[ai][bj][m][n], 0, 0, 0, 0, 0, 0); \
        else { _Pragma("unroll") for (int k = 0; k < 2; ++k) acc[ai][bj][m][n] = __builtin_amdgcn_mfma_f32_16x16x32_bf16(Bt[n][k], At[m][k], acc[ai][bj][m][n], 0, 0, 0); } } \
        __builtin_amdgcn_s_setprio(0); } while (0)
#define PG8_WAIT_V(n) asm volatile("s_waitcnt vmcnt(" #n ")" ::: "memory")
#define PG8_WAIT_L(n) asm volatile("s_waitcnt lgkmcnt(" #n ")" ::: "memory")
#define PG8_BAR __builtin_amdgcn_s_barrier()
#define PG8_SCHED __builtin_amdgcn_sched_barrier(0)
#define PG8_AOFFS(dst, u) do { _Pragma("unroll") for (int _h = 0; _h < 2; ++_h) _Pragma("unroll") for (int _i = 0; _i < 2; ++_i) dst[_h][_i] = (unsigned)S.a_row(u, _h * HALF + RA[_i]) * rowb + voffA[_i]; } while (0)
    Unit cur, nxt; int ui = 0;
    if (!S.next(0, cur)) return;
    f32x4 acc[2][2][4][2];
#pragma unroll
    for (int a = 0; a < 2; ++a)
#pragma unroll
        for (int b = 0; b < 2; ++b)
#pragma unroll
            for (int m = 0; m < 4; ++m)
#pragma unroll
                for (int n = 0; n < 2; ++n) acc[a][b][m][n] = (f32x4){0.f, 0.f, 0.f, 0.f};
    bf16x8 At[4][2], B0[2][2], B1[2][2];
    i32x8 At8[4], B08[2], B18[2];
    unsigned oc[2][2] = {{0u, 0u}, {0u, 0u}}, on[2][2] = {{0u, 0u}, {0u, 0u}};
    const char* cA = S.a_ptr(cur); const char* cB = S.b_ptr(cur);
    if constexpr (GA) PG8_AOFFS(oc, cur);
    PG8_STAGE(PG8_SB(0, 0), cB, voffB); PG8_STAGE(PG8_SB(0, 1), cB + hstep, voffB); PG8_STAGE_A(PG8_SA(0, 0), 0, 0); PG8_STAGE_A(PG8_SA(0, 1), 1, 0);
    if (wr == 1) PG8_BAR;
    PG8_WAIT_V(2); PG8_BAR;
    PG8_STAGE(PG8_SB(1, 0), cB + kstep, voffB); PG8_STAGE_A(PG8_SA(1, 0), 0, kstep); PG8_STAGE(PG8_SB(1, 1), cB + hstep + kstep, voffB);
    PG8_WAIT_V(6); PG8_BAR;
    for (;;) {
        const bool has_next = S.next(ui + 1, nxt);
        const char* nA = cA; const char* nB = cB;
        if (has_next) { nA = S.a_ptr(nxt); nB = S.b_ptr(nxt); if constexpr (GA) PG8_AOFFS(on, nxt); }
        else if constexpr (GA) {
#pragma unroll
            for (int _h = 0; _h < 2; ++_h)
#pragma unroll
                for (int _i = 0; _i < 2; ++_i) on[_h][_i] = oc[_h][_i];
        }
#pragma unroll 1
        for (int t = 0; t < nt; t += 2) {
            const bool last = (t == nt - 2);
            if constexpr (Epi::MID) { if (t == (nt >> 1)) E.mid(acc, cur, wr, wc, fr, fq); }
            PG8_LDB(B0, 0, 0); PG8_LDB(B1, 0, 1); PG8_SCHED; PG8_LDA(At, 0, 0); PG8_STAGE_A(PG8_SA(1, 1), 1, (size_t)(t + 1) * kstep);
            if (last) {
                cA = nA; cB = nB;
                if constexpr (GA) {
#pragma unroll
                    for (int _h = 0; _h < 2; ++_h)
#pragma unroll
                        for (int _i = 0; _i < 2; ++_i) oc[_h][_i] = on[_h][_i];
                }
            }
            const size_t k2 = last ? (size_t)0 : (size_t)(t + 2) * kstep, k3 = k2 + kstep;
            PG8_WAIT_V(8); PG8_WAIT_L(0); PG8_BAR; PG8_MMA(0, 0, At, B0); PG8_MMA(0, 1, At, B1); PG8_BAR; PG8_SCHED;
            PG8_LDA(At, 0, 1); PG8_STAGE(PG8_SB(0, 0), cB + k2, voffB); PG8_STAGE(PG8_SB(0, 1), cB + k2 + hstep, voffB); PG8_STAGE_A(PG8_SA(0, 0), 0, k2);
            PG8_WAIT_V(8); PG8_WAIT_L(0); PG8_BAR; PG8_MMA(1, 0, At, B0); PG8_MMA(1, 1, At, B1); PG8_BAR; PG8_SCHED;
            PG8_LDB(B0, 1, 0); PG8_LDB(B1, 1, 1); PG8_SCHED; PG8_LDA(At, 1, 0); PG8_STAGE_A(PG8_SA(0, 1), 1, k2);
            PG8_WAIT_V(8); PG8_WAIT_L(0); PG8_BAR; PG8_MMA(0, 0, At, B0); PG8_MMA(0, 1, At, B1); PG8_BAR; PG8_SCHED;
            PG8_LDA(At, 1, 1); PG8_STAGE(PG8_SB(1, 0), cB + k3, voffB); PG8_STAGE(PG8_SB(1, 1), cB + k3 + hstep, voffB); PG8_STAGE_A(PG8_SA(1, 0), 0, k3);
            PG8_WAIT_V(8); PG8_WAIT_L(0); PG8_BAR; PG8_MMA(1, 0, At, B0); PG8_MMA(1, 1, At, B1); PG8_BAR; PG8_SCHED;
        }
        if (wr == 0) PG8_BAR;
        E(acc, cur, wr, wc, fr, fq);
        if (!has_next) break;
#pragma unroll
        for (int a = 0; a < 2; ++a)
#pragma unroll
            for (int b = 0; b < 2; ++b)
#pragma unroll
                for (int m = 0; m < 4; ++m)
#pragma unroll
                    for (int n = 0; n < 2; ++n) acc[a][b][m][n] = (f32x4){0.f, 0.f, 0.f, 0.f};
        cur = nxt; ++ui;
        if (wr == 1) PG8_BAR;
    }
    PG8_WAIT_V(0);
    PG8_BAR;
#undef PG8_SA
#undef PG8_SB
#undef PG8_STAGE
#undef PG8_STAGE_A
#undef PG8_LDA
#undef PG8_LDB
#undef PG8_MMA
#undef PG8_WAIT_V
#undef PG8_WAIT_L
#undef PG8_BAR
#undef PG8_SCHED
#undef PG8_AOFFS
}
}

template <bool F8 = false>
__device__ __forceinline__ void transpose_item(const float* W, int K, int N, bf16* WT, int k0, int n0, int drow, LAS float* scr, int lane, int ldt = 0, int kd0 = 0) {
    if (ldt == 0) ldt = K;
    float tv[32];
#pragma unroll
    for (int i = 0; i < 32; ++i) tv[i] = W[(size_t)(k0 + 2 * i + (lane >> 5)) * N + n0 + (lane & 31)];
#pragma unroll
    for (int i = 0; i < 32; ++i) scr[(2 * i + (lane >> 5)) * 33 + (lane & 31)] = tv[i];
    asm volatile("s_waitcnt lgkmcnt(0)" ::: "memory");
    const int c = lane & 7;
#pragma unroll
    for (int j = 0; j < 4; ++j) { const int n = (lane >> 3) + 8 * j; const LAS float* sp = scr + (8 * c) * 33 + n;
        if constexpr (F8) { u32x2 o; o.x = pk4_fp8(sp[0 * 33] * W8S, sp[1 * 33] * W8S, sp[2 * 33] * W8S, sp[3 * 33] * W8S); o.y = pk4_fp8(sp[4 * 33] * W8S, sp[5 * 33] * W8S, sp[6 * 33] * W8S, sp[7 * 33] * W8S);
            *(u32x2*)((unsigned char*)WT + (size_t)(drow + n) * ldt + kd0 + k0 + 8 * c) = o; }
        else { u32x4 o; o.x = pk2(sp[0 * 33], sp[1 * 33]); o.y = pk2(sp[2 * 33], sp[3 * 33]); o.z = pk2(sp[4 * 33], sp[5 * 33]); o.w = pk2(sp[6 * 33], sp[7 * 33]);
            *(u32x4*)(WT + (size_t)(drow + n) * ldt + kd0 + k0 + 8 * c) = o; } }
    asm volatile("s_waitcnt lgkmcnt(0)" ::: "memory");
}

__device__ __forceinline__ void transpose_item2(const float* W, int K, int N, bf16* WT, int k0, int n0a, int drowa, int n0b, int drowb, LAS float* scr, int lane) {
    float ta[32], tb[32];
#pragma unroll
    for (int i = 0; i < 32; ++i) ta[i] = W[(size_t)(k0 + 2 * i + (lane >> 5)) * N + n0a + (lane & 31)];
#pragma unroll
    for (int i = 0; i < 32; ++i) tb[i] = W[(size_t)(k0 + 2 * i + (lane >> 5)) * N + n0b + (lane & 31)];
    const int c = lane & 7;
#pragma unroll
    for (int i = 0; i < 32; ++i) scr[(2 * i + (lane >> 5)) * 33 + (lane & 31)] = ta[i];
    asm volatile("s_waitcnt lgkmcnt(0)" ::: "memory");
#pragma unroll
    for (int j = 0; j < 4; ++j) { const int n = (lane >> 3) + 8 * j; const LAS float* sp = scr + (8 * c) * 33 + n;
        u32x4 o; o.x = pk2(sp[0 * 33], sp[1 * 33]); o.y = pk2(sp[2 * 33], sp[3 * 33]); o.z = pk2(sp[4 * 33], sp[5 * 33]); o.w = pk2(sp[6 * 33], sp[7 * 33]);
        *(u32x4*)(WT + (size_t)(drowa + n) * K + k0 + 8 * c) = o; }
    asm volatile("s_waitcnt lgkmcnt(0)" ::: "memory");
#pragma unroll
    for (int i = 0; i < 32; ++i) scr[(2 * i + (lane >> 5)) * 33 + (lane & 31)] = tb[i];
    asm volatile("s_waitcnt lgkmcnt(0)" ::: "memory");
#pragma unroll
    for (int j = 0; j < 4; ++j) { const int n = (lane >> 3) + 8 * j; const LAS float* sp = scr + (8 * c) * 33 + n;
        u32x4 o; o.x = pk2(sp[0 * 33], sp[1 * 33]); o.y = pk2(sp[2 * 33], sp[3 * 33]); o.z = pk2(sp[4 * 33], sp[5 * 33]); o.w = pk2(sp[6 * 33], sp[7 * 33]);
        *(u32x4*)(WT + (size_t)(drowb + n) * K + k0 + 8 * c) = o; }
    asm volatile("s_waitcnt lgkmcnt(0)" ::: "memory");
}

__device__ __forceinline__ void ph_prologue(Frame& F) {
    const int gw = F.bid * NWAVES + F.wave, NGW = F.G * NWAVES;
    LAS float* SC = (LAS float*)(F.lds + 8 * 8704);
    for (int i = F.tid; i < NB * DM; i += NTHREADS) { const float cv = F.c[i]; SC[i] = cv * sigmoidf_(cv); }
    __syncthreads();
    float* P = wsp<float>(F, WS_P64);
    for (int it = gw; it < 48 * 64; it += NGW) {
        const int cb = it % 48, kc = it / 48;
        f32x4 acc[8];
#pragma unroll
        for (int b = 0; b < 8; ++b) acc[b] = (f32x4){0.f, 0.f, 0.f, 0.f};
        const float* wp = F.w_ada + (size_t)(kc * 32) * (6 * DM) + cb * 256 + F.lane * 4;
        const LAS float* cp = SC + kc * 32;
#pragma unroll 1
        for (int k0 = 0; k0 < 32; k0 += 8) {
            f32x4 w[8];
#pragma unroll
            for (int k = 0; k < 8; ++k) w[k] = *(const f32x4*)(wp + (size_t)(k0 + k) * (6 * DM));
#pragma unroll
            for (int k = 0; k < 8; ++k)
#pragma unroll
                for (int b = 0; b < 8; ++b) acc[b] += w[k] * cp[b * DM + k0 + k];
        }
#pragma unroll
        for (int b = 0; b < 8; ++b) *(f32x4*)(P + (size_t)(kc * 8 + b) * (6 * DM) + cb * 256 + F.lane * 4) = acc[b];
    }
    const int gt = F.bid * NTHREADS + F.tid, NGT = F.G * NTHREADS;
    float* rope = wsp<float>(F, WS_ROPE);
    for (int i = gt; i < SEQ * 8; i += NGT) {
        const int pos = i >> 3, j = i & 7;
        const float invf = powf(500000.0f, -(float)(2 * j) / 16.0f);
        const float ang = (float)pos * invf;
        float sn, cs; sincosf(ang, &sn, &cs);
        rope[pos * 16 + j] = cs; rope[pos * 16 + 8 + j] = sn;
    }
    bf16* wch = wsp<bf16>(F, WS_WCAT); bf16* wcl = wch + 48 * DM;
    for (int i = gt; i < DM * 48; i += NGT) { const int c = i / DM, k = i % DM; const float v = c < 4 ? F.w_group[k * 4 + c] : (c < 36 ? F.w_router[k * 32 + c - 4] : 0.f);
        const unsigned hi = f2bf(v); wch[i] = (bf16)hi; wcl[i] = (bf16)f2bf(v - bf2f(hi)); }
    float* lb = wsp<float>(F, WS_LB);
    for (int i = gt; i < HW; i += NGT) { const float p0 = F.hg_lb[i], p1 = F.hg_lb[HW + i]; lb[i] = 1.0f / (1.0f + __expf(p1 - p0)); }
    if (F.bid == 0 && F.wave == 0) {
        const float a = wave_sum(F.lq1[F.lane] * F.lk1[F.lane]), b = wave_sum(F.lq2[F.lane] * F.lk2[F.lane]);
        if (F.lane == 0) *wsp<float>(F, WS_LAM) = __expf(a) - __expf(b) + LAMBDA_INIT;
    }
}

__device__ __forceinline__ void ph_h1(Frame& F) {
    LAS float* Lsh = (LAS float*)F.lds; LAS float* Lsc = Lsh + DM;
    bf16* H1 = wsp<bf16>(F, WS_H1);
    for (int rb = F.bid; rb < T / 64; rb += F.G) {
        const int batch = (rb * 64) / SEQ;
        __syncthreads(); mod_vec(F, Lsh, 0, batch); mod_vec(F, Lsc, 1, batch); __syncthreads();
#pragma unroll 1
        for (int half = 0; half < 2; ++half) {
            const int row0 = rb * 64 + F.wave * 8 + half * 4;
            f32x4 v[4][8];
#pragma unroll
            for (int r = 0; r < 4; ++r)
#pragma unroll
                for (int j = 0; j < 8; ++j) v[r][j] = *(const f32x4*)(F.x + (size_t)(row0 + r) * DM + 4 * F.lane + 256 * j);
            f32x4 wv[8];
#pragma unroll
            for (int j = 0; j < 8; ++j) wv[j] = *(const f32x4*)(F.pre_mix + 4 * F.lane + 256 * j);
#pragma unroll
            for (int r = 0; r < 4; ++r) {
                float s = 0.f;
#pragma unroll
                for (int j = 0; j < 8; ++j) s += (v[r][j][0] * v[r][j][0] + v[r][j][1] * v[r][j][1]) + (v[r][j][2] * v[r][j][2] + v[r][j][3] * v[r][j][3]);
                const float rstd = 1.0f / sqrtf(wave_sum(s) * (1.0f / DM) + EPS);
#pragma unroll
                for (int j = 0; j < 8; ++j) {
                    const int c0 = 4 * F.lane + 256 * j;
                    const f32x4 w = wv[j];
                    const f32x4 sc = *(const LAS f32x4*)(Lsc + c0), sh = *(const LAS f32x4*)(Lsh + c0);
                    const f32x4 h = v[r][j] * rstd * w * (sc + 1.0f) + sh;
#if PROJ_FP8
                    *(unsigned*)((unsigned char*)H1 + (size_t)(row0 + r) * DM + c0) = pk4_fp8(clamp8(h[0]), clamp8(h[1]), clamp8(h[2]), clamp8(h[3]));
#else
                    u32x2 o; o.x = pk2(h[0], h[1]); o.y = pk2(h[2], h[3]);
                    *(u32x2*)(H1 + (size_t)(row0 + r) * DM + c0) = o;
#endif
                }
            }
        }
    }
}

struct EpiProj { const Frame* F; int m0; __device__ __forceinline__ void operator()(int r, int col0, const float (&v)[8]) const { proj_store8(*F, m0 + r, col0, v, 1); } };
__device__ __forceinline__ void ph_proj_simple(Frame& F) {
    LAS float* As = (LAS float*)F.lds; LAS float* Bs = As + 16 * 132;
    const int NT_ = INC / 128, MT_ = T / 128;
    for (int t = F.bid; t < NT_ * MT_; t += F.G) {
        const int mt = t / NT_, nt = t % NT_;
        RowsDense rows{mt * 128}; EpiProj epi{&F, mt * 128};
        sg_tile(As, Bs, wsp<const bf16>(F, WS_H1), DM, rows, F.w_in, INC, nt * 128, DM, epi);
    }
}

__device__ __forceinline__ void hgrn_chain_simple(Frame& F, int ch) {
    const int b = ch >> 3, h = ch & 7;
    LAS float* Qs = (LAS float*)F.lds;
    LAS float* Fs = Qs + 16 * 128;
    LAS float* Vs = Fs + 16 * 128;
    LAS float* Gs = Vs + 16 * 128;
    LAS float* Po = Gs + 16 * 128;
    LAS float* Red = Po + 2 * 4 * 128;
    const int v = F.tid & 127, kg = F.tid >> 7;
    float S[32];
#pragma unroll
    for (int i = 0; i < 32; ++i) S[i] = 0.f;
    const bf16* QHG = wsp<const bf16>(F, WS_QHG); const float* LOGF = wsp<const float>(F, WS_LOGF);
    const bf16* VHG = wsp<const bf16>(F, WS_VHG); const bf16* GHG = wsp<const bf16>(F, WS_GHG);
    bf16* YHG = wsp<bf16>(F, WS_YHG);
    const float nw = F.hg_nw[h * HD + v];
    const int lt = F.tid >> 5, lc = (F.tid & 31) * 4;
    for (int t0 = 0; t0 < SEQ; t0 += 16) {
        __syncthreads();
        {
            const size_t off = (size_t)(b * SEQ + t0 + lt) * HW + h * HD + lc;
            const u32x2 q = *(const u32x2*)(QHG + off), vv = *(const u32x2*)(VHG + off), g = *(const u32x2*)(GHG + off);
            const f32x4 lf = *(const f32x4*)(LOGF + off);
            LAS float* d = Qs + lt * 128 + lc; d[0] = bf2f(q.x & 0xffffu); d[1] = bf2f(q.x >> 16); d[2] = bf2f(q.y & 0xffffu); d[3] = bf2f(q.y >> 16);
            d = Vs + lt * 128 + lc; d[0] = bf2f(vv.x & 0xffffu); d[1] = bf2f(vv.x >> 16); d[2] = bf2f(vv.y & 0xffffu); d[3] = bf2f(vv.y >> 16);
            d = Gs + lt * 128 + lc; d[0] = bf2f(g.x & 0xffffu); d[1] = bf2f(g.x >> 16); d[2] = bf2f(g.y & 0xffffu); d[3] = bf2f(g.y >> 16);
            d = Fs + lt * 128 + lc; d[0] = __expf(lf[0]); d[1] = __expf(lf[1]); d[2] = __expf(lf[2]); d[3] = __expf(lf[3]);
        }
        __syncthreads();
        for (int tt = 0; tt < 16; ++tt) {
            const int p = tt & 1;
            const float vv = Vs[tt * 128 + v];
            float part = 0.f;
#pragma unroll
            for (int i = 0; i < 32; ++i) {
                const float f = Fs[tt * 128 + kg * 32 + i], q = Qs[tt * 128 + kg * 32 + i];
                S[i] = f * S[i] + (1.0f - f) * vv;
                part += q * S[i];
            }
            Po[(p * 4 + kg) * 128 + v] = part;
            __syncthreads();
            float o = 0.f;
            if (F.tid < 128) {
                o = (Po[(p * 4 + 0) * 128 + v] + Po[(p * 4 + 1) * 128 + v]) + (Po[(p * 4 + 2) * 128 + v] + Po[(p * 4 + 3) * 128 + v]);
                const float sq = wave_sum(o * o);
                if (F.lane == 0) Red[p * 2 + F.wave] = sq;
            }
            __syncthreads();
            if (F.tid < 128) {
                const float tot = Red[p * 2] + Red[p * 2 + 1];
                const float y = o * (1.0f / sqrtf(tot * (1.0f / HD) + EPS)) * nw * Gs[tt * 128 + v];
                YHG[(size_t)(b * SEQ + t0 + tt) * DM + h * HD + v] = (bf16)f2bf(y);
            }
        }
    }
}

__device__ __forceinline__ void attn_unit_simple(Frame& F, int b, int h, int c) {
    LAS float* Q1 = (LAS float*)F.lds; LAS float* Q2 = Q1 + 64 * 65; LAS float* K1 = Q2 + 64 * 65; LAS float* K2 = K1 + 64 * 65;
    LAS float* Vt = K2 + 64 * 65; LAS float* P1 = Vt + 64 * 132; LAS float* P2 = P1 + 64 * 65;
    const bf16* QDA = wsp<const bf16>(F, WS_QDA); const bf16* KDA = wsp<const bf16>(F, WS_KDA); const bf16* VDA = wsp<const bf16>(F, WS_VDA);
    const int r = F.tid >> 3, p = F.tid & 7;
    const int lr = F.tid >> 3, lc = (F.tid & 7) * 16;
    __syncthreads();
    {
        const bf16* src = QDA + (size_t)(b * SEQ + c * 64 + lr) * HW + h * HD + lc;
        const u32x4 a0 = *(const u32x4*)src, a1 = *(const u32x4*)(src + 8);
        LAS float* d = (lc < 64 ? Q1 + lr * 65 + lc : Q2 + lr * 65 + (lc - 64));
        const unsigned w[8] = {a0.x, a0.y, a0.z, a0.w, a1.x, a1.y, a1.z, a1.w};
#pragma unroll
        for (int i = 0; i < 8; ++i) { d[2 * i] = bf2f(w[i] & 0xffffu); d[2 * i + 1] = bf2f(w[i] >> 16); }
    }
    float m1 = -INFINITY, l1 = 0.f, m2 = -INFINITY, l2 = 0.f;
    float O1[16], O2[16];
#pragma unroll
    for (int i = 0; i < 16; ++i) { O1[i] = 0.f; O2[i] = 0.f; }
    for (int kt = 0; kt <= c; ++kt) {
        __syncthreads();
        {
            const size_t ro = (size_t)(b * SEQ + kt * 64 + lr) * HW + h * HD + lc;
            const u32x4 a0 = *(const u32x4*)(KDA + ro), a1 = *(const u32x4*)(KDA + ro + 8);
            const u32x4 b0 = *(const u32x4*)(VDA + ro), b1 = *(const u32x4*)(VDA + ro + 8);
            LAS float* d = (lc < 64 ? K1 + lr * 65 + lc : K2 + lr * 65 + (lc - 64));
            const unsigned w[8] = {a0.x, a0.y, a0.z, a0.w, a1.x, a1.y, a1.z, a1.w};
#pragma unroll
            for (int i = 0; i < 8; ++i) { d[2 * i] = bf2f(w[i] & 0xffffu); d[2 * i + 1] = bf2f(w[i] >> 16); }
            LAS float* dv = Vt + lr * 132 + lc;
            const unsigned wv[8] = {b0.x, b0.y, b0.z, b0.w, b1.x, b1.y, b1.z, b1.w};
#pragma unroll
            for (int i = 0; i < 8; ++i) { dv[2 * i] = bf2f(wv[i] & 0xffffu); dv[2 * i + 1] = bf2f(wv[i] >> 16); }
        }
        __syncthreads();
        float s1[8], s2[8];
#pragma unroll
        for (int j = 0; j < 8; ++j) { s1[j] = 0.f; s2[j] = 0.f; }
        for (int d = 0; d < 64; ++d) {
            const float q1 = Q1[r * 65 + d], q2 = Q2[r * 65 + d];
#pragma unroll
            for (int j = 0; j < 8; ++j) { s1[j] += q1 * K1[(p * 8 + j) * 65 + d]; s2[j] += q2 * K2[(p * 8 + j) * 65 + d]; }
        }
        float mx1 = s1[0], mx2 = s2[0];
#pragma unroll
        for (int j = 1; j < 8; ++j) { mx1 = fmaxf(mx1, s1[j]); mx2 = fmaxf(mx2, s2[j]); }
#pragma unroll
        for (int o = 1; o < 8; o <<= 1) { mx1 = fmaxf(mx1, __shfl_xor(mx1, o)); mx2 = fmaxf(mx2, __shfl_xor(mx2, o)); }
        const float mn1 = fmaxf(m1, mx1), mn2 = fmaxf(m2, mx2);
        const float al1 = exp2f(m1 - mn1), al2 = exp2f(m2 - mn2);
        float rs1 = 0.f, rs2 = 0.f;
#pragma unroll
        for (int j = 0; j < 8; ++j) { const float e1 = exp2f(s1[j] - mn1), e2 = exp2f(s2[j] - mn2); rs1 += e1; rs2 += e2; P1[r * 65 + p * 8 + j] = e1; P2[r * 65 + p * 8 + j] = e2; }
#pragma unroll
        for (int o = 1; o < 8; o <<= 1) { rs1 += __shfl_xor(rs1, o); rs2 += __shfl_xor(rs2, o); }
        l1 = l1 * al1 + rs1; l2 = l2 * al2 + rs2; m1 = mn1; m2 = mn2;
        __syncthreads();
#pragma unroll
        for (int i = 0; i < 16; ++i) { O1[i] *= al1; O2[i] *= al2; }
        for (int k = 0; k < 64; ++k) {
            const float p1 = P1[r * 65 + k], p2 = P2[r * 65 + k];
#pragma unroll
            for (int i4 = 0; i4 < 4; ++i4) {
                const f32x4 vv = *(const LAS f32x4*)&Vt[k * 132 + p * 16 + i4 * 4];
#pragma unroll
                for (int i = 0; i < 4; ++i) { O1[i4 * 4 + i] += p1 * vv[i]; O2[i4 * 4 + i] += p2 * vv[i]; }
            }
        }
    }
    const float i1 = 1.0f / l1, i2 = 1.0f / l2;
    float o1[8], o2[8];
    bf16* Ob1 = wsp<bf16>(F, WS_O1) + (size_t)(b * SEQ + c * 64 + r) * HW + h * HD + p * 16;
    bf16* Ob2 = wsp<bf16>(F, WS_O2) + (size_t)(b * SEQ + c * 64 + r) * HW + h * HD + p * 16;
#pragma unroll
    for (int hh = 0; hh < 2; ++hh) {
#pragma unroll
        for (int i = 0; i < 8; ++i) { o1[i] = O1[hh * 8 + i] * i1; o2[i] = O2[hh * 8 + i] * i2; }
        store8_bf16(Ob1 + hh * 8, o1); store8_bf16(Ob2 + hh * 8, o2);
    }
}

__device__ __forceinline__ void hgrn_chain_fast(Frame& F, int ch);
__device__ __forceinline__ void ph_mix_simple(Frame& F) {
#if FAST_HGRN
    for (int ch = F.bid; ch < NB * NH; ch += F.G) hgrn_chain_fast(F, ch);
#else
    for (int ch = F.bid; ch < NB * NH; ch += F.G) hgrn_chain_simple(F, ch);
#endif
    for (int u = F.bid; u < NB * NH * 32; u += F.G) {
        const int c = 31 - (u >> 6), bh = u & 63;
        attn_unit_simple(F, bh >> 3, bh & 7, c);
    }
}

__device__ __forceinline__ void ph_yda(Frame& F) {
    const int gw = F.bid * NWAVES + F.wave, NGW = F.G * NWAVES;
    const float lam = *wsp<const float>(F, WS_LAM);
    const bf16* O1 = wsp<const bf16>(F, WS_O1); const bf16* O2 = wsp<const bf16>(F, WS_O2); bf16* YDA = wsp<bf16>(F, WS_YDA);
    for (int row = gw; row < T; row += NGW) {
        const size_t off = (size_t)row * HW + F.lane * 16;
        const u32x4 a0 = *(const u32x4*)(O1 + off), a1 = *(const u32x4*)(O1 + off + 8), b0 = *(const u32x4*)(O2 + off), b1 = *(const u32x4*)(O2 + off + 8);
        const unsigned wa[8] = {a0.x, a0.y, a0.z, a0.w, a1.x, a1.y, a1.z, a1.w}, wb[8] = {b0.x, b0.y, b0.z, b0.w, b1.x, b1.y, b1.z, b1.w};
        float o[16]; float s = 0.f;
#pragma unroll
        for (int i = 0; i < 8; ++i) {
            o[2 * i] = bf2f(wa[i] & 0xffffu) - lam * bf2f(wb[i] & 0xffffu); o[2 * i + 1] = bf2f(wa[i] >> 16) - lam * bf2f(wb[i] >> 16);
            s += o[2 * i] * o[2 * i] + o[2 * i + 1] * o[2 * i + 1];
        }
        s += __shfl_xor(s, 1); s += __shfl_xor(s, 2); s += __shfl_xor(s, 4);
        const float rs = (1.0f / sqrtf(s * (1.0f / HD) + EPS)) * (1.0f - LAMBDA_INIT);
        float y[8];
#pragma unroll
        for (int hh = 0; hh < 2; ++hh) {
#pragma unroll
            for (int i = 0; i < 8; ++i) y[i] = o[hh * 8 + i] * rs * F.da_nw[F.lane * 16 + hh * 8 + i];
            store8_bf16(YDA + (size_t)row * DM + F.lane * 16 + hh * 8, y);
        }
    }
}

struct EpiBr1 { const Frame* F; int m0; __device__ __forceinline__ void operator()(int r, int col0, const float (&v)[8]) const {
    const size_t off = (size_t)(m0 + r) * DM + col0; const u32x4 g = *(const u32x4*)(wsp<const bf16>(*F, WS_GATEH) + off);
    float* o = wsp<float>(*F, WS_TMP) + off; const unsigned w[4] = {g.x, g.y, g.z, g.w};
    f32x4 o0, o1;
#pragma unroll
    for (int i = 0; i < 4; ++i) { const float a = v[2 * i] * bf2f(w[i] & 0xffffu), b = v[2 * i + 1] * bf2f(w[i] >> 16); if (i < 2) { o0[2 * i] = a; o0[2 * i + 1] = b; } else { o1[2 * i - 4] = a; o1[2 * i - 3] = b; } }
    *(f32x4*)o = o0; *(f32x4*)(o + 4) = o1; } };
struct EpiBr2 { const Frame* F; int m0; __device__ __forceinline__ void operator()(int r, int col0, const float (&v)[8]) const {
    const size_t off = (size_t)(m0 + r) * DM + col0; const u32x4 g = *(const u32x4*)(wsp<const bf16>(*F, WS_GATED) + off);
    const float* t = wsp<const float>(*F, WS_TMP) + off; const f32x4 t0 = *(const f32x4*)t, t1 = *(const f32x4*)(t + 4); const unsigned w[4] = {g.x, g.y, g.z, g.w};
    float o[8];
#pragma unroll
    for (int i = 0; i < 4; ++i) { o[2 * i] = (i < 2 ? t0[2 * i] : t1[2 * i - 4]) + v[2 * i] * bf2f(w[i] & 0xffffu); o[2 * i + 1] = (i < 2 ? t0[2 * i + 1] : t1[2 * i - 3]) + v[2 * i + 1] * bf2f(w[i] >> 16); }
    store8_bf16(wsp<bf16>(*F, WS_MERGED) + off, o); } };
__device__ __forceinline__ void ph_branch_simple(Frame& F) {
    LAS float* As = (LAS float*)F.lds; LAS float* Bs = As + 16 * 132;
    const int NT_ = DM / 128, MT_ = T / 128;
    for (int t = F.bid; t < NT_ * MT_; t += F.G) {
        const int mt = t / NT_, nt = t % NT_;
        RowsDense rows{mt * 128};
        EpiBr1 e1{&F, mt * 128}; sg_tile(As, Bs, wsp<const bf16>(F, WS_YHG), DM, rows, F.w_bhg, DM, nt * 128, HW, e1);
        EpiBr2 e2{&F, mt * 128}; sg_tile(As, Bs, wsp<const bf16>(F, WS_YDA), DM, rows, F.w_bda, DM, nt * 128, HW, e2);
    }
}
struct EpiU { const Frame* F; int m0; __device__ __forceinline__ void operator()(int r, int col0, const float (&v)[8]) const { store8_bf16(wsp<bf16>(*F, WS_U) + (size_t)(m0 + r) * DM + col0, v); } };
__device__ __forceinline__ void ph_wout_simple(Frame& F) {
    LAS float* As = (LAS float*)F.lds; LAS float* Bs = As + 16 * 132;
    const int NT_ = DM / 128, MT_ = T / 128;
    for (int t = F.bid; t < NT_ * MT_; t += F.G) {
        const int mt = t / NT_, nt = t % NT_;
        RowsDense rows{mt * 128}; EpiU e{&F, mt * 128};
        sg_tile(As, Bs, wsp<const bf16>(F, WS_MERGED), DM, rows, F.w_out, DM, nt * 128, DM, e);
    }
}

__device__ __forceinline__ void ph_post(Frame& F) {
    LAS float* Lgt = (LAS float*)F.lds; LAS float* Lsh = Lgt + DM; LAS float* Lsc = Lsh + DM;
    LAS float* Lh = Lsc + DM + F.wave * DM;
    const bf16* U = wsp<const bf16>(F, WS_U); bf16* X1 = wsp<bf16>(F, WS_X1); bf16* H2 = wsp<bf16>(F, WS_H2);
    int* TOKE = wsp<int>(F, WS_TOKE); int* TOKP = wsp<int>(F, WS_TOKP); int* LT = wsp<int>(F, WS_LISTTOK); float* LW = wsp<float>(F, WS_LISTW);
    int curb = -1;
    for (int rb = F.bid; rb < T / 8; rb += F.G) {
        const int batch = rb / (SEQ / 8);
        if (batch != curb) { __syncthreads(); mod_vec(F, Lgt, 2, batch); mod_vec(F, Lsh, 3, batch); mod_vec(F, Lsc, 4, batch); __syncthreads(); curb = batch; }
        const int row = rb * 8 + F.wave;
        f32x4 u[8]; float s = 0.f;
#pragma unroll
        for (int j = 0; j < 8; ++j) {
            const u32x2 w = *(const u32x2*)(U + (size_t)row * DM + 4 * F.lane + 256 * j);
            u[j] = (f32x4){bf2f(w.x & 0xffffu), bf2f(w.x >> 16), bf2f(w.y & 0xffffu), bf2f(w.y >> 16)};
            s += (u[j][0] * u[j][0] + u[j][1] * u[j][1]) + (u[j][2] * u[j][2] + u[j][3] * u[j][3]);
        }
        const float r1 = 1.0f / sqrtf(wave_sum(s) * (1.0f / DM) + EPS);
        float s2 = 0.f;
#pragma unroll
        for (int j = 0; j < 8; ++j) {
            const int c0 = 4 * F.lane + 256 * j;
            const f32x4 xv = *(const f32x4*)(F.x + (size_t)row * DM + c0), w = *(const f32x4*)(F.post_mix + c0), g = *(const LAS f32x4*)(Lgt + c0);
            u[j] = xv + g * (u[j] * r1 * w);
            { u32x2 xo; xo.x = pk2(u[j][0], u[j][1]); xo.y = pk2(u[j][2], u[j][3]); *(u32x2*)(X1 + (size_t)row * DM + c0) = xo; }
            s2 += (u[j][0] * u[j][0] + u[j][1] * u[j][1]) + (u[j][2] * u[j][2] + u[j][3] * u[j][3]);
        }
        const float r2 = 1.0f / sqrtf(wave_sum(s2) * (1.0f / DM) + EPS);
#pragma unroll
        for (int j = 0; j < 8; ++j) {
            const int c0 = 4 * F.lane + 256 * j;
            const f32x4 w = *(const f32x4*)(F.pre_ffn + c0), sc = *(const LAS f32x4*)(Lsc + c0), sh = *(const LAS f32x4*)(Lsh + c0);
            u[j] = u[j] * r2 * w * (sc + 1.0f) + sh;
            u32x2 o; o.x = pk2(u[j][0], u[j][1]); o.y = pk2(u[j][2], u[j][3]);
            *(u32x2*)(H2 + (size_t)row * DM + c0) = o;
            *(LAS f32x4*)(Lh + c0) = u[j];
        }
        float elog, glog;
        {
            const int j = F.lane & 31, kh = F.lane >> 5;
            const float* wr = F.w_router + (size_t)(kh * 1024) * 32 + j; const LAS float* hp = Lh + kh * 1024;
            float a0 = 0.f, a1 = 0.f;
#pragma unroll 8
            for (int k = 0; k < 1024; k += 2) { a0 += hp[k] * wr[(size_t)k * 32]; a1 += hp[k + 1] * wr[(size_t)(k + 1) * 32]; }
            float a = a0 + a1; a += __shfl_xor(a, 32);
            elog = a + F.b_router[j];
            const int g = F.lane & 3, kp = F.lane >> 2;
            const float* wg = F.w_group + (size_t)(kp * 128) * 4 + g; const LAS float* hq = Lh + kp * 128;
            float c0 = 0.f;
#pragma unroll 8
            for (int k = 0; k < 128; ++k) c0 += hq[k] * wg[(size_t)k * 4];
            c0 += __shfl_xor(c0, 4); c0 += __shfl_xor(c0, 8); c0 += __shfl_xor(c0, 16); c0 += __shfl_xor(c0, 32);
            glog = c0 + F.b_group[g];
        }
        float lg[4];
#pragma unroll
        for (int i = 0; i < 4; ++i) lg[i] = __shfl(glog, i);
        int gi = 0; float gm = lg[0];
#pragma unroll
        for (int i = 1; i < 4; ++i) if (lg[i] > gm) { gm = lg[i]; gi = i; }
        float gden = 0.f;
#pragma unroll
        for (int i = 0; i < 4; ++i) gden += __expf(lg[i] - gm);
        const float gw_ = 1.0f / gden;
        float ev[8];
#pragma unroll
        for (int i = 0; i < 8; ++i) ev[i] = __shfl(elog, gi * 8 + i);
        int i0 = 0; float v0 = ev[0];
#pragma unroll
        for (int i = 1; i < 8; ++i) if (ev[i] > v0) { v0 = ev[i]; i0 = i; }
        int i1 = -1; float v1 = -INFINITY;
#pragma unroll
        for (int i = 0; i < 8; ++i) if (i != i0 && ev[i] > v1) { v1 = ev[i]; i1 = i; }
        const float e1 = __expf(v1 - v0); const float w0 = gw_ / (1.0f + e1), w1 = gw_ * e1 / (1.0f + e1);
        if (F.lane == 0) {
            const int ea = gi * 8 + i0, eb = gi * 8 + i1;
            const int pa = (int)__hip_atomic_fetch_add((unsigned*)(F.ctl + CW_CNT + 16 * ea), 1u, RLX_AGENT);
            const int pb = (int)__hip_atomic_fetch_add((unsigned*)(F.ctl + CW_CNT + 16 * eb), 1u, RLX_AGENT);
            TOKE[row * 2] = ea; TOKE[row * 2 + 1] = eb; TOKP[row * 2] = pa; TOKP[row * 2 + 1] = pb;
            LT[ea * 16384 + pa] = row; LW[ea * 16384 + pa] = w0; LT[eb * 16384 + pb] = row; LW[eb * 16384 + pb] = w1;
        }
    }
#undef POST_LOAD
}


__device__ __forceinline__ void ph_post_fast(Frame& F) {
    LAS float* Hs = (LAS float*)F.lds;
    LAS float* Ps = Hs;
    LAS float* Lg = (LAS float*)(F.lds + 131200);
    const bf16* U = wsp<const bf16>(F, WS_U); bf16* X1 = wsp<bf16>(F, WS_X1); unsigned char* H2 = wsp<unsigned char>(F, WS_H2);
    const float* MODF = wsp<const float>(F, WS_MODF);
    int* TOKE = wsp<int>(F, WS_TOKE); int* TOKP = wsp<int>(F, WS_TOKP); int* LT = wsp<int>(F, WS_LISTTOK); float* LW = wsp<float>(F, WS_LISTW);
    const int l15 = F.lane & 15, kq = F.lane >> 4;
    f32x4 xv2[2][8];
#define POST_LOAD(gg) do { _Pragma("unroll") for (int rr = 0; rr < 2; ++rr) _Pragma("unroll") for (int j = 0; j < 8; ++j) { \
        const size_t off = (size_t)((gg) * 16 + F.wave * 2 + rr) * DM + 4 * F.lane + 256 * j; xv2[rr][j] = *(const f32x4*)(F.x + off); } } while (0)
    if (F.bid < T / 16) POST_LOAD(F.bid);
    for (int g = F.bid; g < T / 16; g += F.G) {
        const int batch = (g * 16) / SEQ;
        const float* Mgt = MODF + (batch * 6 + 2) * DM; const float* Msh = MODF + (batch * 6 + 3) * DM; const float* Msc = MODF + (batch * 6 + 4) * DM;
        __syncthreads();
        {
#pragma unroll 1
            for (int rr = 0; rr < 2; ++rr) {
                int ln = F.lane; asm volatile("" : "+v"(ln));
                const int rl = F.wave * 2 + rr, row = g * 16 + rl;
                f32x4 u[8]; float sq = 0.f;
                {
                    u32x2 uw[8];
#pragma unroll
                    for (int j = 0; j < 8; ++j) uw[j] = *(const u32x2*)(U + (size_t)row * DM + 4 * ln + 256 * j);
#pragma unroll
                    for (int j = 0; j < 8; ++j) {
                        u[j] = (f32x4){bf2f(uw[j].x & 0xffffu), bf2f(uw[j].x >> 16), bf2f(uw[j].y & 0xffffu), bf2f(uw[j].y >> 16)};
                        sq += (u[j][0] * u[j][0] + u[j][1] * u[j][1]) + (u[j][2] * u[j][2] + u[j][3] * u[j][3]);
                    }
                }
                const float r1 = 1.0f / sqrtf(wave_sum(sq) * (1.0f / DM) + EPS);
                float s2 = 0.f;
                {
                    f32x4 w1[8], g1[8];
#pragma unroll
                    for (int j = 0; j < 8; ++j) { const int c0 = 4 * ln + 256 * j; w1[j] = *(const f32x4*)(F.post_mix + c0); g1[j] = *(const f32x4*)(Mgt + c0); }
#pragma unroll
                    for (int j = 0; j < 8; ++j) {
                        const int c0 = 4 * ln + 256 * j;
                        u[j] = (rr == 0 ? xv2[0][j] : xv2[1][j]) + g1[j] * (u[j] * r1 * w1[j]);
                        { u32x2 xo; xo.x = pk2(u[j][0], u[j][1]); xo.y = pk2(u[j][2], u[j][3]); *(u32x2*)(X1 + (size_t)row * DM + c0) = xo; }
                        s2 += (u[j][0] * u[j][0] + u[j][1] * u[j][1]) + (u[j][2] * u[j][2] + u[j][3] * u[j][3]);
                    }
                }
                const float r2 = 1.0f / sqrtf(wave_sum(s2) * (1.0f / DM) + EPS);
                asm volatile("" ::: "memory");
                {
                    f32x4 w2[8], sc2[8], sh2[8];
#pragma unroll
                    for (int j = 0; j < 8; ++j) { const int c0 = 4 * ln + 256 * j; w2[j] = *(const f32x4*)(F.pre_ffn + c0); sc2[j] = *(const f32x4*)(Msc + c0); sh2[j] = *(const f32x4*)(Msh + c0); }
#pragma unroll
                    for (int j = 0; j < 8; ++j) {
                        const int c0 = 4 * ln + 256 * j;
                        const f32x4 hv = u[j] * r2 * w2[j] * (sc2[j] + 1.0f) + sh2[j];
                        *(unsigned*)(H2 + (size_t)row * DM + c0) = pk4_fp8(clamp8(hv[0]), clamp8(hv[1]), clamp8(hv[2]), clamp8(hv[3]));
                        LAS float* hp = Hs + rl * 2050 + c0;
                        *(LAS f32x2_t*)hp = (f32x2_t){hv[0], hv[1]}; *(LAS f32x2_t*)(hp + 2) = (f32x2_t){hv[2], hv[3]};
                    }
                }
                asm volatile("" ::: "memory");
            }
        }
        asm volatile("" ::: "memory");
        if (g + F.G < T / 16) POST_LOAD(g + F.G);
        __syncthreads();
        f32x4 acc[3];
#pragma unroll
        for (int n = 0; n < 3; ++n) acc[n] = (f32x4){0.f, 0.f, 0.f, 0.f};
        {
            typedef short bf16x8_t __attribute__((ext_vector_type(8)));
            const LAS float* ap = Hs + l15 * 2050 + 256 * F.wave + 8 * kq;
            const __amdgpu_buffer_rsrc_t wrs = __builtin_amdgcn_make_buffer_rsrc((void*)wsp<bf16>(F, WS_WCAT), 0, 2 * 48 * DM * 2, 0x00020000);
            const int wvo = (l15 * DM + 256 * F.wave + 8 * kq) * 2;
            bf16x8_t bh[2][2][3], bl[2][2][3];
#define RT_LOADB(buf, sp) do { _Pragma("unroll") for (int s2 = 0; s2 < 2; ++s2) _Pragma("unroll") for (int n = 0; n < 3; ++n) { \
                bh[buf][s2][n] = __builtin_bit_cast(bf16x8_t, __builtin_amdgcn_raw_buffer_load_b128(wrs, wvo, n * 16 * DM * 2 + 64 * (2 * (sp) + s2), 0)); \
                bl[buf][s2][n] = __builtin_bit_cast(bf16x8_t, __builtin_amdgcn_raw_buffer_load_b128(wrs, wvo, 48 * DM * 2 + n * 16 * DM * 2 + 64 * (2 * (sp) + s2), 0)); } } while (0)
            RT_LOADB(0, 0);
#pragma unroll
            for (int sp = 0; sp < 4; ++sp) {
                if (sp + 1 < 4) { if ((sp & 1) == 0) RT_LOADB(1, sp + 1); else RT_LOADB(0, sp + 1); }
#pragma unroll
                for (int s2 = 0; s2 < 2; ++s2) {
                    const int st = 2 * sp + s2;
                    float xv[8];
#pragma unroll
                    for (int q = 0; q < 4; ++q) { const f32x2_t t2 = *(const LAS f32x2_t*)(ap + 32 * st + 2 * q); xv[2 * q] = t2[0]; xv[2 * q + 1] = t2[1]; }
                    u32x4 ah, al;
#pragma unroll
                    for (int q = 0; q < 4; ++q) {
                        const unsigned h = pk2(xv[2 * q], xv[2 * q + 1]);
                        const unsigned l = pk2(xv[2 * q] - bf2f(h & 0xffffu), xv[2 * q + 1] - bf2f(h >> 16));
                        ah[q] = h; al[q] = l;
                    }
                    const bf16x8_t ahi = __builtin_bit_cast(bf16x8_t, ah), alo = __builtin_bit_cast(bf16x8_t, al);
#pragma unroll
                    for (int n = 0; n < 3; ++n) {
                        const bf16x8_t wh = (sp & 1) ? bh[1][s2][n] : bh[0][s2][n], wl = (sp & 1) ? bl[1][s2][n] : bl[0][s2][n];
                        acc[n] = __builtin_amdgcn_mfma_f32_16x16x32_bf16(ahi, wh, acc[n], 0, 0, 0);
                        acc[n] = __builtin_amdgcn_mfma_f32_16x16x32_bf16(alo, wh, acc[n], 0, 0, 0);
                        acc[n] = __builtin_amdgcn_mfma_f32_16x16x32_bf16(ahi, wl, acc[n], 0, 0, 0);
                    }
                }
                asm volatile("" ::: "memory");
            }
#undef RT_LOADB
        }
        __syncthreads();
#pragma unroll
        for (int n = 0; n < 3; ++n)
#pragma unroll
            for (int r = 0; r < 4; ++r) Ps[(F.wave * 16 + 4 * kq + r) * 48 + 16 * n + l15] = acc[n][r];
        __syncthreads();
        for (int o = F.tid; o < 768; o += NTHREADS) {
            float sacc = 0.f;
#pragma unroll
            for (int w8 = 0; w8 < 8; ++w8) sacc += Ps[w8 * 768 + o];
            const int col = o % 48;
            Lg[o] = sacc + (col < 4 ? F.b_group[col] : (col < 36 ? F.b_router[col - 4] : 0.f));
        }
        __syncthreads();
        if (F.lane < 2) {
            const int rl = F.wave * 2 + F.lane, row = g * 16 + rl; const LAS float* lg = Lg + rl * 48;
            int gi = 0; float gm = lg[0];
#pragma unroll
            for (int i = 1; i < 4; ++i) { const float v = lg[i]; if (v > gm) { gm = v; gi = i; } }
            float gden = 0.f;
#pragma unroll
            for (int i = 0; i < 4; ++i) gden += __expf(lg[i] - gm);
            const float gw_ = 1.0f / gden;
            const LAS float* ev = lg + 4 + gi * 8;
            int i0 = 0; float v0 = ev[0];
#pragma unroll
            for (int i = 1; i < 8; ++i) { const float v = ev[i]; if (v > v0) { v0 = v; i0 = i; } }
            int i1 = -1; float v1 = -INFINITY;
#pragma unroll
            for (int i = 0; i < 8; ++i) { const float v = ev[i]; if (i != i0 && v > v1) { v1 = v; i1 = i; } }
            const float e1 = __expf(v1 - v0); const float w0 = gw_ / (1.0f + e1), w1 = gw_ * e1 / (1.0f + e1);
            const int ea = gi * 8 + i0, eb = gi * 8 + i1;
            const int pa = (int)__hip_atomic_fetch_add((unsigned*)(F.ctl + CW_CNT + 16 * ea), 1u, RLX_AGENT);
            const int pb = (int)__hip_atomic_fetch_add((unsigned*)(F.ctl + CW_CNT + 16 * eb), 1u, RLX_AGENT);
            TOKE[row * 2] = ea; TOKE[row * 2 + 1] = eb; TOKP[row * 2] = pa; TOKP[row * 2 + 1] = pb;
            LT[ea * 16384 + pa] = row; LW[ea * 16384 + pa] = w0; LT[eb * 16384 + pb] = row; LW[eb * 16384 + pb] = w1;
        }
    }
}
__device__ __forceinline__ void expert_tables(Frame& F, LAS int* tab, int tile_rows) {
    if (F.tid < NE) tab[F.tid] = (int)__hip_atomic_load((unsigned*)(F.ctl + CW_CNT + 16 * F.tid), RLX_AGENT);
    __syncthreads();
    if (F.tid == 0) {
        int ps = 0, ts = 0;
#pragma unroll 8
        for (int e = 0; e < NE; ++e) {
            const int c = tab[e];
            tab[32 + e] = ps; tab[72 + e] = ts;
            ps += (c + 255) / 256 * 256; ts += (c + tile_rows - 1) / tile_rows;
        }
        tab[32 + NE] = ps; tab[72 + NE] = ts;
    }
    __syncthreads();
}

struct EpiG { const Frame* F; int slot0, n; __device__ __forceinline__ void operator()(int r, int col0, const float (&v)[8]) const {
    if (r >= n) return; float* o = wsp<float>(*F, WS_TMPG) + (size_t)(slot0 + r) * DE + col0;
    f32x4 o0, o1;
#pragma unroll
    for (int i = 0; i < 8; ++i) { const float s = v[i] * sigmoidf_(v[i]); if (i < 4) o0[i] = s; else o1[i - 4] = s; }
    *(f32x4*)o = o0; *(f32x4*)(o + 4) = o1; } };
struct EpiUp { const Frame* F; int slot0, n; __device__ __forceinline__ void operator()(int r, int col0, const float (&v)[8]) const {
    if (r >= n) return; const float* t = wsp<const float>(*F, WS_TMPG) + (size_t)(slot0 + r) * DE + col0; const f32x4 t0 = *(const f32x4*)t, t1 = *(const f32x4*)(t + 4);
    float o[8];
#pragma unroll
    for (int i = 0; i < 8; ++i) o[i] = (i < 4 ? t0[i] : t1[i - 4]) * v[i];
    store8_bf16(wsp<bf16>(*F, WS_ACT) + (size_t)(slot0 + r) * DE + col0, o); } };
__device__ __forceinline__ void ph_moe1_simple(Frame& F) {
    LAS float* As = (LAS float*)F.lds; LAS float* Bs = As + 16 * 132; LAS int* tab = (LAS int*)(Bs + 16 * 132);
    expert_tables(F, tab, 128);
    const int NT_ = DE / 128, ntl = tab[72 + NE] * NT_;
    for (int t = F.bid; t < ntl; t += F.G) {
        const int mtg = t / NT_, nt = t % NT_;
        int e = 0;
#pragma unroll 1
        for (int q = 1; q < NE; ++q) if (tab[72 + q] <= mtg) e = q;
        const int mt = mtg - tab[72 + e], n = min(128, tab[e] - mt * 128), slot0 = tab[32 + e] + mt * 128;
        RowsList rows{wsp<const int>(F, WS_LISTTOK) + e * 16384 + mt * 128, n};
        EpiG eg{&F, slot0, n}; sg_tile(As, Bs, wsp<const bf16>(F, WS_H2), DM, rows, F.w_gate + (size_t)e * DM * DE, DE, nt * 128, DM, eg);
        EpiUp eu{&F, slot0, n}; sg_tile(As, Bs, wsp<const bf16>(F, WS_H2), DM, rows, F.w_up + (size_t)e * DM * DE, DE, nt * 128, DM, eu);
    }
}
struct EpiDown { const Frame* F; int slot0, n; const float* lw; __device__ __forceinline__ void operator()(int r, int col0, const float (&v)[8]) const {
    if (r >= n) return; const float w = lw[r]; float o[8];
#pragma unroll
    for (int i = 0; i < 8; ++i) o[i] = v[i] * w;
    store8_bf16(wsp<bf16>(*F, WS_YW) + (size_t)(slot0 + r) * DM + col0, o); } };
__device__ __forceinline__ void ph_moe2_simple(Frame& F) {
    LAS float* As = (LAS float*)F.lds; LAS float* Bs = As + 16 * 132; LAS int* tab = (LAS int*)(Bs + 16 * 132);
    expert_tables(F, tab, 128);
    const int NT_ = DM / 128, ntl = tab[72 + NE] * NT_;
    for (int t = F.bid; t < ntl; t += F.G) {
        const int mtg = t / NT_, nt = t % NT_;
        int e = 0;
#pragma unroll 1
        for (int q = 1; q < NE; ++q) if (tab[72 + q] <= mtg) e = q;
        const int mt = mtg - tab[72 + e], n = min(128, tab[e] - mt * 128), slot0 = tab[32 + e] + mt * 128;
        RowsDense rows{slot0};
        EpiDown ed{&F, slot0, n, wsp<const float>(F, WS_LISTW) + e * 16384 + mt * 128};
        sg_tile(As, Bs, wsp<const bf16>(F, WS_ACT), DE, rows, F.w_down + (size_t)e * DE * DM, DM, nt * 128, DE, ed);
    }
}

__device__ __forceinline__ void ph_final(Frame& F) {
    LAS int* tab = (LAS int*)F.lds;
    expert_tables(F, tab, 128);
    const bf16* X1 = wsp<const bf16>(F, WS_X1); const unsigned char* YW = wsp<const unsigned char>(F, WS_YW); const float* MODF = wsp<const float>(F, WS_MODF);
    const int* TOKE = wsp<const int>(F, WS_TOKE); const int* TOKP = wsp<const int>(F, WS_TOKP); const float* LW = wsp<const float>(F, WS_LISTW);
    const int gw = F.bid * NWAVES + F.wave, NGW = F.G * NWAVES;
    for (int rp = gw; rp < T / 2; rp += NGW) {
        const int row0 = rp * 2;
        int ln = F.lane; asm volatile("" : "+v"(ln));
        const float* Mgt = MODF + ((row0 / SEQ) * 6 + 5) * DM;
        int sl[2][2]; float rw[2][2];
#pragma unroll
        for (int r = 0; r < 2; ++r)
#pragma unroll
            for (int q = 0; q < 2; ++q) { const int e_ = TOKE[(row0 + r) * 2 + q], p_ = TOKP[(row0 + r) * 2 + q]; sl[r][q] = tab[32 + e_] + p_; rw[r][q] = LW[e_ * 16384 + p_] * Y8I; }
        unsigned ya[2][8], yb[2][8]; u32x2 xr[2][8];
#pragma unroll
        for (int r = 0; r < 2; ++r)
#pragma unroll
            for (int j = 0; j < 8; ++j) { const int c0 = 4 * ln + 256 * j; ya[r][j] = *(const unsigned*)(YW + (size_t)sl[r][0] * DM + c0); yb[r][j] = *(const unsigned*)(YW + (size_t)sl[r][1] * DM + c0);
                xr[r][j] = *(const u32x2*)(X1 + (size_t)(row0 + r) * DM + c0); }
        f32x4 wv[8], gv[8];
#pragma unroll
        for (int j = 0; j < 8; ++j) { const int c0 = 4 * ln + 256 * j; wv[j] = *(const f32x4*)(F.post_ffn + c0); gv[j] = *(const f32x4*)(Mgt + c0); }
#pragma unroll
        for (int r = 0; r < 2; ++r) {
            f32x4 y[8]; float s = 0.f;
#pragma unroll
            for (int j = 0; j < 8; ++j) {
                const f32x2_t a0 = __builtin_amdgcn_cvt_pk_f32_fp8((int)ya[r][j], false), a1 = __builtin_amdgcn_cvt_pk_f32_fp8((int)ya[r][j], true);
                const f32x2_t b0 = __builtin_amdgcn_cvt_pk_f32_fp8((int)yb[r][j], false), b1 = __builtin_amdgcn_cvt_pk_f32_fp8((int)yb[r][j], true);
                y[j] = (f32x4){a0[0] * rw[r][0] + b0[0] * rw[r][1], a0[1] * rw[r][0] + b0[1] * rw[r][1], a1[0] * rw[r][0] + b1[0] * rw[r][1], a1[1] * rw[r][0] + b1[1] * rw[r][1]};
                s += (y[j][0] * y[j][0] + y[j][1] * y[j][1]) + (y[j][2] * y[j][2] + y[j][3] * y[j][3]);
            }
            const float rn = 1.0f / sqrtf(wave_sum(s) * (1.0f / DM) + EPS);
#pragma unroll
            for (int j = 0; j < 8; ++j) {
                const int c0 = 4 * ln + 256 * j;
                const f32x4 xv = (f32x4){bf2f(xr[r][j].x & 0xffffu), bf2f(xr[r][j].x >> 16), bf2f(xr[r][j].y & 0xffffu), bf2f(xr[r][j].y >> 16)};
                *(f32x4*)(F.out + (size_t)(row0 + r) * DM + c0) = xv + gv[j] * (y[j] * rn * wv[j]);
            }
        }
    }
}


#define T_LOAD32(tv, RS, N, k0, n0) do { const int vo_ = ((8 * (lane >> 3)) * (N) + (n0) + 4 * (lane & 7)) * 4; \
        _Pragma("unroll") for (int i = 0; i < 8; ++i) tv[i] = __builtin_bit_cast(f32x4, __builtin_amdgcn_raw_buffer_load_b128(RS, vo_, ((k0) + i) * (N) * 4, 2)); } while (0)
#define T_STORE32F8(tv, WT, K, k0, drow) do { _Pragma("unroll") for (int j = 0; j < 4; ++j) { \
        u32x2 o_; o_.x = pk4_fp8(tv[0][j] * W8S, tv[1][j] * W8S, tv[2][j] * W8S, tv[3][j] * W8S); o_.y = pk4_fp8(tv[4][j] * W8S, tv[5][j] * W8S, tv[6][j] * W8S, tv[7][j] * W8S); \
        *(u32x2*)((WT) + (size_t)((drow) + 4 * (lane & 7) + j) * (K) + (k0) + 8 * (lane >> 3)) = o_; } } while (0)
#define T_STORE32(tv, WT, K, k0, drow) do { _Pragma("unroll") for (int j = 0; j < 4; ++j) { \
        u32x4 o_; o_.x = pk2(tv[0][j], tv[1][j]); o_.y = pk2(tv[2][j], tv[3][j]); o_.z = pk2(tv[4][j], tv[5][j]); o_.w = pk2(tv[6][j], tv[7][j]); \
        *(u32x4*)((WT) + (size_t)((drow) + 4 * (lane & 7) + j) * (K) + (k0) + 8 * (lane >> 3)) = o_; } } while (0)
namespace hg {
typedef short bf16x8 __attribute__((ext_vector_type(8)));
typedef short bf16x4 __attribute__((ext_vector_type(4)));
constexpr int QE_OFF = 0, KE_OFF = 17408, KDT_OFF = 34816, VT_OFF = 53248, AM_OFF = 71680, OB_OFF = 80896, SEG_OFF = 114688, DV_OFF = 118784;
constexpr int QROW = 272, TROW = 144, OROW = 528;
__device__ __forceinline__ bf16x8 cat8(bf16x4 a, bf16x4 b) { return (bf16x8){a[0], a[1], a[2], a[3], b[0], b[1], b[2], b[3]}; }
}
__device__ __forceinline__ void hgrn_chain_fast(Frame& F, int ch) {
    using namespace hg;
    const int b = ch >> 3, h = ch & 7;
    const int lane = F.lane, w = F.wave, tid = F.tid;
    LAS unsigned char* L = F.lds;
    const int l15 = lane & 15, kq = lane >> 4;
    const float* LOGF = wsp<const float>(F, WS_LOGF); const bf16* QHG = wsp<const bf16>(F, WS_QHG); const bf16* VHG = wsp<const bf16>(F, WS_VHG); const bf16* GHG = wsp<const bf16>(F, WS_GHG);
    bf16* YHG = wsp<bf16>(F, WS_YHG);
    const size_t rowbase = (size_t)(b * SEQ) * HW + h * HD;
    f32x4 S[8];
#pragma unroll
    for (int i = 0; i < 8; ++i) S[i] = (f32x4){0.f, 0.f, 0.f, 0.f};
    float lf[8][2]; unsigned qv[8], vv[8]; u32x4 gq[2];
    const int nt_ = tid >> 3, nvg = tid & 7;
#define HG_LOAD(c) do { _Pragma("unroll") for (int i = 0; i < 8; ++i) { const size_t off = rowbase + (size_t)((c) * 64 + 8 * w + i) * HW + 2 * lane; \
        const u32x2 t2 = *(const u32x2*)(LOGF + off); lf[i][0] = __uint_as_float(t2.x); lf[i][1] = __uint_as_float(t2.y); qv[i] = *(const unsigned*)(QHG + off); vv[i] = *(const unsigned*)(VHG + off); } \
        { const bf16* gp = GHG + rowbase + (size_t)((c) * 64 + nt_) * HW + 16 * nvg; gq[0] = *(const u32x4*)gp; gq[1] = *(const u32x4*)(gp + 8); } } while (0)
    f32x4 nwv[4];
#pragma unroll
    for (int i = 0; i < 4; ++i) nwv[i] = *(const f32x4*)(F.hg_nw + h * HD + 16 * nvg + 4 * i);
    HG_LOAD(0);
    __syncthreads();
    for (int c = 0; c < SEQ / 64; ++c) {
        float sum0 = lf[0][0], sum1 = lf[0][1];
#pragma unroll
        for (int i = 1; i < 8; ++i) { sum0 += lf[i][0]; sum1 += lf[i][1]; }
        *(LAS f32x2_t*)(L + SEG_OFF + (w * 128 + 2 * lane) * 4) = (f32x2_t){sum0, sum1};
        __syncthreads();
        float base0 = 0.f, base1 = 0.f, tot0 = 0.f, tot1 = 0.f;
#pragma unroll
        for (int s_ = 0; s_ < 8; ++s_) { const f32x2_t sv = *(const LAS f32x2_t*)(L + SEG_OFF + (s_ * 128 + 2 * lane) * 4); tot0 += sv[0]; tot1 += sv[1]; if (s_ < w) { base0 += sv[0]; base1 += sv[1]; } }
        const float eb0 = __expf(tot0), eb1 = __expf(tot1);
        float E0 = __expf(base0), E1 = __expf(base1);
        unsigned kd0[4], kd1[4], vt0[4], vt1[4];
#pragma unroll
        for (int i = 0; i < 8; ++i) {
            const float f0 = __expf(lf[i][0]), f1 = __expf(lf[i][1]);
            E0 *= f0; E1 *= f1;
            const float q0 = bf2f(qv[i] & 0xffffu), q1 = bf2f(qv[i] >> 16);
            const float qe0 = q0 * E0, qe1 = q1 * E1;
            const float ke0 = (1.0f - f0) * __builtin_amdgcn_rcpf(E0), ke1 = (1.0f - f1) * __builtin_amdgcn_rcpf(E1);
            const float d0 = ke0 * eb0, d1 = ke1 * eb1;
            *(LAS unsigned*)(L + QE_OFF + (8 * w + i) * QROW + 4 * lane) = pk2(qe0, qe1);
            *(LAS unsigned*)(L + KE_OFF + (8 * w + i) * QROW + 4 * lane) = pk2(ke0, ke1);
            const unsigned dd0 = f2bf(d0), dd1 = f2bf(d1);
            if (i & 1) { kd0[i >> 1] |= dd0 << 16; kd1[i >> 1] |= dd1 << 16; vt0[i >> 1] |= (vv[i] & 0xffffu) << 16; vt1[i >> 1] |= (vv[i] >> 16) << 16; }
            else { kd0[i >> 1] = dd0; kd1[i >> 1] = dd1; vt0[i >> 1] = vv[i] & 0xffffu; vt1[i >> 1] = vv[i] >> 16; }
        }
        *(LAS u32x4*)(L + KDT_OFF + (2 * lane) * TROW + 16 * w) = (u32x4){kd0[0], kd0[1], kd0[2], kd0[3]};
        *(LAS u32x4*)(L + KDT_OFF + (2 * lane + 1) * TROW + 16 * w) = (u32x4){kd1[0], kd1[1], kd1[2], kd1[3]};
        *(LAS u32x4*)(L + VT_OFF + (2 * lane) * TROW + 16 * w) = (u32x4){vt0[0], vt0[1], vt0[2], vt0[3]};
        *(LAS u32x4*)(L + VT_OFF + (2 * lane + 1) * TROW + 16 * w) = (u32x4){vt1[0], vt1[1], vt1[2], vt1[3]};
        if (w == 0) *(LAS f32x2_t*)(L + DV_OFF + 8 * lane) = (f32x2_t){eb0, eb1};
        u32x4 gcur[2] = {gq[0], gq[1]};
        if (c + 1 < SEQ / 64) HG_LOAD(c + 1);
        f32x4 twa[8], twb[8];
        const bool tjob = ((w + c) & 1) == 0;
        const int tid_ = (ch * (SEQ / 64) + c) * 4 + (w >> 1), te = tid_ >> 8, tkp = 4 + ((tid_ & 255) >> 6), tnb = tid_ & 63;
        const __amdgpu_buffer_rsrc_t trs = __builtin_amdgcn_make_buffer_rsrc((void*)(F.w_down + (size_t)te * DE * DM), 0, DM * DE * 4, 0x00020000);
        if (tjob) { const int vo_ = ((16 * (lane >> 3)) * DM + tnb * 32 + 4 * (lane & 7)) * 4;
#pragma unroll
            for (int i = 0; i < 8; ++i) twa[i] = __builtin_bit_cast(f32x4, __builtin_amdgcn_raw_buffer_load_b128(trs, vo_, (tkp * 128 + i) * DM * 4, 2));
#pragma unroll
            for (int i = 0; i < 8; ++i) twb[i] = __builtin_bit_cast(f32x4, __builtin_amdgcn_raw_buffer_load_b128(trs, vo_, (tkp * 128 + 8 + i) * DM * 4, 2)); }
        __syncthreads();
        {
            const int ti = w >> 1;
#pragma unroll
            for (int sj = 0; sj < 2; ++sj) {
                const int si = 2 * (w & 1) + sj;
                f32x4 a = (f32x4){0.f, 0.f, 0.f, 0.f};
                if (si <= ti) {
#pragma unroll
                    for (int j = 0; j < 4; ++j) {
                        const bf16x8 ka = *(const LAS bf16x8*)(L + KE_OFF + (16 * si + l15) * QROW + (32 * j + 8 * kq) * 2);
                        const bf16x8 qb = *(const LAS bf16x8*)(L + QE_OFF + (16 * ti + l15) * QROW + (32 * j + 8 * kq) * 2);
                        a = __builtin_amdgcn_mfma_f32_16x16x32_bf16(ka, qb, a, 0, 0, 0);
                    }
                    const int t = 16 * ti + l15, s0 = 16 * si + 4 * kq;
#pragma unroll
                    for (int r = 0; r < 4; ++r) if (s0 + r > t) a[r] = 0.f;
                }
                *(LAS u32x2*)(L + AM_OFF + (16 * ti + l15) * TROW + (16 * si + 4 * kq) * 2) = (u32x2){pk2(a[0], a[1]), pk2(a[2], a[3])};
            }
        }
        __syncthreads();
        {
            bf16x8 vf[2];
#pragma unroll
            for (int j = 0; j < 2; ++j) vf[j] = *(const LAS bf16x8*)(L + VT_OFF + (16 * w + l15) * TROW + (32 * j + 8 * kq) * 2);
            bf16x8 sb[4];
#pragma unroll
            for (int j = 0; j < 4; ++j) { const u32x4 t4 = (u32x4){pk2(S[2 * j][0], S[2 * j][1]), pk2(S[2 * j][2], S[2 * j][3]), pk2(S[2 * j + 1][0], S[2 * j + 1][1]), pk2(S[2 * j + 1][2], S[2 * j + 1][3])}; sb[j] = __builtin_bit_cast(bf16x8, t4); }
#pragma unroll
            for (int ti = 0; ti < 4; ++ti) {
                f32x4 o = (f32x4){0.f, 0.f, 0.f, 0.f};
#pragma unroll
                for (int j = 0; j < 2; ++j) { const bf16x8 am = *(const LAS bf16x8*)(L + AM_OFF + (16 * ti + l15) * TROW + (32 * j + 8 * kq) * 2); o = __builtin_amdgcn_mfma_f32_16x16x32_bf16(am, vf[j], o, 0, 0, 0); }
#pragma unroll
                for (int j = 0; j < 4; ++j) {
                    const bf16x4 lo = *(const LAS bf16x4*)(L + QE_OFF + (16 * ti + l15) * QROW + (32 * j + 4 * kq) * 2);
                    const bf16x4 hi = *(const LAS bf16x4*)(L + QE_OFF + (16 * ti + l15) * QROW + (32 * j + 16 + 4 * kq) * 2);
                    o = __builtin_amdgcn_mfma_f32_16x16x32_bf16(cat8(lo, hi), sb[j], o, 0, 0, 0);
                }
#pragma unroll
                for (int r = 0; r < 4; ++r) *(LAS float*)(L + OB_OFF + (16 * ti + 4 * kq + r) * OROW + (16 * w + l15) * 4) = o[r];
            }
#pragma unroll
            for (int kt = 0; kt < 8; ++kt) {
                const f32x4 dv = *(const LAS f32x4*)(L + DV_OFF + (16 * kt + 4 * kq) * 4);
                f32x4 cacc = S[kt] * dv;
#pragma unroll
                for (int j = 0; j < 2; ++j) { const bf16x8 kd = *(const LAS bf16x8*)(L + KDT_OFF + (16 * kt + l15) * TROW + (32 * j + 8 * kq) * 2); cacc = __builtin_amdgcn_mfma_f32_16x16x32_bf16(kd, vf[j], cacc, 0, 0, 0); }
                S[kt] = cacc;
            }
        }
        __syncthreads();
        {
            f32x4 o4[4]; float ss = 0.f;
#pragma unroll
            for (int i = 0; i < 4; ++i) { o4[i] = *(const LAS f32x4*)(L + OB_OFF + nt_ * OROW + (16 * nvg + 4 * i) * 4); ss += (o4[i][0] * o4[i][0] + o4[i][1] * o4[i][1]) + (o4[i][2] * o4[i][2] + o4[i][3] * o4[i][3]); }
            ss += __shfl_xor(ss, 1); ss += __shfl_xor(ss, 2); ss += __shfl_xor(ss, 4);
            const float rstd = 1.0f / sqrtf(ss * (1.0f / HD) + EPS);
            float y[8];
            bf16* yp = YHG + (size_t)(b * SEQ + c * 64 + nt_) * DM + h * HD + 16 * nvg;
#pragma unroll
            for (int hh = 0; hh < 2; ++hh) {
                const f32x4 n0 = nwv[2 * hh], n1 = nwv[2 * hh + 1];
                const u32x4 g = gcur[hh];
                y[0] = o4[2 * hh][0] * rstd * n0[0] * bf2f(g.x & 0xffffu); y[1] = o4[2 * hh][1] * rstd * n0[1] * bf2f(g.x >> 16);
                y[2] = o4[2 * hh][2] * rstd * n0[2] * bf2f(g.y & 0xffffu); y[3] = o4[2 * hh][3] * rstd * n0[3] * bf2f(g.y >> 16);
                y[4] = o4[2 * hh + 1][0] * rstd * n1[0] * bf2f(g.z & 0xffffu); y[5] = o4[2 * hh + 1][1] * rstd * n1[1] * bf2f(g.z >> 16);
                y[6] = o4[2 * hh + 1][2] * rstd * n1[2] * bf2f(g.w & 0xffffu); y[7] = o4[2 * hh + 1][3] * rstd * n1[3] * bf2f(g.w >> 16);
                store8_bf16(yp + hh * 8, y);
            }
        }
        if (tjob) { unsigned char* wt_ = wsp<unsigned char>(F, WS_WD_T) + (size_t)te * DM * DE;
#pragma unroll
            for (int j = 0; j < 4; ++j) { u32x4 o_;
                o_.x = pk4_fp8(twa[0][j] * W8S, twa[1][j] * W8S, twa[2][j] * W8S, twa[3][j] * W8S); o_.y = pk4_fp8(twa[4][j] * W8S, twa[5][j] * W8S, twa[6][j] * W8S, twa[7][j] * W8S);
                o_.z = pk4_fp8(twb[0][j] * W8S, twb[1][j] * W8S, twb[2][j] * W8S, twb[3][j] * W8S); o_.w = pk4_fp8(twb[4][j] * W8S, twb[5][j] * W8S, twb[6][j] * W8S, twb[7][j] * W8S);
                *(u32x4*)(wt_ + (size_t)(tnb * 32 + 4 * (lane & 7) + j) * DE + tkp * 128 + 16 * (lane >> 3)) = o_; } }
    }
#undef HG_LOAD
    __syncthreads();
}


#include <hip/hip_bf16.h>
#include <cmath>
namespace attn_body {
using bf16=__hip_bfloat16;
using bf16x8=__attribute__((ext_vector_type(8)))short;
using s16x4=__attribute__((ext_vector_type(4)))short;
using f32x16=__attribute__((ext_vector_type(16)))float;
using u32x4=__attribute__((ext_vector_type(4)))unsigned;
constexpr int SEQ=2048,D=64,DM=1024;
constexpr int NW=8,QBLK=32,QB=QBLK*NW,KVBLK=64,NQB=SEQ/QB;
constexpr int ATTN_PITCH=DM, ATTN_UNIT_ROWS=QB;
__device__ __forceinline__ int crow(int r,int hi){return (r&3)+8*(r>>2)+4*hi;}
#define SBAR() __builtin_amdgcn_sched_barrier(0)
__device__ __forceinline__ void cmask(f32x16&p0,f32x16&p1,int jb,int qrel,int hi){
  const float NEG=-INFINITY;
  if(64*jb>(qrel|63)){
  #pragma unroll
  for(int r=0;r<16;++r){p0[r]=NEG;p1[r]=NEG;} }
}

constexpr int NSLOT=3, SLOTB=8192;
constexpr int LDS_K=0, LDS_V=NSLOT*SLOTB, LDS_WS=2*NSLOT*SLOTB, LDS_OST=LDS_WS+NW*64*4, LDS_BYTES=LDS_OST+NW*4096;
constexpr float C2=0.125f*1.4426950408889634f;
__device__ __forceinline__ void glds16(const void*gsrc,unsigned lds_dst){unsigned keep;
  asm volatile("s_mov_b32 %0, m0\n\ts_mov_b32 m0, %2\n\ts_nop 0\n\tglobal_load_lds_dwordx4 %1, off\n\ts_mov_b32 m0, %0":"=&s"(keep):"v"(gsrc),"s"(lds_dst):"memory");}
__device__ __forceinline__ float max3f(float a,float b,float c){float r;asm("v_max3_f32 %0, %1, %2, %3":"=v"(r):"v"(a),"v"(b),"v"(c));return r;}
__device__ __forceinline__ float max2f(float a,float b){float r;asm("v_max_f32_e32 %0, %1, %2":"=v"(r):"v"(a),"v"(b));return r;}
__device__ __forceinline__ float fadd_s(float a,float b){float r;asm("v_add_f32_e32 %0, %1, %2":"=v"(r):"v"(a),"v"(b));return r;}
__device__ __forceinline__ float fsub_s(float a,float b){float r;asm("v_sub_f32_e32 %0, %1, %2":"=v"(r):"v"(a),"v"(b));return r;}
typedef float f32x2_t __attribute__((ext_vector_type(2))); typedef __bf16 bf16x2_t __attribute__((ext_vector_type(2)));
__device__ __forceinline__ unsigned cvtpk_s(float lo,float hi){f32x2_t v={lo,hi};bf16x2_t b=__builtin_convertvector(v,bf16x2_t);return __builtin_bit_cast(unsigned,b);}
#define WAIT_BAR(N) asm volatile("s_waitcnt vmcnt(" #N ") lgkmcnt(0)\n\ts_barrier":::"memory")

__device__ __forceinline__ void qkt(f32x16&p0,f32x16&p1,const char*Kslot,const bf16x8*qr,const f32x16&negm,int r32,int hi){
  const char*kb=Kslot+hi*1024+r32*16;
  #pragma unroll
  for(int d0=0;d0<4;++d0){
    const bf16x8 b0=*reinterpret_cast<const bf16x8*>(kb+d0*2048);
    const bf16x8 b1=*reinterpret_cast<const bf16x8*>(kb+d0*2048+512);
    if(d0==0){p0=__builtin_amdgcn_mfma_f32_32x32x16_bf16(b0,qr[0],negm,0,0,0);p1=__builtin_amdgcn_mfma_f32_32x32x16_bf16(b1,qr[0],negm,0,0,0);}
    else{p0=__builtin_amdgcn_mfma_f32_32x32x16_bf16(b0,qr[d0],p0,0,0,0);p1=__builtin_amdgcn_mfma_f32_32x32x16_bf16(b1,qr[d0],p1,0,0,0);}}
}
typedef __attribute__((address_space(3))) const char* lds_cptr;
typedef short v4i16_t __attribute__((ext_vector_type(4)));
__device__ __forceinline__ void kload8(bf16x8*kf,lds_cptr kp){
  kf[0]=*(const __attribute__((address_space(3))) bf16x8*)(kp);      kf[1]=*(const __attribute__((address_space(3))) bf16x8*)(kp+512);
  kf[2]=*(const __attribute__((address_space(3))) bf16x8*)(kp+2048); kf[3]=*(const __attribute__((address_space(3))) bf16x8*)(kp+2560);
  kf[4]=*(const __attribute__((address_space(3))) bf16x8*)(kp+4096); kf[5]=*(const __attribute__((address_space(3))) bf16x8*)(kp+4608);
  kf[6]=*(const __attribute__((address_space(3))) bf16x8*)(kp+6144); kf[7]=*(const __attribute__((address_space(3))) bf16x8*)(kp+6656);
}
__device__ __forceinline__ void kload2(bf16x8*kf,lds_cptr kp,int j){ kf[2*j]=*(const __attribute__((address_space(3))) bf16x8*)(kp+j*2048); kf[2*j+1]=*(const __attribute__((address_space(3))) bf16x8*)(kp+j*2048+512); }
__device__ __forceinline__ s16x4 vtr(lds_cptr p){ return __builtin_bit_cast(s16x4,__builtin_amdgcn_ds_read_tr16_b64_v4i16((__attribute__((address_space(3))) v4i16_t*)p)); }
__device__ __forceinline__ float rowmax(const f32x16&p0,const f32x16&p1){
  float a=max3f(p0[0],p0[1],p1[0]),b=max3f(p0[2],p0[3],p1[1]);a=max3f(a,p1[2],p1[3]);
  #pragma unroll
  for(int r=4;r<16;r+=4){a=max3f(a,p0[r],p0[r+1]);b=max3f(b,p0[r+2],p0[r+3]);a=max3f(a,p1[r],p1[r+1]);b=max3f(b,p1[r+2],p1[r+3]);}
  const float m=max2f(a,b);
  auto rr=__builtin_amdgcn_permlane32_swap(__float_as_uint(m),__float_as_uint(m),false,false);
  return max2f(__uint_as_float(rr[0]),__uint_as_float(rr[1]));
}
__device__ __forceinline__ void pv(f32x16*o,int vb,bf16x8 pa0,bf16x8 pa1,bf16x8 pa2,bf16x8 pa3){
  #pragma unroll
  for(int d0=0;d0<2;++d0){s16x4 lo[4],hi[4];
    #pragma unroll
    for(int ks=0;ks<4;++ks){
      asm volatile("ds_read_b64_tr_b16 %0,%1 offset:%c2":"=&v"(lo[ks]):"v"(vb),"i"(d0*4096+ks*1024):"memory");
      asm volatile("ds_read_b64_tr_b16 %0,%1 offset:%c2":"=&v"(hi[ks]):"v"(vb),"i"(d0*4096+ks*1024+512):"memory");}
    asm volatile("s_waitcnt lgkmcnt(0)":::"memory");SBAR();
    #define PK(k) (bf16x8){lo[k][0],lo[k][1],lo[k][2],lo[k][3],hi[k][0],hi[k][1],hi[k][2],hi[k][3]}
    o[d0]=__builtin_amdgcn_mfma_f32_32x32x16_bf16(pa0,PK(0),o[d0],0,0,0);
    o[d0]=__builtin_amdgcn_mfma_f32_32x32x16_bf16(pa1,PK(1),o[d0],0,0,0);
    o[d0]=__builtin_amdgcn_mfma_f32_32x32x16_bf16(pa2,PK(2),o[d0],0,0,0);
    o[d0]=__builtin_amdgcn_mfma_f32_32x32x16_bf16(pa3,PK(3),o[d0],0,0,0);
    #undef PK
  }
}

#ifndef ATTN_STORE16
#define ATTN_STORE16(p,v) (*(u32x4*)(p)=(v))
#endif
template<int THRL> __device__ __forceinline__ void attn_unit(int b,int h,int hv,int qb,const bf16*Q,const bf16*__restrict__ K,const bf16*__restrict__ V,bf16*O,char*shm){
  const int tid=threadIdx.x,lane=tid&63,r32=lane&31,hi=lane>>5; const int wid=__builtin_amdgcn_readfirstlane(tid>>6);
  const long rowbase=(long)b*SEQ; const int q0=qb*QB;
  const bf16*Qw=Q+(rowbase+q0+wid*QBLK)*DM+h*D;
  const bf16*Kh=K+rowbase*DM+h*D,*Vh=V+rowbase*DM+hv*D;
  const unsigned lds0=(unsigned)(uintptr_t)shm;
  float*wsf=(float*)(shm+LDS_WS)+wid*64;
  const bf16*ksrc=Kh+(long)lane*DM+wid*8;
  const bf16*vsrc=Vh+(long)(16*(wid&3)+(lane>>2))*DM+(wid>>2)*32+(lane&3)*8;
  const unsigned kdst=lds0+LDS_K+wid*1024, vdst=lds0+LDS_V+wid*1024;
  #define DMA_K(t,slot) glds16(ksrc+(long)(t)*KVBLK*DM,(unsigned)__builtin_amdgcn_readfirstlane(kdst+(slot)))
  #define DMA_V(t,slot) glds16(vsrc+(long)(t)*KVBLK*DM,(unsigned)__builtin_amdgcn_readfirstlane(vdst+(slot)))
  const int vb0=(int)(lds0+LDS_V)+((lane>>4)&1)*32+(lane&3)*8+(4*hi+((lane&15)>>2))*64;
  const char*Kbase=shm+LDS_K; bf16x8 kf[8];
  const lds_cptr shm3=(lds_cptr)shm; const lds_cptr kp0=shm3+LDS_K+hi*1024+r32*16; const lds_cptr vp0=shm3+LDS_V+((lane>>4)&1)*32+(lane&3)*8+(4*hi+((lane&15)>>2))*64;
  const int NT=(q0+QB)/KVBLK;
  DMA_K(0,0);DMA_V(0,0);DMA_K(1,SLOTB);
  bf16x8 qr[4];
  #pragma unroll
  for(int d0=0;d0<4;++d0)qr[d0]=*reinterpret_cast<const bf16x8*>(&Qw[(long)r32*DM+d0*16+hi*8]);
  float mhat=0.f,l_reg=0.f;f32x16 o[2];o[0]=f32x16{};o[1]=f32x16{};f32x16 negm=f32x16{};asm volatile("":"+v"(negm));
  const int qrel=wid*QBLK+r32;
  #define CMASK(P0,P1,t) do{int jb_=(t)-(NT-4); if(jb_>=0)cmask(P0,P1,jb_,qrel,hi);}while(0)
  bool resc=false;
  #define START(P0,P1) do{ const float rm=rowmax(P0,P1); resc=false; \
    { const float dl=rm; mhat=fadd_s(mhat,dl); \
      _Pragma("unroll") for(int r=0;r<16;++r){P0[r]=fsub_s(P0[r],dl);P1[r]=fsub_s(P1[r],dl);} \
      _Pragma("unroll") for(int r=0;r<16;++r)negm[r]=-mhat; asm volatile("":"+v"(negm)); } \
    _Pragma("unroll") for(int r=0;r<16;++r)P0[r]=__builtin_amdgcn_exp2f(P0[r]); }while(0)
  #define RESC() do{ if(resc){ asm volatile("s_waitcnt lgkmcnt(0)":::"memory"); \
      _Pragma("unroll") for(int d_=0;d_<2;++d_) _Pragma("unroll") for(int r=0;r<16;++r)o[d_][r]*=wsf[crow(r,hi)]; } }while(0)
  f32x16 pA0,pA1,pB0,pB1;
  int sl_prev=0,sl_cur=0,sl_next=SLOTB;
  #define ROT() do{sl_prev=sl_cur;sl_cur=sl_next;sl_next=(sl_next==(NSLOT-1)*SLOTB)?0:sl_next+SLOTB;}while(0)
  DMA_K(2,2*SLOTB);
  WAIT_BAR(3);
  qkt(pA0,pA1,Kbase,qr,negm,r32,hi);asm volatile("s_nop 15\n\ts_nop 7":"+v"(pA0),"+v"(pA1));CMASK(pA0,pA1,0);
  START(pA0,pA1);
  _Pragma("unroll") for(int r=0;r<16;++r)pA1[r]=__builtin_amdgcn_exp2f(pA1[r]);
  WAIT_BAR(0);
  DMA_K(3,0);DMA_V(1,SLOTB);
  ROT();
  kload8(kf,kp0+sl_cur);
  WAIT_BAR(2);
  s16x4 vlo[8],vhi[8]; u32x4 pw0,pw1,pw2,pw3;
  #define PKW(P,B) cvtpk_s(P[B],P[B+1])
  #define PAF(k) __builtin_bit_cast(bf16x8,pw##k)
  #define VFR(i) (bf16x8){vlo[i][0],vlo[i][1],vlo[i][2],vlo[i][3],vhi[i][0],vhi[i][1],vhi[i][2],vhi[i][3]}
  #define PIN(x) asm volatile("":"+v"(x))
  #define MX3(a,b,c) __builtin_fmaxf(__builtin_fmaxf((a),(b)),(c))
  #define GAPA(MF,A0,A1,A2,A3,W0,W1,PW) do{ MF; sacc+=A0; sacc+=A1; sacc+=A2; sacc+=A3; PIN(sacc); W0; W1; PIN(PW); SBAR(); }while(0)
  #define EX(v) __builtin_amdgcn_exp2f(v)
  #define GAPB(MF,X,B) do{ MF; X[B]=EX(X[B]); X[B+1]=EX(X[B+1]); X[B+2]=EX(X[B+2]); X[B+3]=EX(X[B+3]); PIN(X); SBAR(); }while(0)
  #define VRD(i) do{ vlo[i]=vtr(vp_+(((i)>>2)*4096+((i)&3)*1024)); vhi[i]=vtr(vp_+(((i)>>2)*4096+((i)&3)*1024+512)); }while(0)
  #define KRD(G,j) do{ if(G){ kload2(kf,kp0+sl_next,j); SBAR(); } }while(0)
  #define STEP(C0,C1,P0,P1,t,GK,GV,GL) do{ SBAR(); \
    const lds_cptr vp_=vp0+sl_prev; \
    VRD(0); SBAR(); float sacc=(P0[0]+P0[1]); \
    GAPA(C0=__builtin_amdgcn_mfma_f32_32x32x16_bf16(kf[0],qr[0],negm,0,0,0), P0[2],P0[3],P0[4],P0[5],     pw0[0]=PKW(P0,0), pw0[1]=PKW(P0,2), pw0); \
    VRD(4); SBAR(); GAPA(C1=__builtin_amdgcn_mfma_f32_32x32x16_bf16(kf[1],qr[0],negm,0,0,0), P0[6],P0[7],P0[8],P0[9],     pw0[2]=PKW(P0,4), pw0[3]=PKW(P0,6), pw0); \
    VRD(1); SBAR(); GAPA(C0=__builtin_amdgcn_mfma_f32_32x32x16_bf16(kf[2],qr[1],C0,0,0,0),   P0[10],P0[11],P0[12],P0[13], pw1[0]=PKW(P0,8), pw1[1]=PKW(P0,10), pw1); \
    VRD(5); SBAR(); GAPA(C1=__builtin_amdgcn_mfma_f32_32x32x16_bf16(kf[3],qr[1],C1,0,0,0),   P0[14],P0[15],P1[0],P1[1],   pw1[2]=PKW(P0,12),pw1[3]=PKW(P0,14), pw1); \
    VRD(2); SBAR(); GAPA(C0=__builtin_amdgcn_mfma_f32_32x32x16_bf16(kf[4],qr[2],C0,0,0,0),   P1[2],P1[3],P1[4],P1[5],     pw2[0]=PKW(P1,0), pw2[1]=PKW(P1,2), pw2); \
    VRD(6); SBAR(); GAPA(C1=__builtin_amdgcn_mfma_f32_32x32x16_bf16(kf[5],qr[2],C1,0,0,0),   P1[6],P1[7],P1[8],P1[9],     pw2[2]=PKW(P1,4), pw2[3]=PKW(P1,6), pw2); \
    VRD(3); SBAR(); GAPA(C0=__builtin_amdgcn_mfma_f32_32x32x16_bf16(kf[6],qr[3],C0,0,0,0),   P1[10],P1[11],P1[12],P1[13], pw3[0]=PKW(P1,8), pw3[1]=PKW(P1,10), pw3); \
    VRD(7); SBAR(); GAPA(C1=__builtin_amdgcn_mfma_f32_32x32x16_bf16(kf[7],qr[3],C1,0,0,0),   P1[14],P1[15],0.f,0.f,       pw3[2]=PKW(P1,12),pw3[3]=PKW(P1,14), pw3); \
    l_reg+=sacc; \
    if(GK){DMA_K((t)+3,sl_cur);} if(GV){DMA_V((t)+1,sl_next);} \
    CMASK(C0,C1,t); \
    { float a=MX3(C0[0],C0[1],C1[0]),b=MX3(C0[2],C0[3],C1[1]); a=MX3(a,C1[2],C1[3]); \
      _Pragma("unroll") for(int r=4;r<16;r+=4){a=MX3(a,C0[r],C0[r+1]);b=MX3(b,C0[r+2],C0[r+3]);a=MX3(a,C1[r],C1[r+1]);b=MX3(b,C1[r+2],C1[r+3]);} \
      float rm=__builtin_fmaxf(a,b); { auto rr=__builtin_amdgcn_permlane32_swap(__float_as_uint(rm),__float_as_uint(rm),false,false); rm=__builtin_fmaxf(__uint_as_float(rr[0]),__uint_as_float(rr[1])); } \
      resc=false; \
      if(__builtin_expect(__any(rm>(float)THRL),0)){ const float dl=__builtin_fmaxf(rm,0.f); mhat+=dl; \
        _Pragma("unroll") for(int r=0;r<16;++r){C0[r]-=dl;C1[r]-=dl;} \
        _Pragma("unroll") for(int r=0;r<16;++r)negm[r]=-mhat; asm volatile("":"+v"(negm)); \
        const float f=__builtin_amdgcn_exp2f(-dl); l_reg*=f; if(hi==0)wsf[r32]=f; resc=true; } } \
    SBAR(); \
    GAPB(o[0]=__builtin_amdgcn_mfma_f32_32x32x16_bf16(PAF(0),VFR(0),o[0],0,0,0), C0,0); \
    GAPB(o[1]=__builtin_amdgcn_mfma_f32_32x32x16_bf16(PAF(0),VFR(4),o[1],0,0,0), C0,4); \
    KRD(GL,0); GAPB(o[0]=__builtin_amdgcn_mfma_f32_32x32x16_bf16(PAF(1),VFR(1),o[0],0,0,0), C0,8); \
    KRD(GL,1); GAPB(o[1]=__builtin_amdgcn_mfma_f32_32x32x16_bf16(PAF(1),VFR(5),o[1],0,0,0), C0,12); \
    KRD(GL,2); GAPB(o[0]=__builtin_amdgcn_mfma_f32_32x32x16_bf16(PAF(2),VFR(2),o[0],0,0,0), C1,0); \
    KRD(GL,3); GAPB(o[1]=__builtin_amdgcn_mfma_f32_32x32x16_bf16(PAF(2),VFR(6),o[1],0,0,0), C1,4); \
    GAPB(o[0]=__builtin_amdgcn_mfma_f32_32x32x16_bf16(PAF(3),VFR(3),o[0],0,0,0), C1,8); \
    GAPB(o[1]=__builtin_amdgcn_mfma_f32_32x32x16_bf16(PAF(3),VFR(7),o[1],0,0,0), C1,12); \
    }while(0)
  int t=1;
  #undef CMASK
  #define CMASK(P0,P1,t) do{}while(0)
  for(;t+5<NT;t+=2){
    STEP(pB0,pB1,pA0,pA1,t,true,true,true);     WAIT_BAR(2); RESC(); ROT();
    STEP(pA0,pA1,pB0,pB1,t+1,true,true,true);   WAIT_BAR(2); RESC(); ROT();
  }
  #undef CMASK
  #define CMASK(P0,P1,t) do{int jb_=(t)-(NT-4); if(jb_>=0)cmask(P0,P1,jb_,qrel,hi);}while(0)
  #define ENDW(tt) do{ if((tt)+3<NT){WAIT_BAR(2);} else if((tt)+2<NT){WAIT_BAR(1);} else {WAIT_BAR(0);} }while(0)
  for(;t+1<NT;t+=2){
    STEP(pB0,pB1,pA0,pA1,t,(t+3<NT),(t+1<NT),(t+1<NT));       ENDW(t);   RESC(); ROT();
    STEP(pA0,pA1,pB0,pB1,t+1,(t+4<NT),(t+2<NT),(t+2<NT));     ENDW(t+1); RESC(); ROT();
  }
  STEP(pB0,pB1,pA0,pA1,NT-1,false,false,false); RESC();
  { float sacc=pB0[0]+pB0[1]; _Pragma("unroll") for(int r=2;r<16;++r)sacc+=pB0[r]; _Pragma("unroll") for(int r=0;r<16;++r)sacc+=pB1[r]; l_reg+=sacc;
    pw0=(u32x4){PKW(pB0,0),PKW(pB0,2),PKW(pB0,4),PKW(pB0,6)};pw1=(u32x4){PKW(pB0,8),PKW(pB0,10),PKW(pB0,12),PKW(pB0,14)};pw2=(u32x4){PKW(pB1,0),PKW(pB1,2),PKW(pB1,4),PKW(pB1,6)};pw3=(u32x4){PKW(pB1,8),PKW(pB1,10),PKW(pB1,12),PKW(pB1,14)};
    SBAR(); pv(o,vb0+sl_cur,PAF(0),PAF(1),PAF(2),PAF(3)); }
  #undef PKW
  #undef PAF
  #undef VFR
  #undef PIN
  #undef MX3
  #undef GAPA
  #undef GAPB
  #undef EX
  #undef VRD
  #undef KRD
  #undef STEP
  #undef ENDW
  {auto rr=__builtin_amdgcn_permlane32_swap(__float_as_uint(l_reg),__float_as_uint(l_reg),false,false);l_reg=__uint_as_float(rr[0])+__uint_as_float(rr[1]);}
  if(hi==0)wsf[32+r32]=l_reg;asm volatile("s_waitcnt lgkmcnt(0)":::"memory");
  float rli[16];
  #pragma unroll
  for(int r=0;r<16;++r)rli[r]=__builtin_amdgcn_rcpf(wsf[32+crow(r,hi)]);
  bf16*Ow=O+(rowbase+q0+wid*QBLK)*DM+hv*D;
  { bf16*stg=(bf16*)(shm+LDS_OST)+wid*2048;
    #pragma unroll
    for(int r=0;r<16;++r){const int orow=crow(r,hi);
      #pragma unroll
      for(int d0=0;d0<2;++d0)stg[orow*64+d0*32+r32]=__float2bfloat16(o[d0][r]*rli[r]);}
    asm volatile("s_waitcnt lgkmcnt(0)":::"memory");
    #pragma unroll
    for(int i=0;i<4;++i){const int row=i*8+(lane>>3),ch=lane&7; const u32x4 v=*(const u32x4*)(stg+row*64+ch*8); ATTN_STORE16(Ow+(long)row*DM+ch*8,v);} }
  asm volatile("s_waitcnt lgkmcnt(0)\n\ts_barrier":::"memory");
  #undef DMA_K
  #undef DMA_V
  #undef CMASK
  #undef START
  #undef RESC
  #undef ROT
}
constexpr int ATTN_LDS_BYTES=LDS_BYTES;
#undef SBAR
#undef WAIT_BAR
}

#define ACC8(v, A_, ai, bj, m) float v[8] = {A_[ai][bj][m][0][0], A_[ai][bj][m][0][1], A_[ai][bj][m][0][2], A_[ai][bj][m][0][3], A_[ai][bj][m][1][0], A_[ai][bj][m][1][1], A_[ai][bj][m][1][2], A_[ai][bj][m][1][3]}
struct EpiProjFast { static constexpr bool PERM = true, MID = false; const Frame* F;
    static constexpr float PSC = PROJ_FP8 ? W8I : 1.0f;
    __device__ __forceinline__ void operator()(const f32x4 (&acc)[2][2][4][2], const fg::Unit& u, int wr, int wc, int fr, int fq) const {
        const int row0 = u.pm * 256 + wr * 64 + fr, col0 = u.pn * 256 + wc * 32 + 8 * fq;
        const int sec = u.pn >> 2;
        if (sec == 1) {
            const float* lb = wsp<const float>(*F, WS_LB) + (col0 - 1024);
            f32x4 l4[2][2];
#pragma unroll
            for (int bj = 0; bj < 2; ++bj) { l4[bj][0] = *(const f32x4*)(lb + bj * 128); l4[bj][1] = *(const f32x4*)(lb + bj * 128 + 4); }
#pragma unroll
            for (int ai = 0; ai < 2; ++ai)
#pragma unroll
                for (int m = 0; m < 4; ++m)
#pragma unroll
                    for (int bj = 0; bj < 2; ++bj) {
                        f32x4 o[2];
#pragma unroll
                        for (int n = 0; n < 2; ++n)
#pragma unroll
                            for (int i = 0; i < 4; ++i) { const float l = l4[bj][n][i]; o[n][i] = __logf(l + (1.0f - l) * sigmoidf_(acc[ai][bj][m][n][i] * PSC)); }
                        float* op = wsp<float>(*F, WS_LOGF) + (size_t)(row0 + ai * 128 + m * 16) * HW + (col0 - 1024) + bj * 128;
                        *(f32x4*)op = o[0]; *(f32x4*)(op + 4) = o[1];
                    }
        } else if (sec == 4 || sec == 5) {
            const bool ropel = ((wc & 1) == 0) && (fq < 2);
            const float sg = (fq == 0) ? -1.0f : 1.0f;
            bf16* dst = wsp<bf16>(*F, sec == 4 ? WS_QDA : WS_KDA); const int cb = col0 - (sec == 4 ? 4096 : 5120);
            const float scl = (sec == 4 ? QSCALE : 1.0f) * PSC;
#pragma unroll
            for (int am = 0; am < 4; ++am) {
                const int ai = am >> 1, mb = (am & 1) * 2;
                f32x4 rt[2][4];
#pragma unroll
                for (int mm = 0; mm < 2; ++mm) { const float* rp = wsp<const float>(*F, WS_ROPE) + (size_t)((row0 + ai * 128 + (mb + mm) * 16) & (SEQ - 1)) * 16;
#pragma unroll
                    for (int q = 0; q < 4; ++q) rt[mm][q] = *(const f32x4*)(rp + 4 * q); }
#pragma unroll
                for (int mm = 0; mm < 2; ++mm)
#pragma unroll
                    for (int bj = 0; bj < 2; ++bj) {
                        const int m = mb + mm;
                        ACC8(v, acc, ai, bj, m);
                        float pv[8];
#pragma unroll
                        for (int i = 0; i < 8; ++i) pv[i] = __shfl_xor(v[i], 16);
#pragma unroll
                        for (int i = 0; i < 8; ++i) { const float cs = ropel ? rt[mm][i >> 2][i & 3] : 1.0f, sn = ropel ? sg * rt[mm][2 + (i >> 2)][i & 3] : 0.0f; v[i] = v[i] * cs + pv[i] * sn; }
#pragma unroll
                        for (int i = 0; i < 8; ++i) v[i] *= scl;
                        store8_bf16(dst + (size_t)(row0 + ai * 128 + m * 16) * HW + cb + bj * 128, v);
                    }
            }
        } else {
#pragma unroll
            for (int ai = 0; ai < 2; ++ai)
#pragma unroll
                for (int m = 0; m < 4; ++m)
#pragma unroll
                    for (int bj = 0; bj < 2; ++bj) { ACC8(v, acc, ai, bj, m);
#pragma unroll
                        for (int i = 0; i < 8; ++i) v[i] *= PSC;
                        proj_store8(*F, row0 + ai * 128 + m * 16, col0 + bj * 128, v, 16); }
        }
    } };
__device__ __forceinline__ void ph_proj_fast(Frame& F) {
#if PROJ_FP8
    fg::DenseOrderT<true> S; S.init(wsp<const bf16>(F, WS_H1), wsp<const bf16>(F, WS_WIN_T), T, INC, DM / 2, F.G, F.bid);
    EpiProjFast E{&F};
    fg::gemm_phase(F.lds, DM / 2, S, E);
#else
    fg::DenseOrder S; S.init(wsp<const bf16>(F, WS_H1), wsp<const bf16>(F, WS_WIN_T), T, INC, DM, F.G, F.bid);
    EpiProjFast E{&F};
    fg::gemm_phase(F.lds, DM, S, E);
#endif
}
struct EpiBranchFast { static constexpr bool PERM = true, MID = true; const Frame* F;
    __device__ __forceinline__ void mid(f32x4 (&acc)[2][2][4][2], const fg::Unit& u, int wr, int wc, int fr, int fq) const {
        int row0 = u.pm * 256 + wr * 64 + fr, col0 = u.pn * 256 + wc * 32 + 8 * fq;
        asm volatile("" : "+v"(row0), "+v"(col0));
        const bf16* GH = wsp<const bf16>(*F, WS_GATEH); const bf16* GD = wsp<const bf16>(*F, WS_GATED);
#pragma unroll
        for (int ai = 0; ai < 2; ++ai) {
            u32x4 gh2[2][4], gd2[2][4];
#pragma unroll
            for (int bj = 0; bj < 2; ++bj)
#pragma unroll
                for (int m = 0; m < 4; ++m) { const size_t off = (size_t)(row0 + ai * 128 + m * 16) * DM + col0 + bj * 128; gh2[bj][m] = *(const u32x4*)(GH + off); gd2[bj][m] = *(const u32x4*)(GD + off); }
#pragma unroll
            for (int bj = 0; bj < 2; ++bj) {
#pragma unroll
                for (int m = 0; m < 4; ++m) {
                    const unsigned hh[4] = {gh2[bj][m].x, gh2[bj][m].y, gh2[bj][m].z, gh2[bj][m].w}, dd[4] = {gd2[bj][m].x, gd2[bj][m].y, gd2[bj][m].z, gd2[bj][m].w};
#pragma unroll
                    for (int i = 0; i < 4; ++i) {
                        const float r0 = bf2f(hh[i] & 0xffffu) * __builtin_amdgcn_rcpf(fmaxf(bf2f(dd[i] & 0xffffu), 1e-30f));
                        const float r1 = bf2f(hh[i] >> 16) * __builtin_amdgcn_rcpf(fmaxf(bf2f(dd[i] >> 16), 1e-30f));
                        acc[ai][bj][m][i >> 1][(i & 1) * 2] *= r0; acc[ai][bj][m][i >> 1][(i & 1) * 2 + 1] *= r1;
                    }
                }
            }
            asm volatile("" ::: "memory");
        }
    }
    __device__ __forceinline__ void operator()(const f32x4 (&acc)[2][2][4][2], const fg::Unit& u, int wr, int wc, int fr, int fq) const {
        const int row0 = u.pm * 256 + wr * 64 + fr, col0 = u.pn * 256 + wc * 32 + 8 * fq;
        const bf16* GD = wsp<const bf16>(*F, WS_GATED);
        u32x4 gda[2][4][2];
#pragma unroll
        for (int ai = 0; ai < 2; ++ai)
#pragma unroll
            for (int m = 0; m < 4; ++m)
#pragma unroll
                for (int bj = 0; bj < 2; ++bj) gda[ai][m][bj] = *(const u32x4*)(GD + (size_t)(row0 + ai * 128 + m * 16) * DM + col0 + bj * 128);
#pragma unroll
        for (int ai = 0; ai < 2; ++ai) {
#pragma unroll
            for (int m = 0; m < 4; ++m)
#pragma unroll
                for (int bj = 0; bj < 2; ++bj) {
                    const u32x4 g = gda[ai][m][bj]; const f32x4 a0 = acc[ai][bj][m][0], a1 = acc[ai][bj][m][1];
                    float o[8] = {a0[0] * bf2f(g.x & 0xffffu), a0[1] * bf2f(g.x >> 16), a0[2] * bf2f(g.y & 0xffffu), a0[3] * bf2f(g.y >> 16),
                                  a1[0] * bf2f(g.z & 0xffffu), a1[1] * bf2f(g.z >> 16), a1[2] * bf2f(g.w & 0xffffu), a1[3] * bf2f(g.w >> 16)};
                    store8_bf16(wsp<bf16>(*F, WS_MERGED) + (size_t)(row0 + ai * 128 + m * 16) * DM + col0 + bj * 128, o);
                }
        }
    } };
__device__ __forceinline__ void ph_branch_fast(Frame& F) {
    fg::DenseOrder S; S.init(wsp<const bf16>(F, WS_YCAT), wsp<const bf16>(F, WS_WBH_T), T, DM, DM, F.G, F.bid);
    EpiBranchFast E{&F};
    fg::gemm_phase(F.lds, DM, S, E);
}
struct EpiUFast { static constexpr bool PERM = true, MID = false; const Frame* F;
    __device__ __forceinline__ void operator()(const f32x4 (&acc)[2][2][4][2], const fg::Unit& u, int wr, int wc, int fr, int fq) const {
        const int row0 = u.pm * 256 + wr * 64 + fr, col0 = u.pn * 256 + wc * 32 + 8 * fq;
#pragma unroll
        for (int ai = 0; ai < 2; ++ai)
#pragma unroll
            for (int m = 0; m < 4; ++m)
#pragma unroll
                for (int bj = 0; bj < 2; ++bj) { ACC8(v, acc, ai, bj, m); store8_bf16(wsp<bf16>(*F, WS_U) + (size_t)(row0 + ai * 128 + m * 16) * DM + col0 + bj * 128, v); }
    } };
__device__ __forceinline__ void ph_wout_fast(Frame& F) {
    fg::DenseOrder S; S.init(wsp<const bf16>(F, WS_MERGED), wsp<const bf16>(F, WS_WOUT_T), T, DM, DM, F.G, F.bid);
    EpiUFast E{&F};
    fg::gemm_phase(F.lds, DM, S, E);
}
struct Args;
typedef const __attribute__((address_space(4))) Args* CArgs;
constexpr int TU_L = 2, TU_M = 40 - TU_L;
constexpr int N_TU_LATE = NE * TU_L, N_TU_MIX = NE * TU_M;
__device__ __forceinline__ void t_unit(CArgs A, int e, int r);
__device__ __forceinline__ int q_claim(CArgs A, int ctr);
template <bool GATHER_, bool IDENT_ = false> struct MoeOrder {
    static constexpr bool GATHER = GATHER_, FP8 = true;
    const LAS int* tab; int G, c; const char* A; const char* Bt; int K; size_t bstride; const int* list;
    __device__ __forceinline__ bool next(int i, fg::Unit& u) const {
        const int q = i * (G >> 3) + (c >> 3), x = c & 7;
        const int mtg = 2 * (q >> 1) + (x >> 2), pn = 2 * (x & 3) + (q & 1);
        if (mtg >= tab[72 + NE]) return false;
        int e = 0;
#pragma unroll 1
        for (int k = 1; k < NE; ++k) if (tab[72 + k] <= mtg) e = k;
        const int mt = mtg - tab[72 + e];
        u.pm = mt; u.pn = pn; u.e = e; u.nvalid = min(256, tab[e] - mt * 256); u.slot0 = tab[32 + e] + mt * 256; return true;
    }
    __device__ __forceinline__ const char* a_ptr(const fg::Unit& u) const { return GATHER ? A : A + (size_t)u.slot0 * K * 2; }
    __device__ __forceinline__ int a_row(const fg::Unit& u, int r) const { if constexpr (IDENT_) return u.slot0 + r; else return r < u.nvalid ? list[u.e * 16384 + u.pm * 256 + r] : 0; }
    __device__ __forceinline__ const char* b_ptr(const fg::Unit& u) const { return Bt + (size_t)u.e * bstride + (size_t)u.pn * 256 * K * 2; }
};
struct EpiMoe1Fast { static constexpr bool PERM = true, MID = false; const Frame* F;
    __device__ __forceinline__ void operator()(const f32x4 (&acc)[2][2][4][2], const fg::Unit& u, int wr, int wc, int fr, int fq) const {
        const int col0 = u.pn * 128 + wc * 32 + 8 * fq;
#pragma unroll
        for (int ai = 0; ai < 2; ++ai)
#pragma unroll
            for (int m = 0; m < 4; ++m) {
                const int r = ai * 128 + wr * 64 + m * 16 + fr;
                ACC8(g, acc, ai, 0, m); ACC8(up, acc, ai, 1, m);
                float o[8];
#pragma unroll
                for (int i = 0; i < 8; ++i) { const float gs = g[i] * W8I; o[i] = clamp8(gs * sigmoidf_(gs) * (up[i] * W8I)); }
                if (r < u.nvalid) { u32x2 p; p.x = pk4_fp8(o[0], o[1], o[2], o[3]); p.y = pk4_fp8(o[4], o[5], o[6], o[7]); *(u32x2*)(wsp<unsigned char>(*F, WS_ACT) + (size_t)(u.slot0 + r) * DE + col0) = p; }
            }
    } };
struct EpiMoe2Fast { static constexpr bool PERM = true, MID = false; const Frame* F;
    __device__ __forceinline__ void operator()(const f32x4 (&acc)[2][2][4][2], const fg::Unit& u, int wr, int wc, int fr, int fq) const {
        const int col0 = u.pn * 256 + wc * 32 + 8 * fq;
        unsigned char* YW8 = wsp<unsigned char>(*F, WS_YW);
#pragma unroll
        for (int ai = 0; ai < 2; ++ai)
#pragma unroll
            for (int m = 0; m < 4; ++m) {
                const int r = ai * 128 + wr * 64 + m * 16 + fr;
                const bool ok = r < u.nvalid;
#pragma unroll
                for (int bj = 0; bj < 2; ++bj) { ACC8(v, acc, ai, bj, m);
#pragma unroll
                    for (int i = 0; i < 8; ++i) v[i] = clamp8(v[i] * (W8I * Y8S));
                    if (ok) { u32x2 p; p.x = pk4_fp8(v[0], v[1], v[2], v[3]); p.y = pk4_fp8(v[4], v[5], v[6], v[7]); *(u32x2*)(YW8 + (size_t)(u.slot0 + r) * DM + col0 + bj * 128) = p; } }
            }
    } };
__device__ __forceinline__ void ph_moe1_fast(Frame& F, CArgs A) {
    LAS int* tab = (LAS int*)(F.lds + 131072);
    expert_tables(F, tab, 256);
    MoeOrder<true> S{tab, F.G, F.bid, (const char*)wsp<const bf16>(F, WS_H2), (const char*)wsp<const bf16>(F, WS_WGU_T), DM / 2, (size_t)2048 * DM, wsp<const int>(F, WS_LISTTOK)};
    EpiMoe1Fast E{&F};
    fg::gemm_phase(F.lds, DM / 2, S, E);
    for (;;) {
        const int j = q_claim(A, CW_TQ + 64);
        if (j >= N_TU_LATE) break;
        t_unit(A, j / TU_L, 32 + j % TU_L);
    }
}
__device__ __forceinline__ void ph_moe2_fast(Frame& F) {
    LAS int* tab = (LAS int*)(F.lds + 131072);
    expert_tables(F, tab, 256);
    MoeOrder<true, true> S{tab, F.G, F.bid, (const char*)wsp<const bf16>(F, WS_ACT), (const char*)wsp<const bf16>(F, WS_WD_T), DE / 2, (size_t)DM * DE, nullptr};
    EpiMoe2Fast E{&F};
    fg::gemm_phase(F.lds, DE / 2, S, E);
}

struct Args { const float* in[26]; float* out; unsigned char* ws; int ph_lo, ph_hi; };
__device__ __forceinline__ void t_unit(CArgs A, int e, int r) {
    asm volatile("" : "+s"(A));
    int t_ = threadIdx.x; asm volatile("" : "+v"(t_));
    const int lane = t_ & 63, wave = __builtin_amdgcn_readfirstlane(t_ >> 6);
    unsigned char* ws = A->ws;
    f32x4 t0[8], t1[8], t2[8], t3[8];
#define T_LOADP(ta, tb, RS, N, k0, n0) do { const int vo_ = ((16 * (lane >> 3)) * (N) + (n0) + 4 * (lane & 7)) * 4; \
        _Pragma("unroll") for (int i = 0; i < 8; ++i) ta[i] = __builtin_bit_cast(f32x4, __builtin_amdgcn_raw_buffer_load_b128(RS, vo_, ((k0) + i) * (N) * 4, 2)); \
        _Pragma("unroll") for (int i = 0; i < 8; ++i) tb[i] = __builtin_bit_cast(f32x4, __builtin_amdgcn_raw_buffer_load_b128(RS, vo_, ((k0) + 8 + i) * (N) * 4, 2)); } while (0)
#define T_STOREP8(ta, tb, WT, K, k0, drow) do { _Pragma("unroll") for (int j = 0; j < 4; ++j) { u32x4 o_; \
        o_.x = pk4_fp8(ta[0][j] * W8S, ta[1][j] * W8S, ta[2][j] * W8S, ta[3][j] * W8S); o_.y = pk4_fp8(ta[4][j] * W8S, ta[5][j] * W8S, ta[6][j] * W8S, ta[7][j] * W8S); \
        o_.z = pk4_fp8(tb[0][j] * W8S, tb[1][j] * W8S, tb[2][j] * W8S, tb[3][j] * W8S); o_.w = pk4_fp8(tb[4][j] * W8S, tb[5][j] * W8S, tb[6][j] * W8S, tb[7][j] * W8S); \
        *(u32x4*)((WT) + (size_t)((drow) + 4 * (lane & 7) + j) * (K) + (k0) + 16 * (lane >> 3)) = o_; } } while (0)
#define T_WAVE(W, N, WT, K, k0, n0, dr) do { \
        T_LOADP(t0, t1, W, N, k0, n0); T_LOADP(t2, t3, W, N, k0, (n0) + 32); \
        T_STOREP8(t0, t1, WT, K, k0, dr); T_LOADP(t0, t1, W, N, k0, (n0) + 64); \
        T_STOREP8(t2, t3, WT, K, k0, (dr) + 32); T_LOADP(t2, t3, W, N, k0, (n0) + 96); \
        T_STOREP8(t0, t1, WT, K, k0, (dr) + 64); T_STOREP8(t2, t3, WT, K, k0, (dr) + 96); } while (0)
    if (r < 32) {
        const int up = r >> 4, k0 = (r & 15) * 128;
        const float* Wp = (up ? A->in[24] : A->in[23]) + (size_t)e * DM * DE; unsigned char* WT = ws + WS_WGU_T + (size_t)e * 2048 * DM;
        const __amdgpu_buffer_rsrc_t W = __builtin_amdgcn_make_buffer_rsrc((void*)Wp, 0, DM * DE * 4, 0x00020000);
        const int n0 = wave * 128, dr = wave * 256 + up * 128;
        T_WAVE(W, DE, WT, DM, k0, n0, dr);
    } else {
        const int rr = r - 32, k0 = (rr >> 1) * 128, n0 = (rr & 1) * 1024 + wave * 128;
        const float* Wp = A->in[25] + (size_t)e * DE * DM; unsigned char* WT = ws + WS_WD_T + (size_t)e * DM * DE;
        const __amdgpu_buffer_rsrc_t W = __builtin_amdgcn_make_buffer_rsrc((void*)Wp, 0, DM * DE * 4, 0x00020000);
        T_WAVE(W, DM, WT, DE, k0, n0, n0);
    }
#undef T_WAVE
#undef T_LOADP
#undef T_STOREP8
}
__device__ __forceinline__ int q_claim(CArgs A, int ctr) {
    volatile LAS int* qslot = (volatile LAS int*)((LAS unsigned char*)0 + MISC_OFF + 64);
    __syncthreads();
    if (threadIdx.x == 0) *qslot = (int)__hip_atomic_fetch_add((unsigned*)(A->ws + WS_CTL) + ctr, 1u, RLX_AGENT);
    __syncthreads();
    return __builtin_amdgcn_readfirstlane(*qslot);
}
__device__ __forceinline__ int attn_claim(CArgs A, int base) {
    volatile LAS int* qslot = (volatile LAS int*)((LAS unsigned char*)0 + MISC_OFF + 64);
    __syncthreads();
    if (threadIdx.x == 0) {
        unsigned* q = (unsigned*)(A->ws + WS_CTL) + base;
        const unsigned x = xb_xcc_id() & 7u;
        int res = -1;
        unsigned j = __hip_atomic_fetch_add(q + 16 * x, 1u, RLX_AGENT);
        if (j < 256u) res = (int)(x * 256u + j);
        else {
            unsigned c[8];
#pragma unroll
            for (int k = 0; k < 8; ++k) c[k] = __hip_atomic_load(q + 16 * k, RLX_AGENT);
#pragma unroll 1
            for (unsigned k = 1; k < 8 && res < 0; ++k) { const unsigned s2 = (x + k) & 7u; bool live = false;
#pragma unroll
                for (int k2 = 0; k2 < 8; ++k2) live = live || ((unsigned)k2 == s2 && c[k2] < 256u);
                if (!live) continue;
                j = __hip_atomic_fetch_add(q + 16 * s2, 1u, RLX_AGENT);
                if (j < 256u) res = (int)(s2 * 256u + j); }
        }
        *qslot = res;
    }
    __syncthreads();
    return __builtin_amdgcn_readfirstlane(*qslot);
}
__device__ __forceinline__ void ph_mix_fast(Frame& F, CArgs A, char* lds_generic, int coff = 0) {
    constexpr float TPC = 1.25f * (float)N_TU_MIX / 55168.0f;
    float credit = (float)(F.bid & 3) * 0.5f; bool a_done = false, t_done = false;
    for (int ch = F.bid; ch < NB * NH; ch += F.G) { hgrn_chain_fast(F, ch); credit += 60.0f * TPC; }
    while (!(a_done && t_done)) {
        while (!t_done && (credit >= 1.0f || a_done)) {
            const int t = q_claim(A, CW_TQ + coff);
            if (t >= N_TU_MIX) { t_done = true; break; }
            { const int e = t / TU_M, rm = t % TU_M; t_unit(A, e, rm < 32 ? rm : rm + TU_L); } credit -= 1.0f;
        }
        if (!a_done) {
            const int a = attn_claim(A, coff ? 12288 : CW_ATTQ);
            if (a < 0) { a_done = true; continue; }
            const int sq = a >> 8, jq = a & 255, wq = jq & 63, pr = sq * 8 + 2 * (jq >> 6) + ((wq >> 2) & 1);
            const int qb = 7 - (wq >> 3), b = pr >> 3, h = pr & 7, m = (wq >> 1) & 1, vhalf = wq & 1;
            unsigned char* ws = A->ws;
            attn_body::attn_unit<8>(b, 2 * h + m, 2 * h + vhalf, qb, (const attn_body::bf16*)(ws + WS_QDA), (const attn_body::bf16*)(ws + WS_KDA), (const attn_body::bf16*)(ws + WS_VDA),
                                    (attn_body::bf16*)(ws + (m ? WS_O2 : WS_O1)), lds_generic);
            credit += (float)(4 * qb + 7) * TPC;
        }
    }
    __syncthreads();
}
__device__ __forceinline__ void ph_transposes(Frame& F) {
    LAS float* scr = (LAS float*)(F.lds + F.wave * 8704);
    const int gw = F.bid * NWAVES + F.wave, NGW = F.G * NWAVES;
    constexpr int I_IN = 32 * 352, I_BH = 16 * 64, I_OUT = 32 * 64, I_GE = 32 * 32, I_DE = 16 * 64;
    constexpr int NITEMS = I_IN + 2 * I_BH + I_OUT + (EXPERT_T_IN_MIX ? 0 : NE * (2 * I_GE + I_DE));
    for (int it = gw; it < NITEMS; it += NGW) {
        int r = it;
        if (r < I_IN) { const int kb = r / 352, nb = r % 352; transpose_item<PROJ_FP8 != 0>(F.w_in, DM, INC, wsp<bf16>(F, WS_WIN_T), kb * 64, nb * 32, nb * 32, scr, F.lane); continue; } r -= I_IN;
        if (r < I_BH) { const int kb = r / 64, nb = r % 64; transpose_item(F.w_bhg, HW, DM, wsp<bf16>(F, WS_WBH_T), kb * 64, nb * 32, nb * 32, scr, F.lane, DM, 0); continue; } r -= I_BH;
        if (r < I_BH) { const int kb = r / 64, nb = r % 64; transpose_item(F.w_bda, HW, DM, wsp<bf16>(F, WS_WBH_T), kb * 64, nb * 32, nb * 32, scr, F.lane, DM, HW); continue; } r -= I_BH;
        if (r < I_OUT) { const int kb = r / 64, nb = r % 64; transpose_item(F.w_out, DM, DM, wsp<bf16>(F, WS_WOUT_T), kb * 64, nb * 32, nb * 32, scr, F.lane); continue; } r -= I_OUT;
        const int e = r / (2 * I_GE + I_DE); r -= e * (2 * I_GE + I_DE);
        if (r < 2 * I_GE) { const int up = r >= I_GE ? 1 : 0; r -= up * I_GE; const int kb = r / 32, nb = r % 32;
            transpose_item((up ? F.w_up : F.w_gate) + (size_t)e * DM * DE, DM, DE, wsp<bf16>(F, WS_WGU_T) + (size_t)e * 2048 * DM, kb * 64, nb * 32, (nb >> 2) * 256 + up * 128 + (nb & 3) * 32, scr, F.lane); continue; }
        r -= 2 * I_GE;
        { const int kb = r / 64, nb = r % 64; transpose_item(F.w_down + (size_t)e * DE * DM, DE, DM, wsp<bf16>(F, WS_WD_T) + (size_t)e * DM * DE, kb * 64, nb * 32, nb * 32, scr, F.lane); }
    }
}

__global__ void __launch_bounds__(NTHREADS, 2) mk_fwd(Args args) {
    extern __shared__ __attribute__((aligned(16))) unsigned char lds[];
    Frame F;
    CArgs A = (CArgs)__builtin_amdgcn_kernarg_segment_ptr();
    F.lds = (LAS unsigned char*)lds;
    F.G = gridDim.x; F.bid = blockIdx.x;
#define ENTER() do { asm volatile("" : "+s"(A)); int t_ = threadIdx.x; asm volatile("" : "+v"(t_)); F.tid = t_; F.lane = t_ & 63; F.wave = __builtin_amdgcn_readfirstlane(t_ >> 6); \
    F.ws = A->ws; F.ctl = (gu32*)(F.ws + WS_CTL); F.out = A->out; \
    F.x = A->in[0]; F.c = A->in[1]; F.w_ada = A->in[2]; F.b_ada = A->in[3]; F.pre_mix = A->in[4]; F.post_mix = A->in[5]; F.pre_ffn = A->in[6]; F.post_ffn = A->in[7]; \
    F.w_in = A->in[8]; F.hg_lb = A->in[9]; F.hg_nw = A->in[10]; F.lq1 = A->in[11]; F.lk1 = A->in[12]; F.lq2 = A->in[13]; F.lk2 = A->in[14]; F.da_nw = A->in[15]; \
    F.w_bhg = A->in[16]; F.w_bda = A->in[17]; F.w_out = A->in[18]; F.w_group = A->in[19]; F.b_group = A->in[20]; F.w_router = A->in[21]; F.b_router = A->in[22]; \
    F.w_gate = A->in[23]; F.w_up = A->in[24]; F.w_down = A->in[25]; } while (0)
    ENTER();
    volatile LAS unsigned* MISC = (volatile LAS unsigned*)(F.lds + MISC_OFF);
    for (int u = F.tid; u < (LDS_BYTES - LDSCTL_OFF) / 4; u += NTHREADS) ((LAS unsigned*)(F.lds + LDSCTL_OFF))[u] = 0u;
    __syncthreads();
    const int lo = A->ph_lo, hi = A->ph_hi;
    XcdBarrier bar; bar.bar = (unsigned*)(F.ctl + CW_BAR); bar.x = 0; bar.st = nullptr;
    if (hi - lo > 1) bar = xcd_barrier_post((unsigned*)(F.ctl + CW_BAR), MISC + 8);
#define IN(k) (lo <= (k) && (k) < hi)
#define SEAM(k) do { if (IN(k) && IN((k) + 1)) xcd_barrier(bar); } while (0)
    if (IN(PH_PRO)) { ENTER(); ph_prologue(F); }
    if (PROBE_DUP == 100) { xcd_barrier(bar); ENTER(); ph_prologue(F); xcd_barrier(bar); }
#if FAST_GEMM
    if (IN(PH_PRO)) { ENTER(); ph_transposes(F); }
    if (PROBE_DUP == PH_PRO) { xcd_barrier(bar); ENTER(); ph_transposes(F); }
#endif
    SEAM(PH_PRO);
    if (IN(PH_MOD)) { ENTER(); ph_mod(F); } SEAM(PH_MOD);
    if (IN(PH_H1)) { ENTER(); ph_h1(F); }
    if (PROBE_DUP == PH_H1) { xcd_barrier(bar); ENTER(); ph_h1(F); }
    SEAM(PH_H1);
#if FAST_GEMM
    if (IN(PH_PROJ)) { ENTER(); ph_proj_fast(F); }
    if (PROBE_DUP == PH_PROJ) { xcd_barrier(bar); ENTER(); ph_proj_fast(F); }
    SEAM(PH_PROJ);
#else
    if (IN(PH_PROJ)) { ENTER(); ph_proj_simple(F); } SEAM(PH_PROJ);
#endif
#if FAST_ATTN
    if (IN(PH_MIX)) { ENTER(); ph_mix_fast(F, A, (char*)lds); }
    if (PROBE_DUP == PH_MIX) { xcd_barrier(bar); ENTER(); ph_mix_fast(F, A, (char*)lds, 32); }
    SEAM(PH_MIX);
#else
    if (IN(PH_MIX)) { ENTER(); ph_mix_simple(F); } SEAM(PH_MIX);
#endif
    if (IN(PH_YDA)) { ENTER(); ph_yda(F); }
    if (PROBE_DUP == PH_YDA) { xcd_barrier(bar); ENTER(); ph_yda(F); }
    SEAM(PH_YDA);
#if FAST_GEMM
    if (IN(PH_BRANCH)) { ENTER(); ph_branch_fast(F); }
    if (PROBE_DUP == PH_BRANCH) { xcd_barrier(bar); ENTER(); ph_branch_fast(F); }
    SEAM(PH_BRANCH);
#else
    if (IN(PH_BRANCH)) { ENTER(); ph_branch_simple(F); } SEAM(PH_BRANCH);
#endif
#if FAST_GEMM
    if (IN(PH_WOUT)) { ENTER(); ph_wout_fast(F); }
    if (PROBE_DUP == PH_WOUT) { xcd_barrier(bar); ENTER(); ph_wout_fast(F); }
    SEAM(PH_WOUT);
#else
    if (IN(PH_WOUT)) { ENTER(); ph_wout_simple(F); } SEAM(PH_WOUT);
#endif
#if FAST_POST
    if (IN(PH_POST)) { ENTER(); ph_post_fast(F); } SEAM(PH_POST);
#else
    if (IN(PH_POST)) { ENTER(); ph_post(F); } SEAM(PH_POST);
#endif
#if FAST_GEMM
    if (IN(PH_MOE1)) { ENTER(); ph_moe1_fast(F, A); }
    if (PROBE_DUP == PH_MOE1) { xcd_barrier(bar); ENTER(); ph_moe1_fast(F, A); }
    SEAM(PH_MOE1);
#else
    if (IN(PH_MOE1)) { ENTER(); ph_moe1_simple(F); } SEAM(PH_MOE1);
#endif
#if FAST_GEMM
    if (IN(PH_MOE2)) { ENTER(); ph_moe2_fast(F); }
    if (PROBE_DUP == PH_MOE2) { xcd_barrier(bar); ENTER(); ph_moe2_fast(F); }
    SEAM(PH_MOE2);
#else
    if (IN(PH_MOE2)) { ENTER(); ph_moe2_simple(F); } SEAM(PH_MOE2);
#endif
    if (IN(PH_FINAL)) { ENTER(); ph_final(F); }
    if (PROBE_DUP == PH_FINAL) { xcd_barrier(bar); ENTER(); ph_final(F); }
#undef IN
#undef SEAM
}

extern "C" void kernel_launch(void* const* d_in, const int* in_sizes, int n_in, void* d_out, int out_size, void* d_ws, size_t ws_size, hipStream_t stream) {
    static int grid = 0;
    if (grid == 0) {
        if (n_in != 26 || out_size != T * DM || ws_size < WS_END) { fprintf(stderr, "kernel_launch: unexpected shapes (n_in %d out %d ws %zu)\n", n_in, out_size, ws_size); grid = -1; return; }
        int dev = 0, cus = 0, per_cu = 0;
        if (hipGetDevice(&dev) != hipSuccess || hipDeviceGetAttribute(&cus, hipDeviceAttributeMultiprocessorCount, dev) != hipSuccess) { grid = -1; return; }
        if (hipFuncSetAttribute((const void*)mk_fwd, hipFuncAttributeMaxDynamicSharedMemorySize, LDS_BYTES) != hipSuccess) { grid = -1; return; }
        if (hipOccupancyMaxActiveBlocksPerMultiprocessor(&per_cu, (const void*)mk_fwd, NTHREADS, LDS_BYTES) != hipSuccess || per_cu < 1) { fprintf(stderr, "kernel_launch: occupancy query says %d\n", per_cu); }
        (void)hipGetLastError();
        grid = cus;
    }
    if (grid < 0) return;
    (void)hipMemsetAsync((char*)d_ws + WS_CTL, 0, CTL_ZERO_BYTES, stream);
    Args a{};
    for (int i = 0; i < 26; ++i) a.in[i] = (const float*)d_in[i];
    a.out = (float*)d_out; a.ws = (unsigned char*)d_ws;
#if MK_ONE_LAUNCH
    a.ph_lo = 0; a.ph_hi = N_PHASES;
    hipLaunchKernelGGL(mk_fwd, dim3(grid), dim3(NTHREADS), LDS_BYTES, stream, a);
#else
    for (int p = 0; p < N_PHASES; ++p) { a.ph_lo = p; a.ph_hi = p + 1; hipLaunchKernelGGL(mk_fwd, dim3(grid), dim3(NTHREADS), LDS_BYTES, stream, a); }
#endif
}
```

```cpp
#include <hip/hip_runtime.h>
#include <cstdio>
#include <cstdint>

constexpr int DM = 2048, NB = 8, SEQ = 2048, T = NB * SEQ;
constexpr int HW = 1024;
constexpr int NH = 8, HD = 128;
constexpr int INC = 11264;
constexpr int NE = 32, EPG = 8, NG = 4, DE = 1024;
constexpr float EPS = 1e-6f;
constexpr float LAMBDA_INIT = 0.2f;
constexpr float QSCALE = 0.125f * 1.4426950408889634f;
constexpr int SLOT_MAX = 40960;

constexpr int NWAVES = 8, NTHREADS = 512;
enum { PH_PRO = 0, PH_MOD, PH_H1, PH_PROJ, PH_MIX, PH_YDA, PH_BRANCH, PH_WOUT, PH_POST, PH_MOE1, PH_MOE2, PH_FINAL, N_PHASES };
#ifndef EXPERT_T_IN_MIX
#define EXPERT_T_IN_MIX 1
#endif
#ifndef FAST_POST
#define FAST_POST 1
#endif
#ifndef PROJ_FP8
#define PROJ_FP8 1
#endif
#ifndef PROBE_DUP
#define PROBE_DUP -1
#endif
#ifndef FAST_ATTN
#define FAST_ATTN 1
#endif
#ifndef FAST_HGRN
#define FAST_HGRN 1
#endif
#ifndef FAST_GEMM
#define FAST_GEMM 1
#endif
#ifndef MK_ONE_LAUNCH
#define MK_ONE_LAUNCH 1
#endif

constexpr size_t MiB = 1u << 20;
constexpr size_t WS_CTL = 0, CTL_ZERO_BYTES = 1 * MiB;
constexpr size_t WS_MODP = 1 * MiB;
constexpr size_t WS_ROPE = 4 * MiB;
constexpr size_t WS_LB = 4 * MiB + 256 * 1024;
constexpr size_t WS_LAM = WS_LB + 8192;
constexpr size_t WS_TOKE = 5 * MiB;
constexpr size_t WS_TOKP = 5 * MiB + 256 * 1024;
constexpr size_t WS_LISTTOK = 6 * MiB;
constexpr size_t WS_LISTW = 8 * MiB;
constexpr size_t WS_P64 = 460 * MiB;
constexpr size_t WS_MODF = 10 * MiB;
constexpr size_t WS_WCAT = 11 * MiB;
constexpr size_t WS_WIN_T = 16 * MiB, WS_WBH_T = 60 * MiB, WS_WBD_T = 64 * MiB, WS_WOUT_T = 68 * MiB, WS_WGU_T = 76 * MiB, WS_WD_T = 332 * MiB;
constexpr size_t WS_TMPG = 76 * MiB;
constexpr size_t WS_H1 = 460 * MiB, WS_QHG = 524 * MiB, WS_LOGF = 556 * MiB, WS_VHG = 620 * MiB, WS_GHG = 652 * MiB;
constexpr size_t WS_QDA = 684 * MiB, WS_KDA = 716 * MiB, WS_VDA = 748 * MiB, WS_GATEH = 780 * MiB, WS_GATED = 844 * MiB;
constexpr size_t WS_YCAT = 908 * MiB;
constexpr size_t WS_YHG = WS_YCAT, WS_YDA = WS_YCAT + 2048, WS_O1 = 972 * MiB, WS_O2 = 1004 * MiB, WS_END = 1036 * MiB;
constexpr size_t WS_TMP = 460 * MiB;
constexpr size_t WS_MERGED = 588 * MiB;
constexpr size_t WS_U = 652 * MiB;
constexpr size_t WS_X1 = 460 * MiB;
constexpr size_t WS_H2 = 588 * MiB;
constexpr size_t WS_ACT = 716 * MiB;
constexpr size_t WS_YW = 796 * MiB;
constexpr int CW_TMO = 0, CW_CODE = 1, CW_BAR = 4096, CW_CNT = 8192  , CW_ATTQ = 9216, CW_TQ = 9216 + 128;

constexpr int RING_BYTES = 131072 + 8192;
constexpr int LDSCTL_OFF = RING_BYTES, MISC_OFF = LDSCTL_OFF + 320;
constexpr int LDS_BYTES = 147456;
static_assert(MISC_OFF + 128 <= LDS_BYTES, "LDS map");

#define GAS __attribute__((address_space(1)))
#define LAS __attribute__((address_space(3)))
typedef unsigned short bf16;
typedef float f32x4 __attribute__((ext_vector_type(4)));
typedef unsigned u32x4 __attribute__((ext_vector_type(4)));
typedef unsigned u32x2 __attribute__((ext_vector_type(2)));
typedef float f32x2_t __attribute__((ext_vector_type(2)));
typedef GAS unsigned gu32;
#define RLX_AGENT __ATOMIC_RELAXED, __HIP_MEMORY_SCOPE_AGENT

__device__ __forceinline__ float bf2f(unsigned h) { return __uint_as_float(h << 16); }
__device__ __forceinline__ unsigned f2bf(float f) { unsigned u = __float_as_uint(f); return (u + 0x7fffu + ((u >> 16) & 1u)) >> 16; }
__device__ __forceinline__ unsigned pk2(float lo, float hi) { unsigned r; asm("v_cvt_pk_bf16_f32 %0, %1, %2" : "=v"(r) : "v"(lo), "v"(hi)); return r; }
__device__ __forceinline__ float sigmoidf_(float v) { return __builtin_amdgcn_rcpf(1.0f + __builtin_amdgcn_exp2f(-1.4426950408889634f * v)); }
__device__ __forceinline__ float wave_sum(float v) {
#pragma unroll
    for (int o = 1; o < 64; o <<= 1) v += __shfl_xor(v, o);
    return v;
}

#define XB_TMO      128
#define XB_XCNT(j)  (256  + 64 * (j))
#define XB_XSUB(j)  (1280 + 64 * (j))
#define XB_XGEN(j)  (2304 + 64 * (j))
#define XB_TOP      3328
#define XB_TOPGEN   3392
#define XCD_BAR_WORDS 3456
#define XB_SPIN_CAP (1u << 22)
__device__ __forceinline__ unsigned xb_ld(unsigned* p)              { return __hip_atomic_load(p, __ATOMIC_RELAXED, __HIP_MEMORY_SCOPE_AGENT); }
__device__ __forceinline__ unsigned xb_add(unsigned* p, unsigned v) { return __hip_atomic_fetch_add(p, v, __ATOMIC_RELAXED, __HIP_MEMORY_SCOPE_AGENT); }
__device__ __forceinline__ unsigned xb_xcc_id() { return (unsigned)__builtin_amdgcn_s_getreg((3 << 11) | 20) & 0xFu; }
#define XB_SPIN(cond, bar) do { unsigned _sp = 0; while (cond) { __builtin_amdgcn_s_sleep(1); \
    if ((++_sp & 255u) == 0u) { if (xb_ld(&(bar)[XB_TMO])) break; if (_sp > XB_SPIN_CAP) { atomicAdd(&(bar)[XB_TMO], 1u); break; } } } } while (0)
struct XcdBarrier { unsigned* bar; unsigned x; volatile LAS unsigned* st; };
__device__ __forceinline__ XcdBarrier xcd_barrier_post(unsigned* bar, volatile LAS unsigned* st) {
    XcdBarrier b; b.bar = bar; b.x = xb_xcc_id(); b.st = st;
    if (threadIdx.x == 0) (void)xb_add(&bar[XB_XCNT(b.x)], 1u);
    return b;
}
__device__ __forceinline__ void xcd_barrier_complete(unsigned* bar, unsigned x, unsigned& nloc, unsigned& nx) {
    const unsigned G = gridDim.x * gridDim.y * gridDim.z;
    unsigned sum, cnt, mine, sp = 0u;
    for (;;) {
        sum = 0u; cnt = 0u; mine = 0u;
#pragma unroll
        for (unsigned j = 0; j < 16; ++j) { const unsigned c = xb_ld(&bar[XB_XCNT(j)]); sum += c; cnt += (c > 0u) ? 1u : 0u; mine = (j == x) ? c : mine; }
        if (sum == G) break;
        __builtin_amdgcn_s_sleep(1);
        if ((++sp & 255u) == 0u) { if (xb_ld(&bar[XB_TMO])) break; if (sp > XB_SPIN_CAP) { atomicAdd(&bar[XB_TMO], 1u); break; } }
    }
    nloc = mine > 0u ? mine : 1u; nx = cnt > 0u ? cnt : 1u;
}
__device__ __forceinline__ void xcd_barrier(const XcdBarrier& b) {
    asm volatile("s_waitcnt vmcnt(0)" ::: "memory");
    __syncthreads();
    if (threadIdx.x == 0) {
        unsigned* bar = b.bar;
        __builtin_amdgcn_s_waitcnt(0);
        unsigned nloc = b.st[0], nx = b.st[1];
        if (nloc == 0u) { xcd_barrier_complete(bar, b.x, nloc, nx); b.st[0] = nloc; b.st[1] = nx; }
        const unsigned old = xb_add(&bar[XB_XSUB(b.x)], 1u);
        const unsigned gen = old / nloc;
        if (old + 1u == (gen + 1u) * nloc) {
            __builtin_amdgcn_fence(__ATOMIC_RELEASE, "agent");
            asm volatile("s_waitcnt vmcnt(0)" ::: "memory");
            const unsigned og = xb_add(&bar[XB_TOP], 1u);
            const unsigned tg = og / nx;
            if (og + 1u == (tg + 1u) * nx) xb_add(&bar[XB_TOPGEN], 1u);
            else XB_SPIN(xb_ld(&bar[XB_TOPGEN]) == tg, bar);
            __builtin_amdgcn_fence(__ATOMIC_ACQUIRE, "agent");
            xb_add(&bar[XB_XGEN(b.x)], 1u);
            asm volatile("s_waitcnt vmcnt(0)" ::: "memory");
        } else {
            XB_SPIN(xb_ld(&bar[XB_XGEN(b.x)]) == gen, bar);
            __builtin_amdgcn_fence(__ATOMIC_ACQUIRE, "agent");
            asm volatile("s_waitcnt vmcnt(0)" ::: "memory");
        }
    }
    __syncthreads();
}

struct Frame {
    LAS unsigned char* lds;
    gu32* ctl;
    int tid, lane, wave, G, bid;
    unsigned char* ws;
    const float* x; const float* c; const float* w_ada; const float* b_ada;
    const float *pre_mix, *post_mix, *pre_ffn, *post_ffn;
    const float* w_in; const float* hg_lb; const float* hg_nw;
    const float *lq1, *lk1, *lq2, *lk2; const float* da_nw;
    const float *w_bhg, *w_bda, *w_out, *w_group, *b_group, *w_router, *b_router, *w_gate, *w_up, *w_down;
    float* out;
};
template <class Tp> __device__ __forceinline__ Tp* wsp(const Frame& F, size_t off) { return (Tp*)(F.ws + off); }

__device__ __forceinline__ void mod_vec(const Frame& F, LAS float* dst, int chunk, int batch) {
    const float* M = wsp<const float>(F, WS_MODF) + (batch * 6 + chunk) * DM;
    for (int j = F.tid; j < DM; j += NTHREADS) dst[j] = M[j];
}
__device__ __forceinline__ void ph_mod(Frame& F) {
    const int gt = F.bid * NTHREADS + F.tid, NGT = F.G * NTHREADS;
    const float* P = wsp<const float>(F, WS_P64); float* MF = wsp<float>(F, WS_MODF);
    for (int o = gt; o < NB * 6 * DM; o += NGT) {
        const int b = o / (6 * DM), col = o % (6 * DM);
        float s0 = 0.f, s1 = 0.f, s2 = 0.f, s3 = 0.f;
#pragma unroll 4
        for (int kc = 0; kc < 64; kc += 4) {
            s0 += P[(size_t)((kc + 0) * 8 + b) * (6 * DM) + col]; s1 += P[(size_t)((kc + 1) * 8 + b) * (6 * DM) + col];
            s2 += P[(size_t)((kc + 2) * 8 + b) * (6 * DM) + col]; s3 += P[(size_t)((kc + 3) * 8 + b) * (6 * DM) + col];
        }
        MF[o] = F.b_ada[col] + ((s0 + s1) + (s2 + s3));
    }
}

template <class Rows, class Epi>
__device__ __forceinline__ void sg_tile(LAS float* As, LAS float* Bs, const bf16* A, int lda, const Rows& rows, const float* B, int ldb, int n0, int K, const Epi& epi) {
    int tid = threadIdx.x; asm volatile("" : "+v"(tid));
    const int tx = tid & 15, ty = tid >> 4;
    float acc[4][8];
#pragma unroll
    for (int i = 0; i < 4; ++i)
#pragma unroll
        for (int j = 0; j < 8; ++j) acc[i][j] = 0.f;
    const int ar = tid >> 2, akq = tid & 3;
    const int arow = rows(ar);
    const bf16* ap = A + (size_t)(arow < 0 ? 0 : arow) * lda + akq * 4;
    const int bk = tid >> 5, bn = (tid & 31) * 4;
    const float* bp = B + (size_t)bk * ldb + n0 + bn;
    for (int k0 = 0; k0 < K; k0 += 16) {
        u32x2 av = *(const u32x2*)(ap + k0);
        const f32x4 bv = *(const f32x4*)(bp + (size_t)k0 * ldb);
        if (arow < 0) { av.x = 0u; av.y = 0u; }
        __syncthreads();
        As[(akq * 4 + 0) * 132 + ar] = bf2f(av.x & 0xffffu);
        As[(akq * 4 + 1) * 132 + ar] = bf2f(av.x >> 16);
        As[(akq * 4 + 2) * 132 + ar] = bf2f(av.y & 0xffffu);
        As[(akq * 4 + 3) * 132 + ar] = bf2f(av.y >> 16);
        *(LAS f32x4*)&Bs[bk * 132 + bn] = bv;
        __syncthreads();
#pragma unroll 2
        for (int kk = 0; kk < 16; ++kk) {
            const f32x4 a4 = *(const LAS f32x4*)&As[kk * 132 + ty * 4];
            const f32x4 b0 = *(const LAS f32x4*)&Bs[kk * 132 + tx * 8];
            const f32x4 b1 = *(const LAS f32x4*)&Bs[kk * 132 + tx * 8 + 4];
#pragma unroll
            for (int i = 0; i < 4; ++i) {
                acc[i][0] += a4[i] * b0[0]; acc[i][1] += a4[i] * b0[1]; acc[i][2] += a4[i] * b0[2]; acc[i][3] += a4[i] * b0[3];
                acc[i][4] += a4[i] * b1[0]; acc[i][5] += a4[i] * b1[1]; acc[i][6] += a4[i] * b1[2]; acc[i][7] += a4[i] * b1[3];
            }
        }
    }
#pragma unroll
    for (int i = 0; i < 4; ++i) epi(ty * 4 + i, n0 + tx * 8, acc[i]);
}
struct RowsDense { int m0; __device__ __forceinline__ int operator()(int r) const { return m0 + r; } };
struct RowsList { const int* list; int n; __device__ __forceinline__ int operator()(int r) const { return r < n ? list[r] : -1; } };

__device__ __forceinline__ void store8_bf16(bf16* p, const float (&v)[8]) {
    u32x4 w; w.x = pk2(v[0], v[1]); w.y = pk2(v[2], v[3]); w.z = pk2(v[4], v[5]); w.w = pk2(v[6], v[7]);
    *(u32x4*)p = w;
}

__device__ __forceinline__ void proj_store8(const Frame& F, int row, int col0, const float (&vin)[8], int pxor) {
    const int sec = col0 >> 10;
    float v[8];
#pragma unroll
    for (int i = 0; i < 8; ++i) v[i] = vin[i];
    if (sec == 0) {
#pragma unroll
        for (int i = 0; i < 8; ++i) v[i] = v[i] * sigmoidf_(v[i]);
        store8_bf16(wsp<bf16>(F, WS_QHG) + (size_t)row * HW + col0, v);
    } else if (sec == 1) {
        const int j = col0 - 1024; const float* lb = wsp<const float>(F, WS_LB) + j;
        float* o = wsp<float>(F, WS_LOGF) + (size_t)row * HW + j;
        f32x4 o0, o1;
#pragma unroll
        for (int i = 0; i < 8; ++i) { const float l = lb[i]; const float f = l + (1.0f - l) * sigmoidf_(v[i]); const float lf = __logf(f); if (i < 4) o0[i] = lf; else o1[i - 4] = lf; }
        *(f32x4*)o = o0; *(f32x4*)(o + 4) = o1;
    } else if (sec == 2) {
        store8_bf16(wsp<bf16>(F, WS_VHG) + (size_t)row * HW + (col0 - 2048), v);
    } else if (sec == 3) {
#pragma unroll
        for (int i = 0; i < 8; ++i) v[i] = sigmoidf_(v[i]);
        store8_bf16(wsp<bf16>(F, WS_GHG) + (size_t)row * HW + (col0 - 3072), v);
    } else if (sec == 4 || sec == 5) {
        const int d0 = col0 & 63;
        float pv[8];
#pragma unroll
        for (int i = 0; i < 8; ++i) pv[i] = __shfl_xor(v[i], pxor);
        if (d0 < 16) {
            const float* rt = wsp<const float>(F, WS_ROPE) + (size_t)(row & (SEQ - 1)) * 16;
            const f32x4 c0 = *(const f32x4*)rt, c1 = *(const f32x4*)(rt + 4), s0 = *(const f32x4*)(rt + 8), s1 = *(const f32x4*)(rt + 12);
            const float sg = (d0 == 0) ? -1.0f : 1.0f;
#pragma unroll
            for (int i = 0; i < 8; ++i) { const float cs = i < 4 ? c0[i] : c1[i - 4], sn = i < 4 ? s0[i] : s1[i - 4]; v[i] = v[i] * cs + sg * pv[i] * sn; }
        }
        if (sec == 4) {
#pragma unroll
            for (int i = 0; i < 8; ++i) v[i] *= QSCALE;
            store8_bf16(wsp<bf16>(F, WS_QDA) + (size_t)row * HW + (col0 - 4096), v);
        } else store8_bf16(wsp<bf16>(F, WS_KDA) + (size_t)row * HW + (col0 - 5120), v);
    } else if (sec == 6) {
        store8_bf16(wsp<bf16>(F, WS_VDA) + (size_t)row * HW + (col0 - 6144), v);
    } else {
#pragma unroll
        for (int i = 0; i < 8; ++i) v[i] = sigmoidf_(v[i]);
        if (sec < 9) store8_bf16(wsp<bf16>(F, WS_GATEH) + (size_t)row * DM + (col0 - 7168), v);
        else store8_bf16(wsp<bf16>(F, WS_GATED) + (size_t)row * DM + (col0 - 9216), v);
    }
}


constexpr float Y8S = 8.0f, Y8I = 1.0f / 8.0f;
constexpr float W8S = 64.0f, W8I = 1.0f / 64.0f;
__device__ __forceinline__ unsigned pk4_fp8(float a, float b, float c, float d) { const int p = __builtin_amdgcn_cvt_pk_fp8_f32(a, b, 0, false); return (unsigned)__builtin_amdgcn_cvt_pk_fp8_f32(c, d, p, true); }
__device__ __forceinline__ float clamp8(float v) { return __builtin_amdgcn_fmed3f(v, -448.0f, 448.0f); }
namespace fg {
typedef short bf16x8 __attribute__((ext_vector_type(8)));
constexpr int BM = 256, BK = 64, HALF = 128, HTB = HALF * BK * 2, STAGE_BYTES = 8 * HTB, NXCD = 8, WGM = 8;
__device__ __forceinline__ int lds_byte(int r, int c) { const int st = (r >> 4) * 2 + (c >> 5), rr = r & 15, cc = c & 31, ob = rr * 64 + cc * 2; return st * 1024 + (ob ^ (((ob >> 9) & 1) << 5)); }
__device__ __forceinline__ void stage_rc(int b, int& R, int& C) { const int st = b / 1024, sb = b % 1024, swz = sb ^ (((sb >> 9) & 1) << 5); R = (st >> 1) * 16 + swz / 64; C = (st & 1) * 32 + (swz % 64) / 2; }
__device__ __forceinline__ int perm32(int rho) { const int n = rho >> 4, i = rho & 15; return 8 * (i >> 2) + 4 * n + (i & 3); }
struct Unit { int pm, pn, e, nvalid, slot0; };
typedef int i32x8 __attribute__((ext_vector_type(8)));
typedef short s16x16 __attribute__((ext_vector_type(16)));
__device__ __forceinline__ i32x8 cat16(bf16x8 a, bf16x8 b) { const s16x16 v = __builtin_shufflevector(a, b, 0, 1, 2, 3, 4, 5, 6, 7, 8, 9, 10, 11, 12, 13, 14, 15); return __builtin_bit_cast(i32x8, v); }
__device__ __forceinline__ unsigned cvt_pk_bf16(float lo, float hi) { unsigned r; asm volatile("v_cvt_pk_bf16_f32 %0, %1, %2" : "=v"(r) : "v"(lo), "v"(hi)); return r; }

template <bool FP8_ = false> struct DenseOrderT {
    int nM, nN, nwg, G, c; const char* A; const char* Bt; int K;
    __device__ __forceinline__ void init(const void* A_, const void* Bt_, int M, int N, int K_, int G_, int c_) { A = (const char*)A_; Bt = (const char*)Bt_; K = K_; nM = M / BM; nN = N / BM; nwg = nM * nN; G = G_; c = c_; }
    __device__ __forceinline__ bool next(int i, Unit& u) const {
        const long L = (long)i * G + c; if (L >= nwg) return false;
        int wgid = (int)L; { const int q = nwg / NXCD, r = nwg % NXCD, xcd = wgid % NXCD, off = wgid / NXCD; wgid = (xcd < r ? xcd * (q + 1) : r * (q + 1) + (xcd - r) * q) + off; }
        const int nig = WGM * nN, gid = wgid / nig, fm = gid * WGM, gsz = (nM - fm) < WGM ? (nM - fm) : WGM;
        u.pm = fm + ((wgid % nig) % gsz); u.pn = (wgid % nig) / gsz; u.e = 0; u.nvalid = BM; u.slot0 = u.pm * BM; return true;
    }
    static constexpr bool GATHER = FP8_, FP8 = FP8_;
    __device__ __forceinline__ const char* a_ptr(const Unit& u) const { return GATHER ? A : A + (size_t)u.pm * BM * K * 2; }
    __device__ __forceinline__ int a_row(const Unit& u, int r) const { return u.pm * BM + r; }
    __device__ __forceinline__ const char* b_ptr(const Unit& u) const { return Bt + (size_t)u.pn * BM * K * 2; }
};

typedef DenseOrderT<false> DenseOrder;
template <class Epi, class Sched>
__device__ __forceinline__ void gemm_phase(LAS unsigned char* lds, const int K, const Sched& S, const Epi& E) {
    int tid = threadIdx.x; asm volatile("" : "+v"(tid));
    const int wid = __builtin_amdgcn_readfirstlane(tid >> 6), lane = tid & 63, wr = wid >> 2, wc = wid & 3, fr = lane & 15, fq = lane >> 4;
    const int nt = K / BK;
    constexpr bool GA = Sched::GATHER;
    int RA[2]; unsigned voffA[2], voffB[2];
#pragma unroll
    for (int i = 0; i < 2; ++i) { int R, C; stage_rc(tid * 16 + i * 8192, R, C); const int Rb = Epi::PERM ? ((R & ~31) + perm32(R & 31)) : R;
        RA[i] = R; voffA[i] = GA ? (unsigned)C * 2u : (unsigned)(R * K + C) * 2u; voffB[i] = (unsigned)(Rb * K + C) * 2u; }
    const size_t kstep = (size_t)(BK * 2);
    const size_t hstep = (size_t)HALF * K * 2;
    const unsigned ldsw = (unsigned)wid * 1024u;
    const int aoff = lds_byte(wr * 64 + fr, fq * 8), boff = lds_byte(wc * 32 + fr, fq * 8);
    const unsigned rowb = (unsigned)K * 2u;
#define PG8_SA(b, h) (((b) * 2 + (h)) * HTB)
#define PG8_SB(b, h) ((4 + (b) * 2 + (h)) * HTB)
#define PG8_STAGE(bufoff, gbase, voff) do { _Pragma("unroll") for (int _i = 0; _i < 2; ++_i) \
        __builtin_amdgcn_global_load_lds((const unsigned*)((const char*)(gbase) + (voff)[_i]), (LAS unsigned*)(lds + (bufoff) + ldsw + _i * 8192), 16, 0, 0); } while (0)
#define PG8_STAGE_A(bufoff, h, kb) do { if constexpr (GA) { PG8_STAGE(bufoff, cA + (kb), oc[h]); } else { PG8_STAGE(bufoff, cA + (kb) + (h) * hstep, voffA); } } while (0)
#define PG8_LDA(dst, b, h) do { if constexpr (Sched::FP8) { _Pragma("unroll") for (int m = 0; m < 4; ++m) dst##8[m] = cat16(*(const LAS bf16x8*)(lds + PG8_SA(b, h) + aoff + m * 2048), *(const LAS bf16x8*)(lds + PG8_SA(b, h) + aoff + m * 2048 + 1024)); } \
        else { _Pragma("unroll") for (int m = 0; m < 4; ++m) _Pragma("unroll") for (int k = 0; k < 2; ++k) dst[m][k] = *(const LAS bf16x8*)(lds + PG8_SA(b, h) + aoff + m * 2048 + k * 1024); } } while (0)
#define PG8_LDB(dst, b, h) do { if constexpr (Sched::FP8) { _Pragma("unroll") for (int n = 0; n < 2; ++n) dst##8[n] = cat16(*(const LAS bf16x8*)(lds + PG8_SB(b, h) + boff + n * 2048), *(const LAS bf16x8*)(lds + PG8_SB(b, h) + boff + n * 2048 + 1024)); } \
        else { _Pragma("unroll") for (int n = 0; n < 2; ++n) _Pragma("unroll") for (int k = 0; k < 2; ++k) dst[n][k] = *(const LAS bf16x8*)(lds + PG8_SB(b, h) + boff + n * 2048 + k * 1024); } } while (0)
#define PG8_MMA(ai, bj, At, Bt) do { __builtin_amdgcn_s_setprio(1); _Pragma("unroll") for (int m = 0; m < 4; ++m) _Pragma("unroll") for (int n = 0; n < 2; ++n) { \
        if constexpr (Sched::FP8) acc[ai][bj][m][n] = __builtin_amdgcn_mfma_scale_f32_16x16x128_f8f6f4(Bt##8[n], At##8[m], acc[ai][bj][m][n], 0, 0, 0, 0, 0, 0); \
        else { _Pragma("unroll") for (int k = 0; k < 2; ++k) acc[ai][bj][m][n] = __builtin_amdgcn_mfma_f32_16x16x32_bf16(Bt[n][k], At[m][k], acc[ai][bj][m][n], 0, 0, 0); } } \
        __builtin_amdgcn_s_setprio(0); } while (0)
#define PG8_WAIT_V(n) asm volatile("s_waitcnt vmcnt(" #n ")" ::: "memory")
#define PG8_WAIT_L(n) asm volatile("s_waitcnt lgkmcnt(" #n ")" ::: "memory")
#define PG8_BAR __builtin_amdgcn_s_barrier()
#define PG8_SCHED __builtin_amdgcn_sched_barrier(0)
#define PG8_AOFFS(dst, u) do { _Pragma("unroll") for (int _h = 0; _h < 2; ++_h) _Pragma("unroll") for (int _i = 0; _i < 2; ++_i) dst[_h][_i] = (unsigned)S.a_row(u, _h * HALF + RA[_i]) * rowb + voffA[_i]; } while (0)
    Unit cur, nxt; int ui = 0;
    if (!S.next(0, cur)) return;
    f32x4 acc[2][2][4][2];
#pragma unroll
    for (int a = 0; a < 2; ++a)
#pragma unroll
        for (int b = 0; b < 2; ++b)
#pragma unroll
            for (int m = 0; m < 4; ++m)
#pragma unroll
                for (int n = 0; n < 2; ++n) acc[a][b][m][n] = (f32x4){0.f, 0.f, 0.f, 0.f};
    bf16x8 At[4][2], B0[2][2], B1[2][2];
    i32x8 At8[4], B08[2], B18[2];
    unsigned oc[2][2] = {{0u, 0u}, {0u, 0u}}, on[2][2] = {{0u, 0u}, {0u, 0u}};
    const char* cA = S.a_ptr(cur); const char* cB = S.b_ptr(cur);
    if constexpr (GA) PG8_AOFFS(oc, cur);
    PG8_STAGE(PG8_SB(0, 0), cB, voffB); PG8_STAGE(PG8_SB(0, 1), cB + hstep, voffB); PG8_STAGE_A(PG8_SA(0, 0), 0, 0); PG8_STAGE_A(PG8_SA(0, 1), 1, 0);
    if (wr == 1) PG8_BAR;
    PG8_WAIT_V(2); PG8_BAR;
    PG8_STAGE(PG8_SB(1, 0), cB + kstep, voffB); PG8_STAGE_A(PG8_SA(1, 0), 0, kstep); PG8_STAGE(PG8_SB(1, 1), cB + hstep + kstep, voffB);
    PG8_WAIT_V(6); PG8_BAR;
    for (;;) {
        const bool has_next = S.next(ui + 1, nxt);
        const char* nA = cA; const char* nB = cB;
        if (has_next) { nA = S.a_ptr(nxt); nB = S.b_ptr(nxt); if constexpr (GA) PG8_AOFFS(on, nxt); }
        else if constexpr (GA) {
#pragma unroll
            for (int _h = 0; _h < 2; ++_h)
#pragma unroll
                for (int _i = 0; _i < 2; ++_i) on[_h][_i] = oc[_h][_i];
        }
#pragma unroll 1
        for (int t = 0; t < nt; t += 2) {
            const bool last = (t == nt - 2);
            if constexpr (Epi::MID) { if (t == (nt >> 1)) E.mid(acc, cur, wr, wc, fr, fq); }
            PG8_LDB(B0, 0, 0); PG8_LDB(B1, 0, 1); PG8_SCHED; PG8_LDA(At, 0, 0); PG8_STAGE_A(PG8_SA(1, 1), 1, (size_t)(t + 1) * kstep);
            if (last) {
                cA = nA; cB = nB;
                if constexpr (GA) {
#pragma unroll
                    for (int _h = 0; _h < 2; ++_h)
#pragma unroll
                        for (int _i = 0; _i < 2; ++_i) oc[_h][_i] = on[_h][_i];
                }
            }
            const size_t k2 = last ? (size_t)0 : (size_t)(t + 2) * kstep, k3 = k2 + kstep;
            PG8_WAIT_V(8); PG8_WAIT_L(0); PG8_BAR; PG8_MMA(0, 0, At, B0); PG8_MMA(0, 1, At, B1); PG8_BAR; PG8_SCHED;
            PG8_LDA(At, 0, 1); PG8_STAGE(PG8_SB(0, 0), cB + k2, voffB); PG8_STAGE(PG8_SB(0, 1), cB + k2 + hstep, voffB); PG8_STAGE_A(PG8_SA(0, 0), 0, k2);
            PG8_WAIT_V(8); PG8_WAIT_L(0); PG8_BAR; PG8_MMA(1, 0, At, B0); PG8_MMA(1, 1, At, B1); PG8_BAR; PG8_SCHED;
            PG8_LDB(B0, 1, 0); PG8_LDB(B1, 1, 1); PG8_SCHED; PG8_LDA(At, 1, 0); PG8_STAGE_A(PG8_SA(0, 1), 1, k2);
            PG8_WAIT_V(8); PG8_WAIT_L(0); PG8_BAR; PG8_MMA(0, 0, At, B0); PG8_MMA(0, 1, At, B1); PG8_BAR; PG8_SCHED;
            PG8_LDA(At, 1, 1); PG8_STAGE(PG8_SB(1, 0), cB + k3, voffB); PG8_STAGE(PG8_SB(1, 1), cB + k3 + hstep, voffB); PG8_STAGE_A(PG8_SA(1, 0), 0, k3);
            PG8_WAIT_V(8); PG8_WAIT_L(0); PG8_BAR; PG8_MMA(1, 0, At, B0); PG8_MMA(1, 1, At, B1); PG8_BAR; PG8_SCHED;
        }
        if (wr == 0) PG8_BAR;
        E(acc, cur, wr, wc, fr, fq);
        if (!has_next) break;
#pragma unroll
        for (int a = 0; a < 2; ++a)
#pragma unroll
            for (int b = 0; b < 2; ++b)
#pragma unroll
                for (int m = 0; m < 4; ++m)
#pragma unroll
                    for (int n = 0; n < 2; ++n) acc[a][b][m][n] = (f32x4){0.f, 0.f, 0.f, 0.f};
        cur = nxt; ++ui;
        if (wr == 1) PG8_BAR;
    }
    PG8_WAIT_V(0);
    PG8_BAR;
#undef PG8_SA
#undef PG8_SB
#undef PG8_STAGE
#undef PG8_STAGE_A
#undef PG8_LDA
#undef PG8_LDB
#undef PG8_MMA
#undef PG8_WAIT_V
#undef PG8_WAIT_L
#undef PG8_BAR
#undef PG8_SCHED
#undef PG8_AOFFS
}
}

template <bool F8 = false>
__device__ __forceinline__ void transpose_item(const float* W, int K, int N, bf16* WT, int k0, int n0, int drow, LAS float* scr, int lane, int ldt = 0, int kd0 = 0) {
    if (ldt == 0) ldt = K;
    float tv[32];
#pragma unroll
    for (int i = 0; i < 32; ++i) tv[i] = W[(size_t)(k0 + 2 * i + (lane >> 5)) * N + n0 + (lane & 31)];
#pragma unroll
    for (int i = 0; i < 32; ++i) scr[(2 * i + (lane >> 5)) * 33 + (lane & 31)] = tv[i];
    asm volatile("s_waitcnt lgkmcnt(0)" ::: "memory");
    const int c = lane & 7;
#pragma unroll
    for (int j = 0; j < 4; ++j) { const int n = (lane >> 3) + 8 * j; const LAS float* sp = scr + (8 * c) * 33 + n;
        if constexpr (F8) { u32x2 o; o.x = pk4_fp8(sp[0 * 33] * W8S, sp[1 * 33] * W8S, sp[2 * 33] * W8S, sp[3 * 33] * W8S); o.y = pk4_fp8(sp[4 * 33] * W8S, sp[5 * 33] * W8S, sp[6 * 33] * W8S, sp[7 * 33] * W8S);
            *(u32x2*)((unsigned char*)WT + (size_t)(drow + n) * ldt + kd0 + k0 + 8 * c) = o; }
        else { u32x4 o; o.x = pk2(sp[0 * 33], sp[1 * 33]); o.y = pk2(sp[2 * 33], sp[3 * 33]); o.z = pk2(sp[4 * 33], sp[5 * 33]); o.w = pk2(sp[6 * 33], sp[7 * 33]);
            *(u32x4*)(WT + (size_t)(drow + n) * ldt + kd0 + k0 + 8 * c) = o; } }
    asm volatile("s_waitcnt lgkmcnt(0)" ::: "memory");
}

__device__ __forceinline__ void transpose_item2(const float* W, int K, int N, bf16* WT, int k0, int n0a, int drowa, int n0b, int drowb, LAS float* scr, int lane) {
    float ta[32], tb[32];
#pragma unroll
    for (int i = 0; i < 32; ++i) ta[i] = W[(size_t)(k0 + 2 * i + (lane >> 5)) * N + n0a + (lane & 31)];
#pragma unroll
    for (int i = 0; i < 32; ++i) tb[i] = W[(size_t)(k0 + 2 * i + (lane >> 5)) * N + n0b + (lane & 31)];
    const int c = lane & 7;
#pragma unroll
    for (int i = 0; i < 32; ++i) scr[(2 * i + (lane >> 5)) * 33 + (lane & 31)] = ta[i];
    asm volatile("s_waitcnt lgkmcnt(0)" ::: "memory");
#pragma unroll
    for (int j = 0; j < 4; ++j) { const int n = (lane >> 3) + 8 * j; const LAS float* sp = scr + (8 * c) * 33 + n;
        u32x4 o; o.x = pk2(sp[0 * 33], sp[1 * 33]); o.y = pk2(sp[2 * 33], sp[3 * 33]); o.z = pk2(sp[4 * 33], sp[5 * 33]); o.w = pk2(sp[6 * 33], sp[7 * 33]);
        *(u32x4*)(WT + (size_t)(drowa + n) * K + k0 + 8 * c) = o; }
    asm volatile("s_waitcnt lgkmcnt(0)" ::: "memory");
#pragma unroll
    for (int i = 0; i < 32; ++i) scr[(2 * i + (lane >> 5)) * 33 + (lane & 31)] = tb[i];
    asm volatile("s_waitcnt lgkmcnt(0)" ::: "memory");
#pragma unroll
    for (int j = 0; j < 4; ++j) { const int n = (lane >> 3) + 8 * j; const LAS float* sp = scr + (8 * c) * 33 + n;
        u32x4 o; o.x = pk2(sp[0 * 33], sp[1 * 33]); o.y = pk2(sp[2 * 33], sp[3 * 33]); o.z = pk2(sp[4 * 33], sp[5 * 33]); o.w = pk2(sp[6 * 33], sp[7 * 33]);
        *(u32x4*)(WT + (size_t)(drowb + n) * K + k0 + 8 * c) = o; }
    asm volatile("s_waitcnt lgkmcnt(0)" ::: "memory");
}

__device__ __forceinline__ void ph_prologue(Frame& F) {
    const int gw = F.bid * NWAVES + F.wave, NGW = F.G * NWAVES;
    LAS float* SC = (LAS float*)(F.lds + 8 * 8704);
    for (int i = F.tid; i < NB * DM; i += NTHREADS) { const float cv = F.c[i]; SC[i] = cv * sigmoidf_(cv); }
    __syncthreads();
    float* P = wsp<float>(F, WS_P64);
    for (int it = gw; it < 48 * 64; it += NGW) {
        const int cb = it % 48, kc = it / 48;
        f32x4 acc[8];
#pragma unroll
        for (int b = 0; b < 8; ++b) acc[b] = (f32x4){0.f, 0.f, 0.f, 0.f};
        const float* wp = F.w_ada + (size_t)(kc * 32) * (6 * DM) + cb * 256 + F.lane * 4;
        const LAS float* cp = SC + kc * 32;
#pragma unroll 1
        for (int k0 = 0; k0 < 32; k0 += 8) {
            f32x4 w[8];
#pragma unroll
            for (int k = 0; k < 8; ++k) w[k] = *(const f32x4*)(wp + (size_t)(k0 + k) * (6 * DM));
#pragma unroll
            for (int k = 0; k < 8; ++k)
#pragma unroll
                for (int b = 0; b < 8; ++b) acc[b] += w[k] * cp[b * DM + k0 + k];
        }
#pragma unroll
        for (int b = 0; b < 8; ++b) *(f32x4*)(P + (size_t)(kc * 8 + b) * (6 * DM) + cb * 256 + F.lane * 4) = acc[b];
    }
    const int gt = F.bid * NTHREADS + F.tid, NGT = F.G * NTHREADS;
    float* rope = wsp<float>(F, WS_ROPE);
    for (int i = gt; i < SEQ * 8; i += NGT) {
        const int pos = i >> 3, j = i & 7;
        const float invf = powf(500000.0f, -(float)(2 * j) / 16.0f);
        const float ang = (float)pos * invf;
        float sn, cs; sincosf(ang, &sn, &cs);
        rope[pos * 16 + j] = cs; rope[pos * 16 + 8 + j] = sn;
    }
    bf16* wch = wsp<bf16>(F, WS_WCAT); bf16* wcl = wch + 48 * DM;
    for (int i = gt; i < DM * 48; i += NGT) { const int c = i / DM, k = i % DM; const float v = c < 4 ? F.w_group[k * 4 + c] : (c < 36 ? F.w_router[k * 32 + c - 4] : 0.f);
        const unsigned hi = f2bf(v); wch[i] = (bf16)hi; wcl[i] = (bf16)f2bf(v - bf2f(hi)); }
    float* lb = wsp<float>(F, WS_LB);
    for (int i = gt; i < HW; i += NGT) { const float p0 = F.hg_lb[i], p1 = F.hg_lb[HW + i]; lb[i] = 1.0f / (1.0f + __expf(p1 - p0)); }
    if (F.bid == 0 && F.wave == 0) {
        const float a = wave_sum(F.lq1[F.lane] * F.lk1[F.lane]), b = wave_sum(F.lq2[F.lane] * F.lk2[F.lane]);
        if (F.lane == 0) *wsp<float>(F, WS_LAM) = __expf(a) - __expf(b) + LAMBDA_INIT;
    }
}

__device__ __forceinline__ void ph_h1(Frame& F) {
    LAS float* Lsh = (LAS float*)F.lds; LAS float* Lsc = Lsh + DM;
    bf16* H1 = wsp<bf16>(F, WS_H1);
    for (int rb = F.bid; rb < T / 64; rb += F.G) {
        const int batch = (rb * 64) / SEQ;
        __syncthreads(); mod_vec(F, Lsh, 0, batch); mod_vec(F, Lsc, 1, batch); __syncthreads();
#pragma unroll 1
        for (int half = 0; half < 2; ++half) {
            const int row0 = rb * 64 + F.wave * 8 + half * 4;
            f32x4 v[4][8];
#pragma unroll
            for (int r = 0; r < 4; ++r)
#pragma unroll
                for (int j = 0; j < 8; ++j) v[r][j] = *(const f32x4*)(F.x + (size_t)(row0 + r) * DM + 4 * F.lane + 256 * j);
            f32x4 wv[8];
#pragma unroll
            for (int j = 0; j < 8; ++j) wv[j] = *(const f32x4*)(F.pre_mix + 4 * F.lane + 256 * j);
#pragma unroll
            for (int r = 0; r < 4; ++r) {
                float s = 0.f;
#pragma unroll
                for (int j = 0; j < 8; ++j) s += (v[r][j][0] * v[r][j][0] + v[r][j][1] * v[r][j][1]) + (v[r][j][2] * v[r][j][2] + v[r][j][3] * v[r][j][3]);
                const float rstd = 1.0f / sqrtf(wave_sum(s) * (1.0f / DM) + EPS);
#pragma unroll
                for (int j = 0; j < 8; ++j) {
                    const int c0 = 4 * F.lane + 256 * j;
                    const f32x4 w = wv[j];
                    const f32x4 sc = *(const LAS f32x4*)(Lsc + c0), sh = *(const LAS f32x4*)(Lsh + c0);
                    const f32x4 h = v[r][j] * rstd * w * (sc + 1.0f) + sh;
#if PROJ_FP8
                    *(unsigned*)((unsigned char*)H1 + (size_t)(row0 + r) * DM + c0) = pk4_fp8(clamp8(h[0]), clamp8(h[1]), clamp8(h[2]), clamp8(h[3]));
#else
                    u32x2 o; o.x = pk2(h[0], h[1]); o.y = pk2(h[2], h[3]);
                    *(u32x2*)(H1 + (size_t)(row0 + r) * DM + c0) = o;
#endif
                }
            }
        }
    }
}

struct EpiProj { const Frame* F; int m0; __device__ __forceinline__ void operator()(int r, int col0, const float (&v)[8]) const { proj_store8(*F, m0 + r, col0, v, 1); } };
__device__ __forceinline__ void ph_proj_simple(Frame& F) {
    LAS float* As = (LAS float*)F.lds; LAS float* Bs = As + 16 * 132;
    const int NT_ = INC / 128, MT_ = T / 128;
    for (int t = F.bid; t < NT_ * MT_; t += F.G) {
        const int mt = t / NT_, nt = t % NT_;
        RowsDense rows{mt * 128}; EpiProj epi{&F, mt * 128};
        sg_tile(As, Bs, wsp<const bf16>(F, WS_H1), DM, rows, F.w_in, INC, nt * 128, DM, epi);
    }
}

__device__ __forceinline__ void hgrn_chain_simple(Frame& F, int ch) {
    const int b = ch >> 3, h = ch & 7;
    LAS float* Qs = (LAS float*)F.lds;
    LAS float* Fs = Qs + 16 * 128;
    LAS float* Vs = Fs + 16 * 128;
    LAS float* Gs = Vs + 16 * 128;
    LAS float* Po = Gs + 16 * 128;
    LAS float* Red = Po + 2 * 4 * 128;
    const int v = F.tid & 127, kg = F.tid >> 7;
    float S[32];
#pragma unroll
    for (int i = 0; i < 32; ++i) S[i] = 0.f;
    const bf16* QHG = wsp<const bf16>(F, WS_QHG); const float* LOGF = wsp<const float>(F, WS_LOGF);
    const bf16* VHG = wsp<const bf16>(F, WS_VHG); const bf16* GHG = wsp<const bf16>(F, WS_GHG);
    bf16* YHG = wsp<bf16>(F, WS_YHG);
    const float nw = F.hg_nw[h * HD + v];
    const int lt = F.tid >> 5, lc = (F.tid & 31) * 4;
    for (int t0 = 0; t0 < SEQ; t0 += 16) {
        __syncthreads();
        {
            const size_t off = (size_t)(b * SEQ + t0 + lt) * HW + h * HD + lc;
            const u32x2 q = *(const u32x2*)(QHG + off), vv = *(const u32x2*)(VHG + off), g = *(const u32x2*)(GHG + off);
            const f32x4 lf = *(const f32x4*)(LOGF + off);
            LAS float* d = Qs + lt * 128 + lc; d[0] = bf2f(q.x & 0xffffu); d[1] = bf2f(q.x >> 16); d[2] = bf2f(q.y & 0xffffu); d[3] = bf2f(q.y >> 16);
            d = Vs + lt * 128 + lc; d[0] = bf2f(vv.x & 0xffffu); d[1] = bf2f(vv.x >> 16); d[2] = bf2f(vv.y & 0xffffu); d[3] = bf2f(vv.y >> 16);
            d = Gs + lt * 128 + lc; d[0] = bf2f(g.x & 0xffffu); d[1] = bf2f(g.x >> 16); d[2] = bf2f(g.y & 0xffffu); d[3] = bf2f(g.y >> 16);
            d = Fs + lt * 128 + lc; d[0] = __expf(lf[0]); d[1] = __expf(lf[1]); d[2] = __expf(lf[2]); d[3] = __expf(lf[3]);
        }
        __syncthreads();
        for (int tt = 0; tt < 16; ++tt) {
            const int p = tt & 1;
            const float vv = Vs[tt * 128 + v];
            float part = 0.f;
#pragma unroll
            for (int i = 0; i < 32; ++i) {
                const float f = Fs[tt * 128 + kg * 32 + i], q = Qs[tt * 128 + kg * 32 + i];
                S[i] = f * S[i] + (1.0f - f) * vv;
                part += q * S[i];
            }
            Po[(p * 4 + kg) * 128 + v] = part;
            __syncthreads();
            float o = 0.f;
            if (F.tid < 128) {
                o = (Po[(p * 4 + 0) * 128 + v] + Po[(p * 4 + 1) * 128 + v]) + (Po[(p * 4 + 2) * 128 + v] + Po[(p * 4 + 3) * 128 + v]);
                const float sq = wave_sum(o * o);
                if (F.lane == 0) Red[p * 2 + F.wave] = sq;
            }
            __syncthreads();
            if (F.tid < 128) {
                const float tot = Red[p * 2] + Red[p * 2 + 1];
                const float y = o * (1.0f / sqrtf(tot * (1.0f / HD) + EPS)) * nw * Gs[tt * 128 + v];
                YHG[(size_t)(b * SEQ + t0 + tt) * DM + h * HD + v] = (bf16)f2bf(y);
            }
        }
    }
}

__device__ __forceinline__ void attn_unit_simple(Frame& F, int b, int h, int c) {
    LAS float* Q1 = (LAS float*)F.lds; LAS float* Q2 = Q1 + 64 * 65; LAS float* K1 = Q2 + 64 * 65; LAS float* K2 = K1 + 64 * 65;
    LAS float* Vt = K2 + 64 * 65; LAS float* P1 = Vt + 64 * 132; LAS float* P2 = P1 + 64 * 65;
    const bf16* QDA = wsp<const bf16>(F, WS_QDA); const bf16* KDA = wsp<const bf16>(F, WS_KDA); const bf16* VDA = wsp<const bf16>(F, WS_VDA);
    const int r = F.tid >> 3, p = F.tid & 7;
    const int lr = F.tid >> 3, lc = (F.tid & 7) * 16;
    __syncthreads();
    {
        const bf16* src = QDA + (size_t)(b * SEQ + c * 64 + lr) * HW + h * HD + lc;
        const u32x4 a0 = *(const u32x4*)src, a1 = *(const u32x4*)(src + 8);
        LAS float* d = (lc < 64 ? Q1 + lr * 65 + lc : Q2 + lr * 65 + (lc - 64));
        const unsigned w[8] = {a0.x, a0.y, a0.z, a0.w, a1.x, a1.y, a1.z, a1.w};
#pragma unroll
        for (int i = 0; i < 8; ++i) { d[2 * i] = bf2f(w[i] & 0xffffu); d[2 * i + 1] = bf2f(w[i] >> 16); }
    }
    float m1 = -INFINITY, l1 = 0.f, m2 = -INFINITY, l2 = 0.f;
    float O1[16], O2[16];
#pragma unroll
    for (int i = 0; i < 16; ++i) { O1[i] = 0.f; O2[i] = 0.f; }
    for (int kt = 0; kt <= c; ++kt) {
        __syncthreads();
        {
            const size_t ro = (size_t)(b * SEQ + kt * 64 + lr) * HW + h * HD + lc;
            const u32x4 a0 = *(const u32x4*)(KDA + ro), a1 = *(const u32x4*)(KDA + ro + 8);
            const u32x4 b0 = *(const u32x4*)(VDA + ro), b1 = *(const u32x4*)(VDA + ro + 8);
            LAS float* d = (lc < 64 ? K1 + lr * 65 + lc : K2 + lr * 65 + (lc - 64));
            const unsigned w[8] = {a0.x, a0.y, a0.z, a0.w, a1.x, a1.y, a1.z, a1.w};
#pragma unroll
            for (int i = 0; i < 8; ++i) { d[2 * i] = bf2f(w[i] & 0xffffu); d[2 * i + 1] = bf2f(w[i] >> 16); }
            LAS float* dv = Vt + lr * 132 + lc;
            const unsigned wv[8] = {b0.x, b0.y, b0.z, b0.w, b1.x, b1.y, b1.z, b1.w};
#pragma unroll
            for (int i = 0; i < 8; ++i) { dv[2 * i] = bf2f(wv[i] & 0xffffu); dv[2 * i + 1] = bf2f(wv[i] >> 16); }
        }
        __syncthreads();
        float s1[8], s2[8];
#pragma unroll
        for (int j = 0; j < 8; ++j) { s1[j] = 0.f; s2[j] = 0.f; }
        for (int d = 0; d < 64; ++d) {
            const float q1 = Q1[r * 65 + d], q2 = Q2[r * 65 + d];
#pragma unroll
            for (int j = 0; j < 8; ++j) { s1[j] += q1 * K1[(p * 8 + j) * 65 + d]; s2[j] += q2 * K2[(p * 8 + j) * 65 + d]; }
        }
        float mx1 = s1[0], mx2 = s2[0];
#pragma unroll
        for (int j = 1; j < 8; ++j) { mx1 = fmaxf(mx1, s1[j]); mx2 = fmaxf(mx2, s2[j]); }
#pragma unroll
        for (int o = 1; o < 8; o <<= 1) { mx1 = fmaxf(mx1, __shfl_xor(mx1, o)); mx2 = fmaxf(mx2, __shfl_xor(mx2, o)); }
        const float mn1 = fmaxf(m1, mx1), mn2 = fmaxf(m2, mx2);
        const float al1 = exp2f(m1 - mn1), al2 = exp2f(m2 - mn2);
        float rs1 = 0.f, rs2 = 0.f;
#pragma unroll
        for (int j = 0; j < 8; ++j) { const float e1 = exp2f(s1[j] - mn1), e2 = exp2f(s2[j] - mn2); rs1 += e1; rs2 += e2; P1[r * 65 + p * 8 + j] = e1; P2[r * 65 + p * 8 + j] = e2; }
#pragma unroll
        for (int o = 1; o < 8; o <<= 1) { rs1 += __shfl_xor(rs1, o); rs2 += __shfl_xor(rs2, o); }
        l1 = l1 * al1 + rs1; l2 = l2 * al2 + rs2; m1 = mn1; m2 = mn2;
        __syncthreads();
#pragma unroll
        for (int i = 0; i < 16; ++i) { O1[i] *= al1; O2[i] *= al2; }
        for (int k = 0; k < 64; ++k) {
            const float p1 = P1[r * 65 + k], p2 = P2[r * 65 + k];
#pragma unroll
            for (int i4 = 0; i4 < 4; ++i4) {
                const f32x4 vv = *(const LAS f32x4*)&Vt[k * 132 + p * 16 + i4 * 4];
#pragma unroll
                for (int i = 0; i < 4; ++i) { O1[i4 * 4 + i] += p1 * vv[i]; O2[i4 * 4 + i] += p2 * vv[i]; }
            }
        }
    }
    const float i1 = 1.0f / l1, i2 = 1.0f / l2;
    float o1[8], o2[8];
    bf16* Ob1 = wsp<bf16>(F, WS_O1) + (size_t)(b * SEQ + c * 64 + r) * HW + h * HD + p * 16;
    bf16* Ob2 = wsp<bf16>(F, WS_O2) + (size_t)(b * SEQ + c * 64 + r) * HW + h * HD + p * 16;
#pragma unroll
    for (int hh = 0; hh < 2; ++hh) {
#pragma unroll
        for (int i = 0; i < 8; ++i) { o1[i] = O1[hh * 8 + i] * i1; o2[i] = O2[hh * 8 + i] * i2; }
        store8_bf16(Ob1 + hh * 8, o1); store8_bf16(Ob2 + hh * 8, o2);
    }
}

__device__ __forceinline__ void hgrn_chain_fast(Frame& F, int ch);
__device__ __forceinline__ void ph_mix_simple(Frame& F) {
#if FAST_HGRN
    for (int ch = F.bid; ch < NB * NH; ch += F.G) hgrn_chain_fast(F, ch);
#else
    for (int ch = F.bid; ch < NB * NH; ch += F.G) hgrn_chain_simple(F, ch);
#endif
    for (int u = F.bid; u < NB * NH * 32; u += F.G) {
        const int c = 31 - (u >> 6), bh = u & 63;
        attn_unit_simple(F, bh >> 3, bh & 7, c);
    }
}

__device__ __forceinline__ void ph_yda(Frame& F) {
    const int gw = F.bid * NWAVES + F.wave, NGW = F.G * NWAVES;
    const float lam = *wsp<const float>(F, WS_LAM);
    const bf16* O1 = wsp<const bf16>(F, WS_O1); const bf16* O2 = wsp<const bf16>(F, WS_O2); bf16* YDA = wsp<bf16>(F, WS_YDA);
    for (int row = gw; row < T; row += NGW) {
        const size_t off = (size_t)row * HW + F.lane * 16;
        const u32x4 a0 = *(const u32x4*)(O1 + off), a1 = *(const u32x4*)(O1 + off + 8), b0 = *(const u32x4*)(O2 + off), b1 = *(const u32x4*)(O2 + off + 8);
        const unsigned wa[8] = {a0.x, a0.y, a0.z, a0.w, a1.x, a1.y, a1.z, a1.w}, wb[8] = {b0.x, b0.y, b0.z, b0.w, b1.x, b1.y, b1.z, b1.w};
        float o[16]; float s = 0.f;
#pragma unroll
        for (int i = 0; i < 8; ++i) {
            o[2 * i] = bf2f(wa[i] & 0xffffu) - lam * bf2f(wb[i] & 0xffffu); o[2 * i + 1] = bf2f(wa[i] >> 16) - lam * bf2f(wb[i] >> 16);
            s += o[2 * i] * o[2 * i] + o[2 * i + 1] * o[2 * i + 1];
        }
        s += __shfl_xor(s, 1); s += __shfl_xor(s, 2); s += __shfl_xor(s, 4);
        const float rs = (1.0f / sqrtf(s * (1.0f / HD) + EPS)) * (1.0f - LAMBDA_INIT);
        float y[8];
#pragma unroll
        for (int hh = 0; hh < 2; ++hh) {
#pragma unroll
            for (int i = 0; i < 8; ++i) y[i] = o[hh * 8 + i] * rs * F.da_nw[F.lane * 16 + hh * 8 + i];
            store8_bf16(YDA + (size_t)row * DM + F.lane * 16 + hh * 8, y);
        }
    }
}

struct EpiBr1 { const Frame* F; int m0; __device__ __forceinline__ void operator()(int r, int col0, const float (&v)[8]) const {
    const size_t off = (size_t)(m0 + r) * DM + col0; const u32x4 g = *(const u32x4*)(wsp<const bf16>(*F, WS_GATEH) + off);
    float* o = wsp<float>(*F, WS_TMP) + off; const unsigned w[4] = {g.x, g.y, g.z, g.w};
    f32x4 o0, o1;
#pragma unroll
    for (int i = 0; i < 4; ++i) { const float a = v[2 * i] * bf2f(w[i] & 0xffffu), b = v[2 * i + 1] * bf2f(w[i] >> 16); if (i < 2) { o0[2 * i] = a; o0[2 * i + 1] = b; } else { o1[2 * i - 4] = a; o1[2 * i - 3] = b; } }
    *(f32x4*)o = o0; *(f32x4*)(o + 4) = o1; } };
struct EpiBr2 { const Frame* F; int m0; __device__ __forceinline__ void operator()(int r, int col0, const float (&v)[8]) const {
    const size_t off = (size_t)(m0 + r) * DM + col0; const u32x4 g = *(const u32x4*)(wsp<const bf16>(*F, WS_GATED) + off);
    const float* t = wsp<const float>(*F, WS_TMP) + off; const f32x4 t0 = *(const f32x4*)t, t1 = *(const f32x4*)(t + 4); const unsigned w[4] = {g.x, g.y, g.z, g.w};
    float o[8];
#pragma unroll
    for (int i = 0; i < 4; ++i) { o[2 * i] = (i < 2 ? t0[2 * i] : t1[2 * i - 4]) + v[2 * i] * bf2f(w[i] & 0xffffu); o[2 * i + 1] = (i < 2 ? t0[2 * i + 1] : t1[2 * i - 3]) + v[2 * i + 1] * bf2f(w[i] >> 16); }
    store8_bf16(wsp<bf16>(*F, WS_MERGED) + off, o); } };
__device__ __forceinline__ void ph_branch_simple(Frame& F) {
    LAS float* As = (LAS float*)F.lds; LAS float* Bs = As + 16 * 132;
    const int NT_ = DM / 128, MT_ = T / 128;
    for (int t = F.bid; t < NT_ * MT_; t += F.G) {
        const int mt = t / NT_, nt = t % NT_;
        RowsDense rows{mt * 128};
        EpiBr1 e1{&F, mt * 128}; sg_tile(As, Bs, wsp<const bf16>(F, WS_YHG), DM, rows, F.w_bhg, DM, nt * 128, HW, e1);
        EpiBr2 e2{&F, mt * 128}; sg_tile(As, Bs, wsp<const bf16>(F, WS_YDA), DM, rows, F.w_bda, DM, nt * 128, HW, e2);
    }
}
struct EpiU { const Frame* F; int m0; __device__ __forceinline__ void operator()(int r, int col0, const float (&v)[8]) const { store8_bf16(wsp<bf16>(*F, WS_U) + (size_t)(m0 + r) * DM + col0, v); } };
__device__ __forceinline__ void ph_wout_simple(Frame& F) {
    LAS float* As = (LAS float*)F.lds; LAS float* Bs = As + 16 * 132;
    const int NT_ = DM / 128, MT_ = T / 128;
    for (int t = F.bid; t < NT_ * MT_; t += F.G) {
        const int mt = t / NT_, nt = t % NT_;
        RowsDense rows{mt * 128}; EpiU e{&F, mt * 128};
        sg_tile(As, Bs, wsp<const bf16>(F, WS_MERGED), DM, rows, F.w_out, DM, nt * 128, DM, e);
    }
}

__device__ __forceinline__ void ph_post(Frame& F) {
    LAS float* Lgt = (LAS float*)F.lds; LAS float* Lsh = Lgt + DM; LAS float* Lsc = Lsh + DM;
    LAS float* Lh = Lsc + DM + F.wave * DM;
    const bf16* U = wsp<const bf16>(F, WS_U); bf16* X1 = wsp<bf16>(F, WS_X1); bf16* H2 = wsp<bf16>(F, WS_H2);
    int* TOKE = wsp<int>(F, WS_TOKE); int* TOKP = wsp<int>(F, WS_TOKP); int* LT = wsp<int>(F, WS_LISTTOK); float* LW = wsp<float>(F, WS_LISTW);
    int curb = -1;
    for (int rb = F.bid; rb < T / 8; rb += F.G) {
        const int batch = rb / (SEQ / 8);
        if (batch != curb) { __syncthreads(); mod_vec(F, Lgt, 2, batch); mod_vec(F, Lsh, 3, batch); mod_vec(F, Lsc, 4, batch); __syncthreads(); curb = batch; }
        const int row = rb * 8 + F.wave;
        f32x4 u[8]; float s = 0.f;
#pragma unroll
        for (int j = 0; j < 8; ++j) {
            const u32x2 w = *(const u32x2*)(U + (size_t)row * DM + 4 * F.lane + 256 * j);
            u[j] = (f32x4){bf2f(w.x & 0xffffu), bf2f(w.x >> 16), bf2f(w.y & 0xffffu), bf2f(w.y >> 16)};
            s += (u[j][0] * u[j][0] + u[j][1] * u[j][1]) + (u[j][2] * u[j][2] + u[j][3] * u[j][3]);
        }
        const float r1 = 1.0f / sqrtf(wave_sum(s) * (1.0f / DM) + EPS);
        float s2 = 0.f;
#pragma unroll
        for (int j = 0; j < 8; ++j) {
            const int c0 = 4 * F.lane + 256 * j;
            const f32x4 xv = *(const f32x4*)(F.x + (size_t)row * DM + c0), w = *(const f32x4*)(F.post_mix + c0), g = *(const LAS f32x4*)(Lgt + c0);
            u[j] = xv + g * (u[j] * r1 * w);
            { u32x2 xo; xo.x = pk2(u[j][0], u[j][1]); xo.y = pk2(u[j][2], u[j][3]); *(u32x2*)(X1 + (size_t)row * DM + c0) = xo; }
            s2 += (u[j][0] * u[j][0] + u[j][1] * u[j][1]) + (u[j][2] * u[j][2] + u[j][3] * u[j][3]);
        }
        const float r2 = 1.0f / sqrtf(wave_sum(s2) * (1.0f / DM) + EPS);
#pragma unroll
        for (int j = 0; j < 8; ++j) {
            const int c0 = 4 * F.lane + 256 * j;
            const f32x4 w = *(const f32x4*)(F.pre_ffn + c0), sc = *(const LAS f32x4*)(Lsc + c0), sh = *(const LAS f32x4*)(Lsh + c0);
            u[j] = u[j] * r2 * w * (sc + 1.0f) + sh;
            u32x2 o; o.x = pk2(u[j][0], u[j][1]); o.y = pk2(u[j][2], u[j][3]);
            *(u32x2*)(H2 + (size_t)row * DM + c0) = o;
            *(LAS f32x4*)(Lh + c0) = u[j];
        }
        float elog, glog;
        {
            const int j = F.lane & 31, kh = F.lane >> 5;
            const float* wr = F.w_router + (size_t)(kh * 1024) * 32 + j; const LAS float* hp = Lh + kh * 1024;
            float a0 = 0.f, a1 = 0.f;
#pragma unroll 8
            for (int k = 0; k < 1024; k += 2) { a0 += hp[k] * wr[(size_t)k * 32]; a1 += hp[k + 1] * wr[(size_t)(k + 1) * 32]; }
            float a = a0 + a1; a += __shfl_xor(a, 32);
            elog = a + F.b_router[j];
            const int g = F.lane & 3, kp = F.lane >> 2;
            const float* wg = F.w_group + (size_t)(kp * 128) * 4 + g; const LAS float* hq = Lh + kp * 128;
            float c0 = 0.f;
#pragma unroll 8
            for (int k = 0; k < 128; ++k) c0 += hq[k] * wg[(size_t)k * 4];
            c0 += __shfl_xor(c0, 4); c0 += __shfl_xor(c0, 8); c0 += __shfl_xor(c0, 16); c0 += __shfl_xor(c0, 32);
            glog = c0 + F.b_group[g];
        }
        float lg[4];
#pragma unroll
        for (int i = 0; i < 4; ++i) lg[i] = __shfl(glog, i);
        int gi = 0; float gm = lg[0];
#pragma unroll
        for (int i = 1; i < 4; ++i) if (lg[i] > gm) { gm = lg[i]; gi = i; }
        float gden = 0.f;
#pragma unroll
        for (int i = 0; i < 4; ++i) gden += __expf(lg[i] - gm);
        const float gw_ = 1.0f / gden;
        float ev[8];
#pragma unroll
        for (int i = 0; i < 8; ++i) ev[i] = __shfl(elog, gi * 8 + i);
        int i0 = 0; float v0 = ev[0];
#pragma unroll
        for (int i = 1; i < 8; ++i) if (ev[i] > v0) { v0 = ev[i]; i0 = i; }
        int i1 = -1; float v1 = -INFINITY;
#pragma unroll
        for (int i = 0; i < 8; ++i) if (i != i0 && ev[i] > v1) { v1 = ev[i]; i1 = i; }
        const float e1 = __expf(v1 - v0); const float w0 = gw_ / (1.0f + e1), w1 = gw_ * e1 / (1.0f + e1);
        if (F.lane == 0) {
            const int ea = gi * 8 + i0, eb = gi * 8 + i1;
            const int pa = (int)__hip_atomic_fetch_add((unsigned*)(F.ctl + CW_CNT + 16 * ea), 1u, RLX_AGENT);
            const int pb = (int)__hip_atomic_fetch_add((unsigned*)(F.ctl + CW_CNT + 16 * eb), 1u, RLX_AGENT);
            TOKE[row * 2] = ea; TOKE[row * 2 + 1] = eb; TOKP[row * 2] = pa; TOKP[row * 2 + 1] = pb;
            LT[ea * 16384 + pa] = row; LW[ea * 16384 + pa] = w0; LT[eb * 16384 + pb] = row; LW[eb * 16384 + pb] = w1;
        }
    }
#undef POST_LOAD
}


__device__ __forceinline__ void ph_post_fast(Frame& F) {
    LAS float* Hs = (LAS float*)F.lds;
    LAS float* Ps = Hs;
    LAS float* Lg = (LAS float*)(F.lds + 131200);
    const bf16* U = wsp<const bf16>(F, WS_U); bf16* X1 = wsp<bf16>(F, WS_X1); unsigned char* H2 = wsp<unsigned char>(F, WS_H2);
    const float* MODF = wsp<const float>(F, WS_MODF);
    int* TOKE = wsp<int>(F, WS_TOKE); int* TOKP = wsp<int>(F, WS_TOKP); int* LT = wsp<int>(F, WS_LISTTOK); float* LW = wsp<float>(F, WS_LISTW);
    const int l15 = F.lane & 15, kq = F.lane >> 4;
    f32x4 xv2[2][8];
#define POST_LOAD(gg) do { _Pragma("unroll") for (int rr = 0; rr < 2; ++rr) _Pragma("unroll") for (int j = 0; j < 8; ++j) { \
        const size_t off = (size_t)((gg) * 16 + F.wave * 2 + rr) * DM + 4 * F.lane + 256 * j; xv2[rr][j] = *(const f32x4*)(F.x + off); } } while (0)
    if (F.bid < T / 16) POST_LOAD(F.bid);
    for (int g = F.bid; g < T / 16; g += F.G) {
        const int batch = (g * 16) / SEQ;
        const float* Mgt = MODF + (batch * 6 + 2) * DM; const float* Msh = MODF + (batch * 6 + 3) * DM; const float* Msc = MODF + (batch * 6 + 4) * DM;
        __syncthreads();
        {
#pragma unroll 1
            for (int rr = 0; rr < 2; ++rr) {
                int ln = F.lane; asm volatile("" : "+v"(ln));
                const int rl = F.wave * 2 + rr, row = g * 16 + rl;
                f32x4 u[8]; float sq = 0.f;
                {
                    u32x2 uw[8];
#pragma unroll
                    for (int j = 0; j < 8; ++j) uw[j] = *(const u32x2*)(U + (size_t)row * DM + 4 * ln + 256 * j);
#pragma unroll
                    for (int j = 0; j < 8; ++j) {
                        u[j] = (f32x4){bf2f(uw[j].x & 0xffffu), bf2f(uw[j].x >> 16), bf2f(uw[j].y & 0xffffu), bf2f(uw[j].y >> 16)};
                        sq += (u[j][0] * u[j][0] + u[j][1] * u[j][1]) + (u[j][2] * u[j][2] + u[j][3] * u[j][3]);
                    }
                }
                const float r1 = 1.0f / sqrtf(wave_sum(sq) * (1.0f / DM) + EPS);
                float s2 = 0.f;
                {
                    f32x4 w1[8], g1[8];
#pragma unroll
                    for (int j = 0; j < 8; ++j) { const int c0 = 4 * ln + 256 * j; w1[j] = *(const f32x4*)(F.post_mix + c0); g1[j] = *(const f32x4*)(Mgt + c0); }
#pragma unroll
                    for (int j = 0; j < 8; ++j) {
                        const int c0 = 4 * ln + 256 * j;
                        u[j] = (rr == 0 ? xv2[0][j] : xv2[1][j]) + g1[j] * (u[j] * r1 * w1[j]);
                        { u32x2 xo; xo.x = pk2(u[j][0], u[j][1]); xo.y = pk2(u[j][2], u[j][3]); *(u32x2*)(X1 + (size_t)row * DM + c0) = xo; }
                        s2 += (u[j][0] * u[j][0] + u[j][1] * u[j][1]) + (u[j][2] * u[j][2] + u[j][3] * u[j][3]);
                    }
                }
                const float r2 = 1.0f / sqrtf(wave_sum(s2) * (1.0f / DM) + EPS);
                asm volatile("" ::: "memory");
                {
                    f32x4 w2[8], sc2[8], sh2[8];
#pragma unroll
                    for (int j = 0; j < 8; ++j) { const int c0 = 4 * ln + 256 * j; w2[j] = *(const f32x4*)(F.pre_ffn + c0); sc2[j] = *(const f32x4*)(Msc + c0); sh2[j] = *(const f32x4*)(Msh + c0); }
#pragma unroll
                    for (int j = 0; j < 8; ++j) {
                        const int c0 = 4 * ln + 256 * j;
                        const f32x4 hv = u[j] * r2 * w2[j] * (sc2[j] + 1.0f) + sh2[j];
                        *(unsigned*)(H2 + (size_t)row * DM + c0) = pk4_fp8(clamp8(hv[0]), clamp8(hv[1]), clamp8(hv[2]), clamp8(hv[3]));
                        LAS float* hp = Hs + rl * 2050 + c0;
                        *(LAS f32x2_t*)hp = (f32x2_t){hv[0], hv[1]}; *(LAS f32x2_t*)(hp + 2) = (f32x2_t){hv[2], hv[3]};
                    }
                }
                asm volatile("" ::: "memory");
            }
        }
        asm volatile("" ::: "memory");
        if (g + F.G < T / 16) POST_LOAD(g + F.G);
        __syncthreads();
        f32x4 acc[3];
#pragma unroll
        for (int n = 0; n < 3; ++n) acc[n] = (f32x4){0.f, 0.f, 0.f, 0.f};
        {
            typedef short bf16x8_t __attribute__((ext_vector_type(8)));
            const LAS float* ap = Hs + l15 * 2050 + 256 * F.wave + 8 * kq;
            const __amdgpu_buffer_rsrc_t wrs = __builtin_amdgcn_make_buffer_rsrc((void*)wsp<bf16>(F, WS_WCAT), 0, 2 * 48 * DM * 2, 0x00020000);
            const int wvo = (l15 * DM + 256 * F.wave + 8 * kq) * 2;
            bf16x8_t bh[2][2][3], bl[2][2][3];
#define RT_LOADB(buf, sp) do { _Pragma("unroll") for (int s2 = 0; s2 < 2; ++s2) _Pragma("unroll") for (int n = 0; n < 3; ++n) { \
                bh[buf][s2][n] = __builtin_bit_cast(bf16x8_t, __builtin_amdgcn_raw_buffer_load_b128(wrs, wvo, n * 16 * DM * 2 + 64 * (2 * (sp) + s2), 0)); \
                bl[buf][s2][n] = __builtin_bit_cast(bf16x8_t, __builtin_amdgcn_raw_buffer_load_b128(wrs, wvo, 48 * DM * 2 + n * 16 * DM * 2 + 64 * (2 * (sp) + s2), 0)); } } while (0)
            RT_LOADB(0, 0);
#pragma unroll
            for (int sp = 0; sp < 4; ++sp) {
                if (sp + 1 < 4) { if ((sp & 1) == 0) RT_LOADB(1, sp + 1); else RT_LOADB(0, sp + 1); }
#pragma unroll
                for (int s2 = 0; s2 < 2; ++s2) {
                    const int st = 2 * sp + s2;
                    float xv[8];
#pragma unroll
                    for (int q = 0; q < 4; ++q) { const f32x2_t t2 = *(const LAS f32x2_t*)(ap + 32 * st + 2 * q); xv[2 * q] = t2[0]; xv[2 * q + 1] = t2[1]; }
                    u32x4 ah, al;
#pragma unroll
                    for (int q = 0; q < 4; ++q) {
                        const unsigned h = pk2(xv[2 * q], xv[2 * q + 1]);
                        const unsigned l = pk2(xv[2 * q] - bf2f(h & 0xffffu), xv[2 * q + 1] - bf2f(h >> 16));
                        ah[q] = h; al[q] = l;
                    }
                    const bf16x8_t ahi = __builtin_bit_cast(bf16x8_t, ah), alo = __builtin_bit_cast(bf16x8_t, al);
#pragma unroll
                    for (int n = 0; n < 3; ++n) {
                        const bf16x8_t wh = (sp & 1) ? bh[1][s2][n] : bh[0][s2][n], wl = (sp & 1) ? bl[1][s2][n] : bl[0][s2][n];
                        acc[n] = __builtin_amdgcn_mfma_f32_16x16x32_bf16(ahi, wh, acc[n], 0, 0, 0);
                        acc[n] = __builtin_amdgcn_mfma_f32_16x16x32_bf16(alo, wh, acc[n], 0, 0, 0);
                        acc[n] = __builtin_amdgcn_mfma_f32_16x16x32_bf16(ahi, wl, acc[n], 0, 0, 0);
                    }
                }
                asm volatile("" ::: "memory");
            }
#undef RT_LOADB
        }
        __syncthreads();
#pragma unroll
        for (int n = 0; n < 3; ++n)
#pragma unroll
            for (int r = 0; r < 4; ++r) Ps[(F.wave * 16 + 4 * kq + r) * 48 + 16 * n + l15] = acc[n][r];
        __syncthreads();
        for (int o = F.tid; o < 768; o += NTHREADS) {
            float sacc = 0.f;
#pragma unroll
            for (int w8 = 0; w8 < 8; ++w8) sacc += Ps[w8 * 768 + o];
            const int col = o % 48;
            Lg[o] = sacc + (col < 4 ? F.b_group[col] : (col < 36 ? F.b_router[col - 4] : 0.f));
        }
        __syncthreads();
        if (F.lane < 2) {
            const int rl = F.wave * 2 + F.lane, row = g * 16 + rl; const LAS float* lg = Lg + rl * 48;
            int gi = 0; float gm = lg[0];
#pragma unroll
            for (int i = 1; i < 4; ++i) { const float v = lg[i]; if (v > gm) { gm = v; gi = i; } }
            float gden = 0.f;
#pragma unroll
            for (int i = 0; i < 4; ++i) gden += __expf(lg[i] - gm);
            const float gw_ = 1.0f / gden;
            const LAS float* ev = lg + 4 + gi * 8;
            int i0 = 0; float v0 = ev[0];
#pragma unroll
            for (int i = 1; i < 8; ++i) { const float v = ev[i]; if (v > v0) { v0 = v; i0 = i; } }
            int i1 = -1; float v1 = -INFINITY;
#pragma unroll
            for (int i = 0; i < 8; ++i) { const float v = ev[i]; if (i != i0 && v > v1) { v1 = v; i1 = i; } }
            const float e1 = __expf(v1 - v0); const float w0 = gw_ / (1.0f + e1), w1 = gw_ * e1 / (1.0f + e1);
            const int ea = gi * 8 + i0, eb = gi * 8 + i1;
            const int pa = (int)__hip_atomic_fetch_add((unsigned*)(F.ctl + CW_CNT + 16 * ea), 1u, RLX_AGENT);
            const int pb = (int)__hip_atomic_fetch_add((unsigned*)(F.ctl + CW_CNT + 16 * eb), 1u, RLX_AGENT);
            TOKE[row * 2] = ea; TOKE[row * 2 + 1] = eb; TOKP[row * 2] = pa; TOKP[row * 2 + 1] = pb;
            LT[ea * 16384 + pa] = row; LW[ea * 16384 + pa] = w0; LT[eb * 16384 + pb] = row; LW[eb * 16384 + pb] = w1;
        }
    }
}
__device__ __forceinline__ void expert_tables(Frame& F, LAS int* tab, int tile_rows) {
    if (F.tid < NE) tab[F.tid] = (int)__hip_atomic_load((unsigned*)(F.ctl + CW_CNT + 16 * F.tid), RLX_AGENT);
    __syncthreads();
    if (F.tid == 0) {
        int ps = 0, ts = 0;
#pragma unroll 8
        for (int e = 0; e < NE; ++e) {
            const int c = tab[e];
            tab[32 + e] = ps; tab[72 + e] = ts;
            ps += (c + 255) / 256 * 256; ts += (c + tile_rows - 1) / tile_rows;
        }
        tab[32 + NE] = ps; tab[72 + NE] = ts;
    }
    __syncthreads();
}

struct EpiG { const Frame* F; int slot0, n; __device__ __forceinline__ void operator()(int r, int col0, const float (&v)[8]) const {
    if (r >= n) return; float* o = wsp<float>(*F, WS_TMPG) + (size_t)(slot0 + r) * DE + col0;
    f32x4 o0, o1;
#pragma unroll
    for (int i = 0; i < 8; ++i) { const float s = v[i] * sigmoidf_(v[i]); if (i < 4) o0[i] = s; else o1[i - 4] = s; }
    *(f32x4*)o = o0; *(f32x4*)(o + 4) = o1; } };
struct EpiUp { const Frame* F; int slot0, n; __device__ __forceinline__ void operator()(int r, int col0, const float (&v)[8]) const {
    if (r >= n) return; const float* t = wsp<const float>(*F, WS_TMPG) + (size_t)(slot0 + r) * DE + col0; const f32x4 t0 = *(const f32x4*)t, t1 = *(const f32x4*)(t + 4);
    float o[8];
#pragma unroll
    for (int i = 0; i < 8; ++i) o[i] = (i < 4 ? t0[i] : t1[i - 4]) * v[i];
    store8_bf16(wsp<bf16>(*F, WS_ACT) + (size_t)(slot0 + r) * DE + col0, o); } };
__device__ __forceinline__ void ph_moe1_simple(Frame& F) {
    LAS float* As = (LAS float*)F.lds; LAS float* Bs = As + 16 * 132; LAS int* tab = (LAS int*)(Bs + 16 * 132);
    expert_tables(F, tab, 128);
    const int NT_ = DE / 128, ntl = tab[72 + NE] * NT_;
    for (int t = F.bid; t < ntl; t += F.G) {
        const int mtg = t / NT_, nt = t % NT_;
        int e = 0;
#pragma unroll 1
        for (int q = 1; q < NE; ++q) if (tab[72 + q] <= mtg) e = q;
        const int mt = mtg - tab[72 + e], n = min(128, tab[e] - mt * 128), slot0 = tab[32 + e] + mt * 128;
        RowsList rows{wsp<const int>(F, WS_LISTTOK) + e * 16384 + mt * 128, n};
        EpiG eg{&F, slot0, n}; sg_tile(As, Bs, wsp<const bf16>(F, WS_H2), DM, rows, F.w_gate + (size_t)e * DM * DE, DE, nt * 128, DM, eg);
        EpiUp eu{&F, slot0, n}; sg_tile(As, Bs, wsp<const bf16>(F, WS_H2), DM, rows, F.w_up + (size_t)e * DM * DE, DE, nt * 128, DM, eu);
    }
}
struct EpiDown { const Frame* F; int slot0, n; const float* lw; __device__ __forceinline__ void operator()(int r, int col0, const float (&v)[8]) const {
    if (r >= n) return; const float w = lw[r]; float o[8];
#pragma unroll
    for (int i = 0; i < 8; ++i) o[i] = v[i] * w;
    store8_bf16(wsp<bf16>(*F, WS_YW) + (size_t)(slot0 + r) * DM + col0, o); } };
__device__ __forceinline__ void ph_moe2_simple(Frame& F) {
    LAS float* As = (LAS float*)F.lds; LAS float* Bs = As + 16 * 132; LAS int* tab = (LAS int*)(Bs + 16 * 132);
    expert_tables(F, tab, 128);
    const int NT_ = DM / 128, ntl = tab[72 + NE] * NT_;
    for (int t = F.bid; t < ntl; t += F.G) {
        const int mtg = t / NT_, nt = t % NT_;
        int e = 0;
#pragma unroll 1
        for (int q = 1; q < NE; ++q) if (tab[72 + q] <= mtg) e = q;
        const int mt = mtg - tab[72 + e], n = min(128, tab[e] - mt * 128), slot0 = tab[32 + e] + mt * 128;
        RowsDense rows{slot0};
        EpiDown ed{&F, slot0, n, wsp<const float>(F, WS_LISTW) + e * 16384 + mt * 128};
        sg_tile(As, Bs, wsp<const bf16>(F, WS_ACT), DE, rows, F.w_down + (size_t)e * DE * DM, DM, nt * 128, DE, ed);
    }
}

__device__ __forceinline__ void ph_final(Frame& F) {
    LAS int* tab = (LAS int*)F.lds;
    expert_tables(F, tab, 128);
    const bf16* X1 = wsp<const bf16>(F, WS_X1); const unsigned char* YW = wsp<const unsigned char>(F, WS_YW); const float* MODF = wsp<const float>(F, WS_MODF);
    const int* TOKE = wsp<const int>(F, WS_TOKE); const int* TOKP = wsp<const int>(F, WS_TOKP); const float* LW = wsp<const float>(F, WS_LISTW);
    const int gw = F.bid * NWAVES + F.wave, NGW = F.G * NWAVES;
    for (int rp = gw; rp < T / 2; rp += NGW) {
        const int row0 = rp * 2;
        int ln = F.lane; asm volatile("" : "+v"(ln));
        const float* Mgt = MODF + ((row0 / SEQ) * 6 + 5) * DM;
        int sl[2][2]; float rw[2][2];
#pragma unroll
        for (int r = 0; r < 2; ++r)
#pragma unroll
            for (int q = 0; q < 2; ++q) { const int e_ = TOKE[(row0 + r) * 2 + q], p_ = TOKP[(row0 + r) * 2 + q]; sl[r][q] = tab[32 + e_] + p_; rw[r][q] = LW[e_ * 16384 + p_] * Y8I; }
        unsigned ya[2][8], yb[2][8]; u32x2 xr[2][8];
#pragma unroll
        for (int r = 0; r < 2; ++r)
#pragma unroll
            for (int j = 0; j < 8; ++j) { const int c0 = 4 * ln + 256 * j; ya[r][j] = *(const unsigned*)(YW + (size_t)sl[r][0] * DM + c0); yb[r][j] = *(const unsigned*)(YW + (size_t)sl[r][1] * DM + c0);
                xr[r][j] = *(const u32x2*)(X1 + (size_t)(row0 + r) * DM + c0); }
        f32x4 wv[8], gv[8];
#pragma unroll
        for (int j = 0; j < 8; ++j) { const int c0 = 4 * ln + 256 * j; wv[j] = *(const f32x4*)(F.post_ffn + c0); gv[j] = *(const f32x4*)(Mgt + c0); }
#pragma unroll
        for (int r = 0; r < 2; ++r) {
            f32x4 y[8]; float s = 0.f;
#pragma unroll
            for (int j = 0; j < 8; ++j) {
                const f32x2_t a0 = __builtin_amdgcn_cvt_pk_f32_fp8((int)ya[r][j], false), a1 = __builtin_amdgcn_cvt_pk_f32_fp8((int)ya[r][j], true);
                const f32x2_t b0 = __builtin_amdgcn_cvt_pk_f32_fp8((int)yb[r][j], false), b1 = __builtin_amdgcn_cvt_pk_f32_fp8((int)yb[r][j], true);
                y[j] = (f32x4){a0[0] * rw[r][0] + b0[0] * rw[r][1], a0[1] * rw[r][0] + b0[1] * rw[r][1], a1[0] * rw[r][0] + b1[0] * rw[r][1], a1[1] * rw[r][0] + b1[1] * rw[r][1]};
                s += (y[j][0] * y[j][0] + y[j][1] * y[j][1]) + (y[j][2] * y[j][2] + y[j][3] * y[j][3]);
            }
            const float rn = 1.0f / sqrtf(wave_sum(s) * (1.0f / DM) + EPS);
#pragma unroll
            for (int j = 0; j < 8; ++j) {
                const int c0 = 4 * ln + 256 * j;
                const f32x4 xv = (f32x4){bf2f(xr[r][j].x & 0xffffu), bf2f(xr[r][j].x >> 16), bf2f(xr[r][j].y & 0xffffu), bf2f(xr[r][j].y >> 16)};
                *(f32x4*)(F.out + (size_t)(row0 + r) * DM + c0) = xv + gv[j] * (y[j] * rn * wv[j]);
            }
        }
    }
}


#define T_LOAD32(tv, RS, N, k0, n0) do { const int vo_ = ((8 * (lane >> 3)) * (N) + (n0) + 4 * (lane & 7)) * 4; \
        _Pragma("unroll") for (int i = 0; i < 8; ++i) tv[i] = __builtin_bit_cast(f32x4, __builtin_amdgcn_raw_buffer_load_b128(RS, vo_, ((k0) + i) * (N) * 4, 2)); } while (0)
#define T_STORE32F8(tv, WT, K, k0, drow) do { _Pragma("unroll") for (int j = 0; j < 4; ++j) { \
        u32x2 o_; o_.x = pk4_fp8(tv[0][j] * W8S, tv[1][j] * W8S, tv[2][j] * W8S, tv[3][j] * W8S); o_.y = pk4_fp8(tv[4][j] * W8S, tv[5][j] * W8S, tv[6][j] * W8S, tv[7][j] * W8S); \
        *(u32x2*)((WT) + (size_t)((drow) + 4 * (lane & 7) + j) * (K) + (k0) + 8 * (lane >> 3)) = o_; } } while (0)
#define T_STORE32(tv, WT, K, k0, drow) do { _Pragma("unroll") for (int j = 0; j < 4; ++j) { \
        u32x4 o_; o_.x = pk2(tv[0][j], tv[1][j]); o_.y = pk2(tv[2][j], tv[3][j]); o_.z = pk2(tv[4][j], tv[5][j]); o_.w = pk2(tv[6][j], tv[7][j]); \
        *(u32x4*)((WT) + (size_t)((drow) + 4 * (lane & 7) + j) * (K) + (k0) + 8 * (lane >> 3)) = o_; } } while (0)
namespace hg {
typedef short bf16x8 __attribute__((ext_vector_type(8)));
typedef short bf16x4 __attribute__((ext_vector_type(4)));
constexpr int QE_OFF = 0, KE_OFF = 17408, KDT_OFF = 34816, VT_OFF = 53248, AM_OFF = 71680, OB_OFF = 80896, SEG_OFF = 114688, DV_OFF = 118784;
constexpr int QROW = 272, TROW = 144, OROW = 528;
__device__ __forceinline__ bf16x8 cat8(bf16x4 a, bf16x4 b) { return (bf16x8){a[0], a[1], a[2], a[3], b[0], b[1], b[2], b[3]}; }
}
__device__ __forceinline__ void hgrn_chain_fast(Frame& F, int ch) {
    using namespace hg;
    const int b = ch >> 3, h = ch & 7;
    const int lane = F.lane, w = F.wave, tid = F.tid;
    LAS unsigned char* L = F.lds;
    const int l15 = lane & 15, kq = lane >> 4;
    const float* LOGF = wsp<const float>(F, WS_LOGF); const bf16* QHG = wsp<const bf16>(F, WS_QHG); const bf16* VHG = wsp<const bf16>(F, WS_VHG); const bf16* GHG = wsp<const bf16>(F, WS_GHG);
    bf16* YHG = wsp<bf16>(F, WS_YHG);
    const size_t rowbase = (size_t)(b * SEQ) * HW + h * HD;
    f32x4 S[8];
#pragma unroll
    for (int i = 0; i < 8; ++i) S[i] = (f32x4){0.f, 0.f, 0.f, 0.f};
    float lf[8][2]; unsigned qv[8], vv[8]; u32x4 gq[2];
    const int nt_ = tid >> 3, nvg = tid & 7;
#define HG_LOAD(c) do { _Pragma("unroll") for (int i = 0; i < 8; ++i) { const size_t off = rowbase + (size_t)((c) * 64 + 8 * w + i) * HW + 2 * lane; \
        const u32x2 t2 = *(const u32x2*)(LOGF + off); lf[i][0] = __uint_as_float(t2.x); lf[i][1] = __uint_as_float(t2.y); qv[i] = *(const unsigned*)(QHG + off); vv[i] = *(const unsigned*)(VHG + off); } \
        { const bf16* gp = GHG + rowbase + (size_t)((c) * 64 + nt_) * HW + 16 * nvg; gq[0] = *(const u32x4*)gp; gq[1] = *(const u32x4*)(gp + 8); } } while (0)
    f32x4 nwv[4];
#pragma unroll
    for (int i = 0; i < 4; ++i) nwv[i] = *(const f32x4*)(F.hg_nw + h * HD + 16 * nvg + 4 * i);
    HG_LOAD(0);
    __syncthreads();
    for (int c = 0; c < SEQ / 64; ++c) {
        float sum0 = lf[0][0], sum1 = lf[0][1];
#pragma unroll
        for (int i = 1; i < 8; ++i) { sum0 += lf[i][0]; sum1 += lf[i][1]; }
        *(LAS f32x2_t*)(L + SEG_OFF + (w * 128 + 2 * lane) * 4) = (f32x2_t){sum0, sum1};
        __syncthreads();
        float base0 = 0.f, base1 = 0.f, tot0 = 0.f, tot1 = 0.f;
#pragma unroll
        for (int s_ = 0; s_ < 8; ++s_) { const f32x2_t sv = *(const LAS f32x2_t*)(L + SEG_OFF + (s_ * 128 + 2 * lane) * 4); tot0 += sv[0]; tot1 += sv[1]; if (s_ < w) { base0 += sv[0]; base1 += sv[1]; } }
        const float eb0 = __expf(tot0), eb1 = __expf(tot1);
        float E0 = __expf(base0), E1 = __expf(base1);
        unsigned kd0[4], kd1[4], vt0[4], vt1[4];
#pragma unroll
        for (int i = 0; i < 8; ++i) {
            const float f0 = __expf(lf[i][0]), f1 = __expf(lf[i][1]);
            E0 *= f0; E1 *= f1;
            const float q0 = bf2f(qv[i] & 0xffffu), q1 = bf2f(qv[i] >> 16);
            const float qe0 = q0 * E0, qe1 = q1 * E1;
            const float ke0 = (1.0f - f0) * __builtin_amdgcn_rcpf(E0), ke1 = (1.0f - f1) * __builtin_amdgcn_rcpf(E1);
            const float d0 = ke0 * eb0, d1 = ke1 * eb1;
            *(LAS unsigned*)(L + QE_OFF + (8 * w + i) * QROW + 4 * lane) = pk2(qe0, qe1);
            *(LAS unsigned*)(L + KE_OFF + (8 * w + i) * QROW + 4 * lane) = pk2(ke0, ke1);
            const unsigned dd0 = f2bf(d0), dd1 = f2bf(d1);
            if (i & 1) { kd0[i >> 1] |= dd0 << 16; kd1[i >> 1] |= dd1 << 16; vt0[i >> 1] |= (vv[i] & 0xffffu) << 16; vt1[i >> 1] |= (vv[i] >> 16) << 16; }
            else { kd0[i >> 1] = dd0; kd1[i >> 1] = dd1; vt0[i >> 1] = vv[i] & 0xffffu; vt1[i >> 1] = vv[i] >> 16; }
        }
        *(LAS u32x4*)(L + KDT_OFF + (2 * lane) * TROW + 16 * w) = (u32x4){kd0[0], kd0[1], kd0[2], kd0[3]};
        *(LAS u32x4*)(L + KDT_OFF + (2 * lane + 1) * TROW + 16 * w) = (u32x4){kd1[0], kd1[1], kd1[2], kd1[3]};
        *(LAS u32x4*)(L + VT_OFF + (2 * lane) * TROW + 16 * w) = (u32x4){vt0[0], vt0[1], vt0[2], vt0[3]};
        *(LAS u32x4*)(L + VT_OFF + (2 * lane + 1) * TROW + 16 * w) = (u32x4){vt1[0], vt1[1], vt1[2], vt1[3]};
        if (w == 0) *(LAS f32x2_t*)(L + DV_OFF + 8 * lane) = (f32x2_t){eb0, eb1};
        u32x4 gcur[2] = {gq[0], gq[1]};
        if (c + 1 < SEQ / 64) HG_LOAD(c + 1);
        f32x4 twa[8], twb[8];
        const bool tjob = ((w + c) & 1) == 0;
        const int tid_ = (ch * (SEQ / 64) + c) * 4 + (w >> 1), te = tid_ >> 8, tkp = 4 + ((tid_ & 255) >> 6), tnb = tid_ & 63;
        const __amdgpu_buffer_rsrc_t trs = __builtin_amdgcn_make_buffer_rsrc((void*)(F.w_down + (size_t)te * DE * DM), 0, DM * DE * 4, 0x00020000);
        if (tjob) { const int vo_ = ((16 * (lane >> 3)) * DM + tnb * 32 + 4 * (lane & 7)) * 4;
#pragma unroll
            for (int i = 0; i < 8; ++i) twa[i] = __builtin_bit_cast(f32x4, __builtin_amdgcn_raw_buffer_load_b128(trs, vo_, (tkp * 128 + i) * DM * 4, 2));
#pragma unroll
            for (int i = 0; i < 8; ++i) twb[i] = __builtin_bit_cast(f32x4, __builtin_amdgcn_raw_buffer_load_b128(trs, vo_, (tkp * 128 + 8 + i) * DM * 4, 2)); }
        __syncthreads();
        {
            const int ti = w >> 1;
#pragma unroll
            for (int sj = 0; sj < 2; ++sj) {
                const int si = 2 * (w & 1) + sj;
                f32x4 a = (f32x4){0.f, 0.f, 0.f, 0.f};
                if (si <= ti) {
#pragma unroll
                    for (int j = 0; j < 4; ++j) {
                        const bf16x8 ka = *(const LAS bf16x8*)(L + KE_OFF + (16 * si + l15) * QROW + (32 * j + 8 * kq) * 2);
                        const bf16x8 qb = *(const LAS bf16x8*)(L + QE_OFF + (16 * ti + l15) * QROW + (32 * j + 8 * kq) * 2);
                        a = __builtin_amdgcn_mfma_f32_16x16x32_bf16(ka, qb, a, 0, 0, 0);
                    }
                    const int t = 16 * ti + l15, s0 = 16 * si + 4 * kq;
#pragma unroll
                    for (int r = 0; r < 4; ++r) if (s0 + r > t) a[r] = 0.f;
                }
                *(LAS u32x2*)(L + AM_OFF + (16 * ti + l15) * TROW + (16 * si + 4 * kq) * 2) = (u32x2){pk2(a[0], a[1]), pk2(a[2], a[3])};
            }
        }
        __syncthreads();
        {
            bf16x8 vf[2];
#pragma unroll
            for (int j = 0; j < 2; ++j) vf[j] = *(const LAS bf16x8*)(L + VT_OFF + (16 * w + l15) * TROW + (32 * j + 8 * kq) * 2);
            bf16x8 sb[4];
#pragma unroll
            for (int j = 0; j < 4; ++j) { const u32x4 t4 = (u32x4){pk2(S[2 * j][0], S[2 * j][1]), pk2(S[2 * j][2], S[2 * j][3]), pk2(S[2 * j + 1][0], S[2 * j + 1][1]), pk2(S[2 * j + 1][2], S[2 * j + 1][3])}; sb[j] = __builtin_bit_cast(bf16x8, t4); }
#pragma unroll
            for (int ti = 0; ti < 4; ++ti) {
                f32x4 o = (f32x4){0.f, 0.f, 0.f, 0.f};
#pragma unroll
                for (int j = 0; j < 2; ++j) { const bf16x8 am = *(const LAS bf16x8*)(L + AM_OFF + (16 * ti + l15) * TROW + (32 * j + 8 * kq) * 2); o = __builtin_amdgcn_mfma_f32_16x16x32_bf16(am, vf[j], o, 0, 0, 0); }
#pragma unroll
                for (int j = 0; j < 4; ++j) {
                    const bf16x4 lo = *(const LAS bf16x4*)(L + QE_OFF + (16 * ti + l15) * QROW + (32 * j + 4 * kq) * 2);
                    const bf16x4 hi = *(const LAS bf16x4*)(L + QE_OFF + (16 * ti + l15) * QROW + (32 * j + 16 + 4 * kq) * 2);
                    o = __builtin_amdgcn_mfma_f32_16x16x32_bf16(cat8(lo, hi), sb[j], o, 0, 0, 0);
                }
#pragma unroll
                for (int r = 0; r < 4; ++r) *(LAS float*)(L + OB_OFF + (16 * ti + 4 * kq + r) * OROW + (16 * w + l15) * 4) = o[r];
            }
#pragma unroll
            for (int kt = 0; kt < 8; ++kt) {
                const f32x4 dv = *(const LAS f32x4*)(L + DV_OFF + (16 * kt + 4 * kq) * 4);
                f32x4 cacc = S[kt] * dv;
#pragma unroll
                for (int j = 0; j < 2; ++j) { const bf16x8 kd = *(const LAS bf16x8*)(L + KDT_OFF + (16 * kt + l15) * TROW + (32 * j + 8 * kq) * 2); cacc = __builtin_amdgcn_mfma_f32_16x16x32_bf16(kd, vf[j], cacc, 0, 0, 0); }
                S[kt] = cacc;
            }
        }
        __syncthreads();
        {
            f32x4 o4[4]; float ss = 0.f;
#pragma unroll
            for (int i = 0; i < 4; ++i) { o4[i] = *(const LAS f32x4*)(L + OB_OFF + nt_ * OROW + (16 * nvg + 4 * i) * 4); ss += (o4[i][0] * o4[i][0] + o4[i][1] * o4[i][1]) + (o4[i][2] * o4[i][2] + o4[i][3] * o4[i][3]); }
            ss += __shfl_xor(ss, 1); ss += __shfl_xor(ss, 2); ss += __shfl_xor(ss, 4);
            const float rstd = 1.0f / sqrtf(ss * (1.0f / HD) + EPS);
            float y[8];
            bf16* yp = YHG + (size_t)(b * SEQ + c * 64 + nt_) * DM + h * HD + 16 * nvg;
#pragma unroll
            for (int hh = 0; hh < 2; ++hh) {
                const f32x4 n0 = nwv[2 * hh], n1 = nwv[2 * hh + 1];
                const u32x4 g = gcur[hh];
                y[0] = o4[2 * hh][0] * rstd * n0[0] * bf2f(g.x & 0xffffu); y[1] = o4[2 * hh][1] * rstd * n0[1] * bf2f(g.x >> 16);
                y[2] = o4[2 * hh][2] * rstd * n0[2] * bf2f(g.y & 0xffffu); y[3] = o4[2 * hh][3] * rstd * n0[3] * bf2f(g.y >> 16);
                y[4] = o4[2 * hh + 1][0] * rstd * n1[0] * bf2f(g.z & 0xffffu); y[5] = o4[2 * hh + 1][1] * rstd * n1[1] * bf2f(g.z >> 16);
                y[6] = o4[2 * hh + 1][2] * rstd * n1[2] * bf2f(g.w & 0xffffu); y[7] = o4[2 * hh + 1][3] * rstd * n1[3] * bf2f(g.w >> 16);
                store8_bf16(yp + hh * 8, y);
            }
        }
        if (tjob) { unsigned char* wt_ = wsp<unsigned char>(F, WS_WD_T) + (size_t)te * DM * DE;
#pragma unroll
            for (int j = 0; j < 4; ++j) { u32x4 o_;
                o_.x = pk4_fp8(twa[0][j] * W8S, twa[1][j] * W8S, twa[2][j] * W8S, twa[3][j] * W8S); o_.y = pk4_fp8(twa[4][j] * W8S, twa[5][j] * W8S, twa[6][j] * W8S, twa[7][j] * W8S);
                o_.z = pk4_fp8(twb[0][j] * W8S, twb[1][j] * W8S, twb[2][j] * W8S, twb[3][j] * W8S); o_.w = pk4_fp8(twb[4][j] * W8S, twb[5][j] * W8S, twb[6][j] * W8S, twb[7][j] * W8S);
                *(u32x4*)(wt_ + (size_t)(tnb * 32 + 4 * (lane & 7) + j) * DE + tkp * 128 + 16 * (lane >> 3)) = o_; } }
    }
#undef HG_LOAD
    __syncthreads();
}


#include <hip/hip_bf16.h>
#include <cmath>
namespace attn_body {
using bf16=__hip_bfloat16;
using bf16x8=__attribute__((ext_vector_type(8)))short;
using s16x4=__attribute__((ext_vector_type(4)))short;
using f32x16=__attribute__((ext_vector_type(16)))float;
using u32x4=__attribute__((ext_vector_type(4)))unsigned;
constexpr int SEQ=2048,D=64,DM=1024;
constexpr int NW=8,QBLK=32,QB=QBLK*NW,KVBLK=64,NQB=SEQ/QB;
constexpr int ATTN_PITCH=DM, ATTN_UNIT_ROWS=QB;
__device__ __forceinline__ int crow(int r,int hi){return (r&3)+8*(r>>2)+4*hi;}
#define SBAR() __builtin_amdgcn_sched_barrier(0)
__device__ __forceinline__ void cmask(f32x16&p0,f32x16&p1,int jb,int qrel,int hi){
  const float NEG=-INFINITY;
  if(64*jb>(qrel|63)){
  #pragma unroll
  for(int r=0;r<16;++r){p0[r]=NEG;p1[r]=NEG;} }
}

constexpr int NSLOT=3, SLOTB=8192;
constexpr int LDS_K=0, LDS_V=NSLOT*SLOTB, LDS_WS=2*NSLOT*SLOTB, LDS_OST=LDS_WS+NW*64*4, LDS_BYTES=LDS_OST+NW*4096;
constexpr float C2=0.125f*1.4426950408889634f;
__device__ __forceinline__ void glds16(const void*gsrc,unsigned lds_dst){unsigned keep;
  asm volatile("s_mov_b32 %0, m0\n\ts_mov_b32 m0, %2\n\ts_nop 0\n\tglobal_load_lds_dwordx4 %1, off\n\ts_mov_b32 m0, %0":"=&s"(keep):"v"(gsrc),"s"(lds_dst):"memory");}
__device__ __forceinline__ float max3f(float a,float b,float c){float r;asm("v_max3_f32 %0, %1, %2, %3":"=v"(r):"v"(a),"v"(b),"v"(c));return r;}
__device__ __forceinline__ float max2f(float a,float b){float r;asm("v_max_f32_e32 %0, %1, %2":"=v"(r):"v"(a),"v"(b));return r;}
__device__ __forceinline__ float fadd_s(float a,float b){float r;asm("v_add_f32_e32 %0, %1, %2":"=v"(r):"v"(a),"v"(b));return r;}
__device__ __forceinline__ float fsub_s(float a,float b){float r;asm("v_sub_f32_e32 %0, %1, %2":"=v"(r):"v"(a),"v"(b));return r;}
typedef float f32x2_t __attribute__((ext_vector_type(2))); typedef __bf16 bf16x2_t __attribute__((ext_vector_type(2)));
__device__ __forceinline__ unsigned cvtpk_s(float lo,float hi){f32x2_t v={lo,hi};bf16x2_t b=__builtin_convertvector(v,bf16x2_t);return __builtin_bit_cast(unsigned,b);}
#define WAIT_BAR(N) asm volatile("s_waitcnt vmcnt(" #N ") lgkmcnt(0)\n\ts_barrier":::"memory")

__device__ __forceinline__ void qkt(f32x16&p0,f32x16&p1,const char*Kslot,const bf16x8*qr,const f32x16&negm,int r32,int hi){
  const char*kb=Kslot+hi*1024+r32*16;
  #pragma unroll
  for(int d0=0;d0<4;++d0){
    const bf16x8 b0=*reinterpret_cast<const bf16x8*>(kb+d0*2048);
    const bf16x8 b1=*reinterpret_cast<const bf16x8*>(kb+d0*2048+512);
    if(d0==0){p0=__builtin_amdgcn_mfma_f32_32x32x16_bf16(b0,qr[0],negm,0,0,0);p1=__builtin_amdgcn_mfma_f32_32x32x16_bf16(b1,qr[0],negm,0,0,0);}
    else{p0=__builtin_amdgcn_mfma_f32_32x32x16_bf16(b0,qr[d0],p0,0,0,0);p1=__builtin_amdgcn_mfma_f32_32x32x16_bf16(b1,qr[d0],p1,0,0,0);}}
}
typedef __attribute__((address_space(3))) const char* lds_cptr;
typedef short v4i16_t __attribute__((ext_vector_type(4)));
__device__ __forceinline__ void kload8(bf16x8*kf,lds_cptr kp){
  kf[0]=*(const __attribute__((address_space(3))) bf16x8*)(kp);      kf[1]=*(const __attribute__((address_space(3))) bf16x8*)(kp+512);
  kf[2]=*(const __attribute__((address_space(3))) bf16x8*)(kp+2048); kf[3]=*(const __attribute__((address_space(3))) bf16x8*)(kp+2560);
  kf[4]=*(const __attribute__((address_space(3))) bf16x8*)(kp+4096); kf[5]=*(const __attribute__((address_space(3))) bf16x8*)(kp+4608);
  kf[6]=*(const __attribute__((address_space(3))) bf16x8*)(kp+6144); kf[7]=*(const __attribute__((address_space(3))) bf16x8*)(kp+6656);
}
__device__ __forceinline__ void kload2(bf16x8*kf,lds_cptr kp,int j){ kf[2*j]=*(const __attribute__((address_space(3))) bf16x8*)(kp+j*2048); kf[2*j+1]=*(const __attribute__((address_space(3))) bf16x8*)(kp+j*2048+512); }
__device__ __forceinline__ s16x4 vtr(lds_cptr p){ return __builtin_bit_cast(s16x4,__builtin_amdgcn_ds_read_tr16_b64_v4i16((__attribute__((address_space(3))) v4i16_t*)p)); }
__device__ __forceinline__ float rowmax(const f32x16&p0,const f32x16&p1){
  float a=max3f(p0[0],p0[1],p1[0]),b=max3f(p0[2],p0[3],p1[1]);a=max3f(a,p1[2],p1[3]);
  #pragma unroll
  for(int r=4;r<16;r+=4){a=max3f(a,p0[r],p0[r+1]);b=max3f(b,p0[r+2],p0[r+3]);a=max3f(a,p1[r],p1[r+1]);b=max3f(b,p1[r+2],p1[r+3]);}
  const float m=max2f(a,b);
  auto rr=__builtin_amdgcn_permlane32_swap(__float_as_uint(m),__float_as_uint(m),false,false);
  return max2f(__uint_as_float(rr[0]),__uint_as_float(rr[1]));
}
__device__ __forceinline__ void pv(f32x16*o,int vb,bf16x8 pa0,bf16x8 pa1,bf16x8 pa2,bf16x8 pa3){
  #pragma unroll
  for(int d0=0;d0<2;++d0){s16x4 lo[4],hi[4];
    #pragma unroll
    for(int ks=0;ks<4;++ks){
      asm volatile("ds_read_b64_tr_b16 %0,%1 offset:%c2":"=&v"(lo[ks]):"v"(vb),"i"(d0*4096+ks*1024):"memory");
      asm volatile("ds_read_b64_tr_b16 %0,%1 offset:%c2":"=&v"(hi[ks]):"v"(vb),"i"(d0*4096+ks*1024+512):"memory");}
    asm volatile("s_waitcnt lgkmcnt(0)":::"memory");SBAR();
    #define PK(k) (bf16x8){lo[k][0],lo[k][1],lo[k][2],lo[k][3],hi[k][0],hi[k][1],hi[k][2],hi[k][3]}
    o[d0]=__builtin_amdgcn_mfma_f32_32x32x16_bf16(pa0,PK(0),o[d0],0,0,0);
    o[d0]=__builtin_amdgcn_mfma_f32_32x32x16_bf16(pa1,PK(1),o[d0],0,0,0);
    o[d0]=__builtin_amdgcn_mfma_f32_32x32x16_bf16(pa2,PK(2),o[d0],0,0,0);
    o[d0]=__builtin_amdgcn_mfma_f32_32x32x16_bf16(pa3,PK(3),o[d0],0,0,0);
    #undef PK
  }
}

#ifndef ATTN_STORE16
#define ATTN_STORE16(p,v) (*(u32x4*)(p)=(v))
#endif
template<int THRL> __device__ __forceinline__ void attn_unit(int b,int h,int hv,int qb,const bf16*Q,const bf16*__restrict__ K,const bf16*__restrict__ V,bf16*O,char*shm){
  const int tid=threadIdx.x,lane=tid&63,r32=lane&31,hi=lane>>5; const int wid=__builtin_amdgcn_readfirstlane(tid>>6);
  const long rowbase=(long)b*SEQ; const int q0=qb*QB;
  const bf16*Qw=Q+(rowbase+q0+wid*QBLK)*DM+h*D;
  const bf16*Kh=K+rowbase*DM+h*D,*Vh=V+rowbase*DM+hv*D;
  const unsigned lds0=(unsigned)(uintptr_t)shm;
  float*wsf=(float*)(shm+LDS_WS)+wid*64;
  const bf16*ksrc=Kh+(long)lane*DM+wid*8;
  const bf16*vsrc=Vh+(long)(16*(wid&3)+(lane>>2))*DM+(wid>>2)*32+(lane&3)*8;
  const unsigned kdst=lds0+LDS_K+wid*1024, vdst=lds0+LDS_V+wid*1024;
  #define DMA_K(t,slot) glds16(ksrc+(long)(t)*KVBLK*DM,(unsigned)__builtin_amdgcn_readfirstlane(kdst+(slot)))
  #define DMA_V(t,slot) glds16(vsrc+(long)(t)*KVBLK*DM,(unsigned)__builtin_amdgcn_readfirstlane(vdst+(slot)))
  const int vb0=(int)(lds0+LDS_V)+((lane>>4)&1)*32+(lane&3)*8+(4*hi+((lane&15)>>2))*64;
  const char*Kbase=shm+LDS_K; bf16x8 kf[8];
  const lds_cptr shm3=(lds_cptr)shm; const lds_cptr kp0=shm3+LDS_K+hi*1024+r32*16; const lds_cptr vp0=shm3+LDS_V+((lane>>4)&1)*32+(lane&3)*8+(4*hi+((lane&15)>>2))*64;
  const int NT=(q0+QB)/KVBLK;
  DMA_K(0,0);DMA_V(0,0);DMA_K(1,SLOTB);
  bf16x8 qr[4];
  #pragma unroll
  for(int d0=0;d0<4;++d0)qr[d0]=*reinterpret_cast<const bf16x8*>(&Qw[(long)r32*DM+d0*16+hi*8]);
  float mhat=0.f,l_reg=0.f;f32x16 o[2];o[0]=f32x16{};o[1]=f32x16{};f32x16 negm=f32x16{};asm volatile("":"+v"(negm));
  const int qrel=wid*QBLK+r32;
  #define CMASK(P0,P1,t) do{int jb_=(t)-(NT-4); if(jb_>=0)cmask(P0,P1,jb_,qrel,hi);}while(0)
  bool resc=false;
  #define START(P0,P1) do{ const float rm=rowmax(P0,P1); resc=false; \
    { const float dl=rm; mhat=fadd_s(mhat,dl); \
      _Pragma("unroll") for(int r=0;r<16;++r){P0[r]=fsub_s(P0[r],dl);P1[r]=fsub_s(P1[r],dl);} \
      _Pragma("unroll") for(int r=0;r<16;++r)negm[r]=-mhat; asm volatile("":"+v"(negm)); } \
    _Pragma("unroll") for(int r=0;r<16;++r)P0[r]=__builtin_amdgcn_exp2f(P0[r]); }while(0)
  #define RESC() do{ if(resc){ asm volatile("s_waitcnt lgkmcnt(0)":::"memory"); \
      _Pragma("unroll") for(int d_=0;d_<2;++d_) _Pragma("unroll") for(int r=0;r<16;++r)o[d_][r]*=wsf[crow(r,hi)]; } }while(0)
  f32x16 pA0,pA1,pB0,pB1;
  int sl_prev=0,sl_cur=0,sl_next=SLOTB;
  #define ROT() do{sl_prev=sl_cur;sl_cur=sl_next;sl_next=(sl_next==(NSLOT-1)*SLOTB)?0:sl_next+SLOTB;}while(0)
  DMA_K(2,2*SLOTB);
  WAIT_BAR(3);
  qkt(pA0,pA1,Kbase,qr,negm,r32,hi);asm volatile("s_nop 15\n\ts_nop 7":"+v"(pA0),"+v"(pA1));CMASK(pA0,pA1,0);
  START(pA0,pA1);
  _Pragma("unroll") for(int r=0;r<16;++r)pA1[r]=__builtin_amdgcn_exp2f(pA1[r]);
  WAIT_BAR(0);
  DMA_K(3,0);DMA_V(1,SLOTB);
  ROT();
  kload8(kf,kp0+sl_cur);
  WAIT_BAR(2);
  s16x4 vlo[8],vhi[8]; u32x4 pw0,pw1,pw2,pw3;
  #define PKW(P,B) cvtpk_s(P[B],P[B+1])
  #define PAF(k) __builtin_bit_cast(bf16x8,pw##k)
  #define VFR(i) (bf16x8){vlo[i][0],vlo[i][1],vlo[i][2],vlo[i][3],vhi[i][0],vhi[i][1],vhi[i][2],vhi[i][3]}
  #define PIN(x) asm volatile("":"+v"(x))
  #define MX3(a,b,c) __builtin_fmaxf(__builtin_fmaxf((a),(b)),(c))
  #define GAPA(MF,A0,A1,A2,A3,W0,W1,PW) do{ MF; sacc+=A0; sacc+=A1; sacc+=A2; sacc+=A3; PIN(sacc); W0; W1; PIN(PW); SBAR(); }while(0)
  #define EX(v) __builtin_amdgcn_exp2f(v)
  #define GAPB(MF,X,B) do{ MF; X[B]=EX(X[B]); X[B+1]=EX(X[B+1]); X[B+2]=EX(X[B+2]); X[B+3]=EX(X[B+3]); PIN(X); SBAR(); }while(0)
  #define VRD(i) do{ vlo[i]=vtr(vp_+(((i)>>2)*4096+((i)&3)*1024)); vhi[i]=vtr(vp_+(((i)>>2)*4096+((i)&3)*1024+512)); }while(0)
  #define KRD(G,j) do{ if(G){ kload2(kf,kp0+sl_next,j); SBAR(); } }while(0)
  #define STEP(C0,C1,P0,P1,t,GK,GV,GL) do{ SBAR(); \
    const lds_cptr vp_=vp0+sl_prev; \
    VRD(0); SBAR(); float sacc=(P0[0]+P0[1]); \
    GAPA(C0=__builtin_amdgcn_mfma_f32_32x32x16_bf16(kf[0],qr[0],negm,0,0,0), P0[2],P0[3],P0[4],P0[5],     pw0[0]=PKW(P0,0), pw0[1]=PKW(P0,2), pw0); \
    VRD(4); SBAR(); GAPA(C1=__builtin_amdgcn_mfma_f32_32x32x16_bf16(kf[1],qr[0],negm,0,0,0), P0[6],P0[7],P0[8],P0[9],     pw0[2]=PKW(P0,4), pw0[3]=PKW(P0,6), pw0); \
    VRD(1); SBAR(); GAPA(C0=__builtin_amdgcn_mfma_f32_32x32x16_bf16(kf[2],qr[1],C0,0,0,0),   P0[10],P0[11],P0[12],P0[13], pw1[0]=PKW(P0,8), pw1[1]=PKW(P0,10), pw1); \
    VRD(5); SBAR(); GAPA(C1=__builtin_amdgcn_mfma_f32_32x32x16_bf16(kf[3],qr[1],C1,0,0,0),   P0[14],P0[15],P1[0],P1[1],   pw1[2]=PKW(P0,12),pw1[3]=PKW(P0,14), pw1); \
    VRD(2); SBAR(); GAPA(C0=__builtin_amdgcn_mfma_f32_32x32x16_bf16(kf[4],qr[2],C0,0,0,0),   P1[2],P1[3],P1[4],P1[5],     pw2[0]=PKW(P1,0), pw2[1]=PKW(P1,2), pw2); \
    VRD(6); SBAR(); GAPA(C1=__builtin_amdgcn_mfma_f32_32x32x16_bf16(kf[5],qr[2],C1,0,0,0),   P1[6],P1[7],P1[8],P1[9],     pw2[2]=PKW(P1,4), pw2[3]=PKW(P1,6), pw2); \
    VRD(3); SBAR(); GAPA(C0=__builtin_amdgcn_mfma_f32_32x32x16_bf16(kf[6],qr[3],C0,0,0,0),   P1[10],P1[11],P1[12],P1[13], pw3[0]=PKW(P1,8), pw3[1]=PKW(P1,10), pw3); \
    VRD(7); SBAR(); GAPA(C1=__builtin_amdgcn_mfma_f32_32x32x16_bf16(kf[7],qr[3],C1,0,0,0),   P1[14],P1[15],0.f,0.f,       pw3[2]=PKW(P1,12),pw3[3]=PKW(P1,14), pw3); \
    l_reg+=sacc; \
    if(GK){DMA_K((t)+3,sl_cur);} if(GV){DMA_V((t)+1,sl_next);} \
    CMASK(C0,C1,t); \
    { float a=MX3(C0[0],C0[1],C1[0]),b=MX3(C0[2],C0[3],C1[1]); a=MX3(a,C1[2],C1[3]); \
      _Pragma("unroll") for(int r=4;r<16;r+=4){a=MX3(a,C0[r],C0[r+1]);b=MX3(b,C0[r+2],C0[r+3]);a=MX3(a,C1[r],C1[r+1]);b=MX3(b,C1[r+2],C1[r+3]);} \
      float rm=__builtin_fmaxf(a,b); { auto rr=__builtin_amdgcn_permlane32_swap(__float_as_uint(rm),__float_as_uint(rm),false,false); rm=__builtin_fmaxf(__uint_as_float(rr[0]),__uint_as_float(rr[1])); } \
      resc=false; \
      if(__builtin_expect(__any(rm>(float)THRL),0)){ const float dl=__builtin_fmaxf(rm,0.f); mhat+=dl; \
        _Pragma("unroll") for(int r=0;r<16;++r){C0[r]-=dl;C1[r]-=dl;} \
        _Pragma("unroll") for(int r=0;r<16;++r)negm[r]=-mhat; asm volatile("":"+v"(negm)); \
        const float f=__builtin_amdgcn_exp2f(-dl); l_reg*=f; if(hi==0)wsf[r32]=f; resc=true; } } \
    SBAR(); \
    GAPB(o[0]=__builtin_amdgcn_mfma_f32_32x32x16_bf16(PAF(0),VFR(0),o[0],0,0,0), C0,0); \
    GAPB(o[1]=__builtin_amdgcn_mfma_f32_32x32x16_bf16(PAF(0),VFR(4),o[1],0,0,0), C0,4); \
    KRD(GL,0); GAPB(o[0]=__builtin_amdgcn_mfma_f32_32x32x16_bf16(PAF(1),VFR(1),o[0],0,0,0), C0,8); \
    KRD(GL,1); GAPB(o[1]=__builtin_amdgcn_mfma_f32_32x32x16_bf16(PAF(1),VFR(5),o[1],0,0,0), C0,12); \
    KRD(GL,2); GAPB(o[0]=__builtin_amdgcn_mfma_f32_32x32x16_bf16(PAF(2),VFR(2),o[0],0,0,0), C1,0); \
    KRD(GL,3); GAPB(o[1]=__builtin_amdgcn_mfma_f32_32x32x16_bf16(PAF(2),VFR(6),o[1],0,0,0), C1,4); \
    GAPB(o[0]=__builtin_amdgcn_mfma_f32_32x32x16_bf16(PAF(3),VFR(3),o[0],0,0,0), C1,8); \
    GAPB(o[1]=__builtin_amdgcn_mfma_f32_32x32x16_bf16(PAF(3),VFR(7),o[1],0,0,0), C1,12); \
    }while(0)
  int t=1;
  #undef CMASK
  #define CMASK(P0,P1,t) do{}while(0)
  for(;t+5<NT;t+=2){
    STEP(pB0,pB1,pA0,pA1,t,true,true,true);     WAIT_BAR(2); RESC(); ROT();
    STEP(pA0,pA1,pB0,pB1,t+1,true,true,true);   WAIT_BAR(2); RESC(); ROT();
  }
  #undef CMASK
  #define CMASK(P0,P1,t) do{int jb_=(t)-(NT-4); if(jb_>=0)cmask(P0,P1,jb_,qrel,hi);}while(0)
  #define ENDW(tt) do{ if((tt)+3<NT){WAIT_BAR(2);} else if((tt)+2<NT){WAIT_BAR(1);} else {WAIT_BAR(0);} }while(0)
  for(;t+1<NT;t+=2){
    STEP(pB0,pB1,pA0,pA1,t,(t+3<NT),(t+1<NT),(t+1<NT));       ENDW(t);   RESC(); ROT();
    STEP(pA0,pA1,pB0,pB1,t+1,(t+4<NT),(t+2<NT),(t+2<NT));     ENDW(t+1); RESC(); ROT();
  }
  STEP(pB0,pB1,pA0,pA1,NT-1,false,false,false); RESC();
  { float sacc=pB0[0]+pB0[1]; _Pragma("unroll") for(int r=2;r<16;++r)sacc+=pB0[r]; _Pragma("unroll") for(int r=0;r<16;++r)sacc+=pB1[r]; l_reg+=sacc;
    pw0=(u32x4){PKW(pB0,0),PKW(pB0,2),PKW(pB0,4),PKW(pB0,6)};pw1=(u32x4){PKW(pB0,8),PKW(pB0,10),PKW(pB0,12),PKW(pB0,14)};pw2=(u32x4){PKW(pB1,0),PKW(pB1,2),PKW(pB1,4),PKW(pB1,6)};pw3=(u32x4){PKW(pB1,8),PKW(pB1,10),PKW(pB1,12),PKW(pB1,14)};
    SBAR(); pv(o,vb0+sl_cur,PAF(0),PAF(1),PAF(2),PAF(3)); }
  #undef PKW
  #undef PAF
  #undef VFR
  #undef PIN
  #undef MX3
  #undef GAPA
  #undef GAPB
  #undef EX
  #undef VRD
  #undef KRD
  #undef STEP
  #undef ENDW
  {auto rr=__builtin_amdgcn_permlane32_swap(__float_as_uint(l_reg),__float_as_uint(l_reg),false,false);l_reg=__uint_as_float(rr[0])+__uint_as_float(rr[1]);}
  if(hi==0)wsf[32+r32]=l_reg;asm volatile("s_waitcnt lgkmcnt(0)":::"memory");
  float rli[16];
  #pragma unroll
  for(int r=0;r<16;++r)rli[r]=__builtin_amdgcn_rcpf(wsf[32+crow(r,hi)]);
  bf16*Ow=O+(rowbase+q0+wid*QBLK)*DM+hv*D;
  { bf16*stg=(bf16*)(shm+LDS_OST)+wid*2048;
    #pragma unroll
    for(int r=0;r<16;++r){const int orow=crow(r,hi);
      #pragma unroll
      for(int d0=0;d0<2;++d0)stg[orow*64+d0*32+r32]=__float2bfloat16(o[d0][r]*rli[r]);}
    asm volatile("s_waitcnt lgkmcnt(0)":::"memory");
    #pragma unroll
    for(int i=0;i<4;++i){const int row=i*8+(lane>>3),ch=lane&7; const u32x4 v=*(const u32x4*)(stg+row*64+ch*8); ATTN_STORE16(Ow+(long)row*DM+ch*8,v);} }
  asm volatile("s_waitcnt lgkmcnt(0)\n\ts_barrier":::"memory");
  #undef DMA_K
  #undef DMA_V
  #undef CMASK
  #undef START
  #undef RESC
  #undef ROT
}
constexpr int ATTN_LDS_BYTES=LDS_BYTES;
#undef SBAR
#undef WAIT_BAR
}

#define ACC8(v, A_, ai, bj, m) float v[8] = {A_[ai][bj][m][0][0], A_[ai][bj][m][0][1], A_[ai][bj][m][0][2], A_[ai][bj][m][0][3], A_[ai][bj][m][1][0], A_[ai][bj][m][1][1], A_[ai][bj][m][1][2], A_[ai][bj][m][1][3]}
struct EpiProjFast { static constexpr bool PERM = true, MID = false; const Frame* F;
    static constexpr float PSC = PROJ_FP8 ? W8I : 1.0f;
    __device__ __forceinline__ void operator()(const f32x4 (&acc)[2][2][4][2], const fg::Unit& u, int wr, int wc, int fr, int fq) const {
        const int row0 = u.pm * 256 + wr * 64 + fr, col0 = u.pn * 256 + wc * 32 + 8 * fq;
        const int sec = u.pn >> 2;
        if (sec == 1) {
            const float* lb = wsp<const float>(*F, WS_LB) + (col0 - 1024);
            f32x4 l4[2][2];
#pragma unroll
            for (int bj = 0; bj < 2; ++bj) { l4[bj][0] = *(const f32x4*)(lb + bj * 128); l4[bj][1] = *(const f32x4*)(lb + bj * 128 + 4); }
#pragma unroll
            for (int ai = 0; ai < 2; ++ai)
#pragma unroll
                for (int m = 0; m < 4; ++m)
#pragma unroll
                    for (int bj = 0; bj < 2; ++bj) {
                        f32x4 o[2];
#pragma unroll
                        for (int n = 0; n < 2; ++n)
#pragma unroll
                            for (int i = 0; i < 4; ++i) { const float l = l4[bj][n][i]; o[n][i] = __logf(l + (1.0f - l) * sigmoidf_(acc[ai][bj][m][n][i] * PSC)); }
                        float* op = wsp<float>(*F, WS_LOGF) + (size_t)(row0 + ai * 128 + m * 16) * HW + (col0 - 1024) + bj * 128;
                        *(f32x4*)op = o[0]; *(f32x4*)(op + 4) = o[1];
                    }
        } else if (sec == 4 || sec == 5) {
            const bool ropel = ((wc & 1) == 0) && (fq < 2);
            const float sg = (fq == 0) ? -1.0f : 1.0f;
            bf16* dst = wsp<bf16>(*F, sec == 4 ? WS_QDA : WS_KDA); const int cb = col0 - (sec == 4 ? 4096 : 5120);
            const float scl = (sec == 4 ? QSCALE : 1.0f) * PSC;
#pragma unroll
            for (int am = 0; am < 4; ++am) {
                const int ai = am >> 1, mb = (am & 1) * 2;
                f32x4 rt[2][4];
#pragma unroll
                for (int mm = 0; mm < 2; ++mm) { const float* rp = wsp<const float>(*F, WS_ROPE) + (size_t)((row0 + ai * 128 + (mb + mm) * 16) & (SEQ - 1)) * 16;
#pragma unroll
                    for (int q = 0; q < 4; ++q) rt[mm][q] = *(const f32x4*)(rp + 4 * q); }
#pragma unroll
                for (int mm = 0; mm < 2; ++mm)
#pragma unroll
                    for (int bj = 0; bj < 2; ++bj) {
                        const int m = mb + mm;
                        ACC8(v, acc, ai, bj, m);
                        float pv[8];
#pragma unroll
                        for (int i = 0; i < 8; ++i) pv[i] = __shfl_xor(v[i], 16);
#pragma unroll
                        for (int i = 0; i < 8; ++i) { const float cs = ropel ? rt[mm][i >> 2][i & 3] : 1.0f, sn = ropel ? sg * rt[mm][2 + (i >> 2)][i & 3] : 0.0f; v[i] = v[i] * cs + pv[i] * sn; }
#pragma unroll
                        for (int i = 0; i < 8; ++i) v[i] *= scl;
                        store8_bf16(dst + (size_t)(row0 + ai * 128 + m * 16) * HW + cb + bj * 128, v);
                    }
            }
        } else {
#pragma unroll
            for (int ai = 0; ai < 2; ++ai)
#pragma unroll
                for (int m = 0; m < 4; ++m)
#pragma unroll
                    for (int bj = 0; bj < 2; ++bj) { ACC8(v, acc, ai, bj, m);
#pragma unroll
                        for (int i = 0; i < 8; ++i) v[i] *= PSC;
                        proj_store8(*F, row0 + ai * 128 + m * 16, col0 + bj * 128, v, 16); }
        }
    } };
__device__ __forceinline__ void ph_proj_fast(Frame& F) {
#if PROJ_FP8
    fg::DenseOrderT<true> S; S.init(wsp<const bf16>(F, WS_H1), wsp<const bf16>(F, WS_WIN_T), T, INC, DM / 2, F.G, F.bid);
    EpiProjFast E{&F};
    fg::gemm_phase(F.lds, DM / 2, S, E);
#else
    fg::DenseOrder S; S.init(wsp<const bf16>(F, WS_H1), wsp<const bf16>(F, WS_WIN_T), T, INC, DM, F.G, F.bid);
    EpiProjFast E{&F};
    fg::gemm_phase(F.lds, DM, S, E);
#endif
}
struct EpiBranchFast { static constexpr bool PERM = true, MID = true; const Frame* F;
    __device__ __forceinline__ void mid(f32x4 (&acc)[2][2][4][2], const fg::Unit& u, int wr, int wc, int fr, int fq) const {
        int row0 = u.pm * 256 + wr * 64 + fr, col0 = u.pn * 256 + wc * 32 + 8 * fq;
        asm volatile("" : "+v"(row0), "+v"(col0));
        const bf16* GH = wsp<const bf16>(*F, WS_GATEH); const bf16* GD = wsp<const bf16>(*F, WS_GATED);
#pragma unroll
        for (int ai = 0; ai < 2; ++ai) {
            u32x4 gh2[2][4], gd2[2][4];
#pragma unroll
            for (int bj = 0; bj < 2; ++bj)
#pragma unroll
                for (int m = 0; m < 4; ++m) { const size_t off = (size_t)(row0 + ai * 128 + m * 16) * DM + col0 + bj * 128; gh2[bj][m] = *(const u32x4*)(GH + off); gd2[bj][m] = *(const u32x4*)(GD + off); }
#pragma unroll
            for (int bj = 0; bj < 2; ++bj) {
#pragma unroll
                for (int m = 0; m < 4; ++m) {
                    const unsigned hh[4] = {gh2[bj][m].x, gh2[bj][m].y, gh2[bj][m].z, gh2[bj][m].w}, dd[4] = {gd2[bj][m].x, gd2[bj][m].y, gd2[bj][m].z, gd2[bj][m].w};
#pragma unroll
                    for (int i = 0; i < 4; ++i) {
                        const float r0 = bf2f(hh[i] & 0xffffu) * __builtin_amdgcn_rcpf(fmaxf(bf2f(dd[i] & 0xffffu), 1e-30f));
                        const float r1 = bf2f(hh[i] >> 16) * __builtin_amdgcn_rcpf(fmaxf(bf2f(dd[i] >> 16), 1e-30f));
                        acc[ai][bj][m][i >> 1][(i & 1) * 2] *= r0; acc[ai][bj][m][i >> 1][(i & 1) * 2 + 1] *= r1;
                    }
                }
            }
            asm volatile("" ::: "memory");
        }
    }
    __device__ __forceinline__ void operator()(const f32x4 (&acc)[2][2][4][2], const fg::Unit& u, int wr, int wc, int fr, int fq) const {
        const int row0 = u.pm * 256 + wr * 64 + fr, col0 = u.pn * 256 + wc * 32 + 8 * fq;
        const bf16* GD = wsp<const bf16>(*F, WS_GATED);
        u32x4 gda[2][4][2];
#pragma unroll
        for (int ai = 0; ai < 2; ++ai)
#pragma unroll
            for (int m = 0; m < 4; ++m)
#pragma unroll
                for (int bj = 0; bj < 2; ++bj) gda[ai][m][bj] = *(const u32x4*)(GD + (size_t)(row0 + ai * 128 + m * 16) * DM + col0 + bj * 128);
#pragma unroll
        for (int ai = 0; ai < 2; ++ai) {
#pragma unroll
            for (int m = 0; m < 4; ++m)
#pragma unroll
                for (int bj = 0; bj < 2; ++bj) {
                    const u32x4 g = gda[ai][m][bj]; const f32x4 a0 = acc[ai][bj][m][0], a1 = acc[ai][bj][m][1];
                    float o[8] = {a0[0] * bf2f(g.x & 0xffffu), a0[1] * bf2f(g.x >> 16), a0[2] * bf2f(g.y & 0xffffu), a0[3] * bf2f(g.y >> 16),
                                  a1[0] * bf2f(g.z & 0xffffu), a1[1] * bf2f(g.z >> 16), a1[2] * bf2f(g.w & 0xffffu), a1[3] * bf2f(g.w >> 16)};
                    store8_bf16(wsp<bf16>(*F, WS_MERGED) + (size_t)(row0 + ai * 128 + m * 16) * DM + col0 + bj * 128, o);
                }
        }
    } };
__device__ __forceinline__ void ph_branch_fast(Frame& F) {
    fg::DenseOrder S; S.init(wsp<const bf16>(F, WS_YCAT), wsp<const bf16>(F, WS_WBH_T), T, DM, DM, F.G, F.bid);
    EpiBranchFast E{&F};
    fg::gemm_phase(F.lds, DM, S, E);
}
struct EpiUFast { static constexpr bool PERM = true, MID = false; const Frame* F;
    __device__ __forceinline__ void operator()(const f32x4 (&acc)[2][2][4][2], const fg::Unit& u, int wr, int wc, int fr, int fq) const {
        const int row0 = u.pm * 256 + wr * 64 + fr, col0 = u.pn * 256 + wc * 32 + 8 * fq;
#pragma unroll
        for (int ai = 0; ai < 2; ++ai)
#pragma unroll
            for (int m = 0; m < 4; ++m)
#pragma unroll
                for (int bj = 0; bj < 2; ++bj) { ACC8(v, acc, ai, bj, m); store8_bf16(wsp<bf16>(*F, WS_U) + (size_t)(row0 + ai * 128 + m * 16) * DM + col0 + bj * 128, v); }
    } };
__device__ __forceinline__ void ph_wout_fast(Frame& F) {
    fg::DenseOrder S; S.init(wsp<const bf16>(F, WS_MERGED), wsp<const bf16>(F, WS_WOUT_T), T, DM, DM, F.G, F.bid);
    EpiUFast E{&F};
    fg::gemm_phase(F.lds, DM, S, E);
}
struct Args;
typedef const __attribute__((address_space(4))) Args* CArgs;
constexpr int TU_L = 2, TU_M = 40 - TU_L;
constexpr int N_TU_LATE = NE * TU_L, N_TU_MIX = NE * TU_M;
__device__ __forceinline__ void t_unit(CArgs A, int e, int r);
__device__ __forceinline__ int q_claim(CArgs A, int ctr);
template <bool GATHER_, bool IDENT_ = false> struct MoeOrder {
    static constexpr bool GATHER = GATHER_, FP8 = true;
    const LAS int* tab; int G, c; const char* A; const char* Bt; int K; size_t bstride; const int* list;
    __device__ __forceinline__ bool next(int i, fg::Unit& u) const {
        const int q = i * (G >> 3) + (c >> 3), x = c & 7;
        const int mtg = 2 * (q >> 1) + (x >> 2), pn = 2 * (x & 3) + (q & 1);
        if (mtg >= tab[72 + NE]) return false;
        int e = 0;
#pragma unroll
        for (int st = 16; st >= 1; st >>= 1) if (tab[72 + e + st] <= mtg) e += st;
        const int mt = mtg - tab[72 + e];
        u.pm = mt; u.pn = pn; u.e = e; u.nvalid = min(256, tab[e] - mt * 256); u.slot0 = tab[32 + e] + mt * 256; return true;
    }
    __device__ __forceinline__ const char* a_ptr(const fg::Unit& u) const { return GATHER ? A : A + (size_t)u.slot0 * K * 2; }
    __device__ __forceinline__ int a_row(const fg::Unit& u, int r) const { if constexpr (IDENT_) return u.slot0 + r; else return r < u.nvalid ? list[u.e * 16384 + u.pm * 256 + r] : 0; }
    __device__ __forceinline__ const char* b_ptr(const fg::Unit& u) const { return Bt + (size_t)u.e * bstride + (size_t)u.pn * 256 * K * 2; }
};
struct EpiMoe1Fast { static constexpr bool PERM = true, MID = false; const Frame* F;
    __device__ __forceinline__ void operator()(const f32x4 (&acc)[2][2][4][2], const fg::Unit& u, int wr, int wc, int fr, int fq) const {
        const int col0 = u.pn * 128 + wc * 32 + 8 * fq;
#pragma unroll
        for (int ai = 0; ai < 2; ++ai)
#pragma unroll
            for (int m = 0; m < 4; ++m) {
                const int r = ai * 128 + wr * 64 + m * 16 + fr;
                ACC8(g, acc, ai, 0, m); ACC8(up, acc, ai, 1, m);
                float o[8];
#pragma unroll
                for (int i = 0; i < 8; ++i) { const float gs = g[i] * W8I; o[i] = clamp8(gs * sigmoidf_(gs) * (up[i] * W8I)); }
                if (r < u.nvalid) { u32x2 p; p.x = pk4_fp8(o[0], o[1], o[2], o[3]); p.y = pk4_fp8(o[4], o[5], o[6], o[7]); *(u32x2*)(wsp<unsigned char>(*F, WS_ACT) + (size_t)(u.slot0 + r) * DE + col0) = p; }
            }
    } };
struct EpiMoe2Fast { static constexpr bool PERM = true, MID = false; const Frame* F;
    __device__ __forceinline__ void operator()(const f32x4 (&acc)[2][2][4][2], const fg::Unit& u, int wr, int wc, int fr, int fq) const {
        const int col0 = u.pn * 256 + wc * 32 + 8 * fq;
        unsigned char* YW8 = wsp<unsigned char>(*F, WS_YW);
#pragma unroll
        for (int ai = 0; ai < 2; ++ai)
#pragma unroll
            for (int m = 0; m < 4; ++m) {
                const int r = ai * 128 + wr * 64 + m * 16 + fr;
                const bool ok = r < u.nvalid;
#pragma unroll
                for (int bj = 0; bj < 2; ++bj) { ACC8(v, acc, ai, bj, m);
#pragma unroll
                    for (int i = 0; i < 8; ++i) v[i] = clamp8(v[i] * (W8I * Y8S));
                    if (ok) { u32x2 p; p.x = pk4_fp8(v[0], v[1], v[2], v[3]); p.y = pk4_fp8(v[4], v[5], v[6], v[7]); *(u32x2*)(YW8 + (size_t)(u.slot0 + r) * DM + col0 + bj * 128) = p; } }
            }
    } };
__device__ __forceinline__ void ph_moe1_fast(Frame& F, CArgs A) {
    LAS int* tab = (LAS int*)(F.lds + 131072);
    expert_tables(F, tab, 256);
    MoeOrder<true> S{tab, F.G, F.bid, (const char*)wsp<const bf16>(F, WS_H2), (const char*)wsp<const bf16>(F, WS_WGU_T), DM / 2, (size_t)2048 * DM, wsp<const int>(F, WS_LISTTOK)};
    EpiMoe1Fast E{&F};
    fg::gemm_phase(F.lds, DM / 2, S, E);
    for (;;) {
        const int j = q_claim(A, CW_TQ + 64);
        if (j >= N_TU_LATE) break;
        t_unit(A, j / TU_L, 32 + j % TU_L);
    }
}
__device__ __forceinline__ void ph_moe2_fast(Frame& F) {
    LAS int* tab = (LAS int*)(F.lds + 131072);
    expert_tables(F, tab, 256);
    MoeOrder<true, true> S{tab, F.G, F.bid, (const char*)wsp<const bf16>(F, WS_ACT), (const char*)wsp<const bf16>(F, WS_WD_T), DE / 2, (size_t)DM * DE, nullptr};
    EpiMoe2Fast E{&F};
    fg::gemm_phase(F.lds, DE / 2, S, E);
}

struct Args { const float* in[26]; float* out; unsigned char* ws; int ph_lo, ph_hi; };
__device__ __forceinline__ void t_unit(CArgs A, int e, int r) {
    asm volatile("" : "+s"(A));
    int t_ = threadIdx.x; asm volatile("" : "+v"(t_));
    const int lane = t_ & 63, wave = __builtin_amdgcn_readfirstlane(t_ >> 6);
    unsigned char* ws = A->ws;
    f32x4 t0[8], t1[8], t2[8], t3[8];
#define T_LOADP(ta, tb, RS, N, k0, n0) do { const int vo_ = ((16 * (lane >> 3)) * (N) + (n0) + 4 * (lane & 7)) * 4; \
        _Pragma("unroll") for (int i = 0; i < 8; ++i) ta[i] = __builtin_bit_cast(f32x4, __builtin_amdgcn_raw_buffer_load_b128(RS, vo_, ((k0) + i) * (N) * 4, 2)); \
        _Pragma("unroll") for (int i = 0; i < 8; ++i) tb[i] = __builtin_bit_cast(f32x4, __builtin_amdgcn_raw_buffer_load_b128(RS, vo_, ((k0) + 8 + i) * (N) * 4, 2)); } while (0)
#define T_STOREP8(ta, tb, WT, K, k0, drow) do { _Pragma("unroll") for (int j = 0; j < 4; ++j) { u32x4 o_; \
        o_.x = pk4_fp8(ta[0][j] * W8S, ta[1][j] * W8S, ta[2][j] * W8S, ta[3][j] * W8S); o_.y = pk4_fp8(ta[4][j] * W8S, ta[5][j] * W8S, ta[6][j] * W8S, ta[7][j] * W8S); \
        o_.z = pk4_fp8(tb[0][j] * W8S, tb[1][j] * W8S, tb[2][j] * W8S, tb[3][j] * W8S); o_.w = pk4_fp8(tb[4][j] * W8S, tb[5][j] * W8S, tb[6][j] * W8S, tb[7][j] * W8S); \
        *(u32x4*)((WT) + (size_t)((drow) + 4 * (lane & 7) + j) * (K) + (k0) + 16 * (lane >> 3)) = o_; } } while (0)
#define T_WAVE(W, N, WT, K, k0, n0, dr) do { \
        T_LOADP(t0, t1, W, N, k0, n0); T_LOADP(t2, t3, W, N, k0, (n0) + 32); \
        T_STOREP8(t0, t1, WT, K, k0, dr); T_LOADP(t0, t1, W, N, k0, (n0) + 64); \
        T_STOREP8(t2, t3, WT, K, k0, (dr) + 32); T_LOADP(t2, t3, W, N, k0, (n0) + 96); \
        T_STOREP8(t0, t1, WT, K, k0, (dr) + 64); T_STOREP8(t2, t3, WT, K, k0, (dr) + 96); } while (0)
    if (r < 32) {
        const int up = r >> 4, k0 = (r & 15) * 128;
        const float* Wp = (up ? A->in[24] : A->in[23]) + (size_t)e * DM * DE; unsigned char* WT = ws + WS_WGU_T + (size_t)e * 2048 * DM;
        const __amdgpu_buffer_rsrc_t W = __builtin_amdgcn_make_buffer_rsrc((void*)Wp, 0, DM * DE * 4, 0x00020000);
        const int n0 = wave * 128, dr = wave * 256 + up * 128;
        T_WAVE(W, DE, WT, DM, k0, n0, dr);
    } else {
        const int rr = r - 32, k0 = (rr >> 1) * 128, n0 = (rr & 1) * 1024 + wave * 128;
        const float* Wp = A->in[25] + (size_t)e * DE * DM; unsigned char* WT = ws + WS_WD_T + (size_t)e * DM * DE;
        const __amdgpu_buffer_rsrc_t W = __builtin_amdgcn_make_buffer_rsrc((void*)Wp, 0, DM * DE * 4, 0x00020000);
        T_WAVE(W, DM, WT, DE, k0, n0, n0);
    }
#undef T_WAVE
#undef T_LOADP
#undef T_STOREP8
}
__device__ __forceinline__ int q_claim(CArgs A, int ctr) {
    volatile LAS int* qslot = (volatile LAS int*)((LAS unsigned char*)0 + MISC_OFF + 64);
    __syncthreads();
    if (threadIdx.x == 0) *qslot = (int)__hip_atomic_fetch_add((unsigned*)(A->ws + WS_CTL) + ctr, 1u, RLX_AGENT);
    __syncthreads();
    return __builtin_amdgcn_readfirstlane(*qslot);
}
__device__ __forceinline__ int attn_claim(CArgs A, int base) {
    volatile LAS int* qslot = (volatile LAS int*)((LAS unsigned char*)0 + MISC_OFF + 64);
    __syncthreads();
    if (threadIdx.x == 0) {
        unsigned* q = (unsigned*)(A->ws + WS_CTL) + base;
        const unsigned x = xb_xcc_id() & 7u;
        int res = -1;
        unsigned j = __hip_atomic_fetch_add(q + 16 * x, 1u, RLX_AGENT);
        if (j < 256u) res = (int)(x * 256u + j);
        else {
            unsigned c[8];
#pragma unroll
            for (int k = 0; k < 8; ++k) c[k] = __hip_atomic_load(q + 16 * k, RLX_AGENT);
#pragma unroll 1
            for (unsigned k = 1; k < 8 && res < 0; ++k) { const unsigned s2 = (x + k) & 7u; bool live = false;
#pragma unroll
                for (int k2 = 0; k2 < 8; ++k2) live = live || ((unsigned)k2 == s2 && c[k2] < 256u);
                if (!live) continue;
                j = __hip_atomic_fetch_add(q + 16 * s2, 1u, RLX_AGENT);
                if (j < 256u) res = (int)(s2 * 256u + j); }
        }
        *qslot = res;
    }
    __syncthreads();
    return __builtin_amdgcn_readfirstlane(*qslot);
}
__device__ __forceinline__ void ph_mix_fast(Frame& F, CArgs A, char* lds_generic, int coff = 0) {
    constexpr float TPC = 1.25f * (float)N_TU_MIX / 55168.0f;
    float credit = (float)(F.bid & 3) * 0.5f; bool a_done = false, t_done = false;
    for (int ch = F.bid; ch < NB * NH; ch += F.G) { hgrn_chain_fast(F, ch); credit += 60.0f * TPC; }
    while (!(a_done && t_done)) {
        while (!t_done && (credit >= 1.0f || a_done)) {
            const int t = q_claim(A, CW_TQ + coff);
            if (t >= N_TU_MIX) { t_done = true; break; }
            { const int e = t / TU_M, rm = t % TU_M; t_unit(A, e, rm < 32 ? rm : rm + TU_L); } credit -= 1.0f;
        }
        if (!a_done) {
            const int a = attn_claim(A, coff ? 12288 : CW_ATTQ);
            if (a < 0) { a_done = true; continue; }
            const int sq = a >> 8, jq = a & 255, wq = jq & 63, pr = sq * 8 + 2 * (jq >> 6) + ((wq >> 2) & 1);
            const int qb = 7 - (wq >> 3), b = pr >> 3, h = pr & 7, m = (wq >> 1) & 1, vhalf = wq & 1;
            unsigned char* ws = A->ws;
            attn_body::attn_unit<8>(b, 2 * h + m, 2 * h + vhalf, qb, (const attn_body::bf16*)(ws + WS_QDA), (const attn_body::bf16*)(ws + WS_KDA), (const attn_body::bf16*)(ws + WS_VDA),
                                    (attn_body::bf16*)(ws + (m ? WS_O2 : WS_O1)), lds_generic);
            credit += (float)(4 * qb + 7) * TPC;
        }
    }
    __syncthreads();
}
__device__ __forceinline__ void ph_transposes(Frame& F) {
    LAS float* scr = (LAS float*)(F.lds + F.wave * 8704);
    const int gw = F.bid * NWAVES + F.wave, NGW = F.G * NWAVES;
    constexpr int I_IN = 32 * 352, I_BH = 16 * 64, I_OUT = 32 * 64, I_GE = 32 * 32, I_DE = 16 * 64;
    constexpr int NITEMS = I_IN + 2 * I_BH + I_OUT + (EXPERT_T_IN_MIX ? 0 : NE * (2 * I_GE + I_DE));
    for (int it = gw; it < NITEMS; it += NGW) {
        int r = it;
        if (r < I_IN) { const int kb = r / 352, nb = r % 352; transpose_item<PROJ_FP8 != 0>(F.w_in, DM, INC, wsp<bf16>(F, WS_WIN_T), kb * 64, nb * 32, nb * 32, scr, F.lane); continue; } r -= I_IN;
        if (r < I_BH) { const int kb = r / 64, nb = r % 64; transpose_item(F.w_bhg, HW, DM, wsp<bf16>(F, WS_WBH_T), kb * 64, nb * 32, nb * 32, scr, F.lane, DM, 0); continue; } r -= I_BH;
        if (r < I_BH) { const int kb = r / 64, nb = r % 64; transpose_item(F.w_bda, HW, DM, wsp<bf16>(F, WS_WBH_T), kb * 64, nb * 32, nb * 32, scr, F.lane, DM, HW); continue; } r -= I_BH;
        if (r < I_OUT) { const int kb = r / 64, nb = r % 64; transpose_item(F.w_out, DM, DM, wsp<bf16>(F, WS_WOUT_T), kb * 64, nb * 32, nb * 32, scr, F.lane); continue; } r -= I_OUT;
        const int e = r / (2 * I_GE + I_DE); r -= e * (2 * I_GE + I_DE);
        if (r < 2 * I_GE) { const int up = r >= I_GE ? 1 : 0; r -= up * I_GE; const int kb = r / 32, nb = r % 32;
            transpose_item((up ? F.w_up : F.w_gate) + (size_t)e * DM * DE, DM, DE, wsp<bf16>(F, WS_WGU_T) + (size_t)e * 2048 * DM, kb * 64, nb * 32, (nb >> 2) * 256 + up * 128 + (nb & 3) * 32, scr, F.lane); continue; }
        r -= 2 * I_GE;
        { const int kb = r / 64, nb = r % 64; transpose_item(F.w_down + (size_t)e * DE * DM, DE, DM, wsp<bf16>(F, WS_WD_T) + (size_t)e * DM * DE, kb * 64, nb * 32, nb * 32, scr, F.lane); }
    }
}

__global__ void __launch_bounds__(NTHREADS, 2) mk_fwd(Args args) {
    extern __shared__ __attribute__((aligned(16))) unsigned char lds[];
    Frame F;
    CArgs A = (CArgs)__builtin_amdgcn_kernarg_segment_ptr();
    F.lds = (LAS unsigned char*)lds;
    F.G = gridDim.x; F.bid = blockIdx.x;
#define ENTER() do { asm volatile("" : "+s"(A)); int t_ = threadIdx.x; asm volatile("" : "+v"(t_)); F.tid = t_; F.lane = t_ & 63; F.wave = __builtin_amdgcn_readfirstlane(t_ >> 6); \
    F.ws = A->ws; F.ctl = (gu32*)(F.ws + WS_CTL); F.out = A->out; \
    F.x = A->in[0]; F.c = A->in[1]; F.w_ada = A->in[2]; F.b_ada = A->in[3]; F.pre_mix = A->in[4]; F.post_mix = A->in[5]; F.pre_ffn = A->in[6]; F.post_ffn = A->in[7]; \
    F.w_in = A->in[8]; F.hg_lb = A->in[9]; F.hg_nw = A->in[10]; F.lq1 = A->in[11]; F.lk1 = A->in[12]; F.lq2 = A->in[13]; F.lk2 = A->in[14]; F.da_nw = A->in[15]; \
    F.w_bhg = A->in[16]; F.w_bda = A->in[17]; F.w_out = A->in[18]; F.w_group = A->in[19]; F.b_group = A->in[20]; F.w_router = A->in[21]; F.b_router = A->in[22]; \
    F.w_gate = A->in[23]; F.w_up = A->in[24]; F.w_down = A->in[25]; } while (0)
    ENTER();
    volatile LAS unsigned* MISC = (volatile LAS unsigned*)(F.lds + MISC_OFF);
    for (int u = F.tid; u < (LDS_BYTES - LDSCTL_OFF) / 4; u += NTHREADS) ((LAS unsigned*)(F.lds + LDSCTL_OFF))[u] = 0u;
    __syncthreads();
    const int lo = A->ph_lo, hi = A->ph_hi;
    XcdBarrier bar; bar.bar = (unsigned*)(F.ctl + CW_BAR); bar.x = 0; bar.st = nullptr;
    if (hi - lo > 1) bar = xcd_barrier_post((unsigned*)(F.ctl + CW_BAR), MISC + 8);
#define IN(k) (lo <= (k) && (k) < hi)
#define SEAM(k) do { if (IN(k) && IN((k) + 1)) xcd_barrier(bar); } while (0)
    if (IN(PH_PRO)) { ENTER(); ph_prologue(F); }
    if (PROBE_DUP == 100) { xcd_barrier(bar); ENTER(); ph_prologue(F); xcd_barrier(bar); }
#if FAST_GEMM
    if (IN(PH_PRO)) { ENTER(); ph_transposes(F); }
    if (PROBE_DUP == PH_PRO) { xcd_barrier(bar); ENTER(); ph_transposes(F); }
#endif
    SEAM(PH_PRO);
    if (IN(PH_MOD)) { ENTER(); ph_mod(F); } SEAM(PH_MOD);
    if (IN(PH_H1)) { ENTER(); ph_h1(F); }
    if (PROBE_DUP == PH_H1) { xcd_barrier(bar); ENTER(); ph_h1(F); }
    SEAM(PH_H1);
#if FAST_GEMM
    if (IN(PH_PROJ)) { ENTER(); ph_proj_fast(F); }
    if (PROBE_DUP == PH_PROJ) { xcd_barrier(bar); ENTER(); ph_proj_fast(F); }
    SEAM(PH_PROJ);
#else
    if (IN(PH_PROJ)) { ENTER(); ph_proj_simple(F); } SEAM(PH_PROJ);
#endif
#if FAST_ATTN
    if (IN(PH_MIX)) { ENTER(); ph_mix_fast(F, A, (char*)lds); }
    if (PROBE_DUP == PH_MIX) { xcd_barrier(bar); ENTER(); ph_mix_fast(F, A, (char*)lds, 32); }
    SEAM(PH_MIX);
#else
    if (IN(PH_MIX)) { ENTER(); ph_mix_simple(F); } SEAM(PH_MIX);
#endif
    if (IN(PH_YDA)) { ENTER(); ph_yda(F); }
    if (PROBE_DUP == PH_YDA) { xcd_barrier(bar); ENTER(); ph_yda(F); }
    SEAM(PH_YDA);
#if FAST_GEMM
    if (IN(PH_BRANCH)) { ENTER(); ph_branch_fast(F); }
    if (PROBE_DUP == PH_BRANCH) { xcd_barrier(bar); ENTER(); ph_branch_fast(F); }
    SEAM(PH_BRANCH);
#else
    if (IN(PH_BRANCH)) { ENTER(); ph_branch_simple(F); } SEAM(PH_BRANCH);
#endif
#if FAST_GEMM
    if (IN(PH_WOUT)) { ENTER(); ph_wout_fast(F); }
    if (PROBE_DUP == PH_WOUT) { xcd_barrier(bar); ENTER(); ph_wout_fast(F); }
    SEAM(PH_WOUT);
#else
    if (IN(PH_WOUT)) { ENTER(); ph_wout_simple(F); } SEAM(PH_WOUT);
#endif
#if FAST_POST
    if (IN(PH_POST)) { ENTER(); ph_post_fast(F); } SEAM(PH_POST);
#else
    if (IN(PH_POST)) { ENTER(); ph_post(F); } SEAM(PH_POST);
#endif
#if FAST_GEMM
    if (IN(PH_MOE1)) { ENTER(); ph_moe1_fast(F, A); }
    if (PROBE_DUP == PH_MOE1) { xcd_barrier(bar); ENTER(); ph_moe1_fast(F, A); }
    SEAM(PH_MOE1);
#else
    if (IN(PH_MOE1)) { ENTER(); ph_moe1_simple(F); } SEAM(PH_MOE1);
#endif
#if FAST_GEMM
    if (IN(PH_MOE2)) { ENTER(); ph_moe2_fast(F); }
    if (PROBE_DUP == PH_MOE2) { xcd_barrier(bar); ENTER(); ph_moe2_fast(F); }
    SEAM(PH_MOE2);
#else
    if (IN(PH_MOE2)) { ENTER(); ph_moe2_simple(F); } SEAM(PH_MOE2);
#endif
    if (IN(PH_FINAL)) { ENTER(); ph_final(F); }
    if (PROBE_DUP == PH_FINAL) { xcd_barrier(bar); ENTER(); ph_final(F); }
#undef IN
#undef SEAM
}

extern "C" void kernel_launch(void* const* d_in, const int* in_sizes, int n_in, void* d_out, int out_size, void* d_ws, size_t ws_size, hipStream_t stream) {
    static int grid = 0;
    if (grid == 0) {
        if (n_in != 26 || out_size != T * DM || ws_size < WS_END) { fprintf(stderr, "kernel_launch: unexpected shapes (n_in %d out %d ws %zu)\n", n_in, out_size, ws_size); grid = -1; return; }
        int dev = 0, cus = 0, per_cu = 0;
        if (hipGetDevice(&dev) != hipSuccess || hipDeviceGetAttribute(&cus, hipDeviceAttributeMultiprocessorCount, dev) != hipSuccess) { grid = -1; return; }
        if (hipFuncSetAttribute((const void*)mk_fwd, hipFuncAttributeMaxDynamicSharedMemorySize, LDS_BYTES) != hipSuccess) { grid = -1; return; }
        if (hipOccupancyMaxActiveBlocksPerMultiprocessor(&per_cu, (const void*)mk_fwd, NTHREADS, LDS_BYTES) != hipSuccess || per_cu < 1) { fprintf(stderr, "kernel_launch: occupancy query says %d\n", per_cu); }
        (void)hipGetLastError();
        grid = cus;
    }
    if (grid < 0) return;
    (void)hipMemsetAsync((char*)d_ws + WS_CTL, 0, CTL_ZERO_BYTES, stream);
    Args a{};
    for (int i = 0; i < 26; ++i) a.in[i] = (const float*)d_in[i];
    a.out = (float*)d_out; a.ws = (unsigned char*)d_ws;
#if MK_ONE_LAUNCH
    a.ph_lo = 0; a.ph_hi = N_PHASES;
    hipLaunchKernelGGL(mk_fwd, dim3(grid), dim3(NTHREADS), LDS_BYTES, stream, a);
#else
    for (int p = 0; p < N_PHASES; ++p) { a.ph_lo = p; a.ph_hi = p + 1; hipLaunchKernelGGL(mk_fwd, dim3(grid), dim3(NTHREADS), LDS_BYTES, stream, a); }
#endif
}
```

```cpp
#include <hip/hip_runtime.h>
#include <cstdio>
#include <cstdint>

constexpr int DM = 2048, NB = 8, SEQ = 2048, T = NB * SEQ;
constexpr int HW = 1024;
constexpr int NH = 8, HD = 128;
constexpr int INC = 11264;
constexpr int NE = 32, EPG = 8, NG = 4, DE = 1024;
constexpr float EPS = 1e-6f;
constexpr float LAMBDA_INIT = 0.2f;
constexpr float QSCALE = 0.125f * 1.4426950408889634f;
constexpr int SLOT_MAX = 40960;

constexpr int NWAVES = 8, NTHREADS = 512;
enum { PH_PRO = 0, PH_MOD, PH_H1, PH_PROJ, PH_MIX, PH_YDA, PH_BRANCH, PH_WOUT, PH_POST, PH_MOE1, PH_MOE2, PH_FINAL, N_PHASES };
#ifndef EXPERT_T_IN_MIX
#define EXPERT_T_IN_MIX 1
#endif
#ifndef FAST_POST
#define FAST_POST 1
#endif
#ifndef PROJ_FP8
#define PROJ_FP8 1
#endif
#ifndef BRANCH_FP8
#define BRANCH_FP8 1
#endif
#ifndef WOUT_FP8
#define WOUT_FP8 1
#endif
#ifndef PROBE_DUP
#define PROBE_DUP -1
#endif
#ifndef FAST_ATTN
#define FAST_ATTN 1
#endif
#ifndef FAST_HGRN
#define FAST_HGRN 1
#endif
#ifndef FAST_GEMM
#define FAST_GEMM 1
#endif
#ifndef MK_ONE_LAUNCH
#define MK_ONE_LAUNCH 1
#endif

constexpr size_t MiB = 1u << 20;
constexpr size_t WS_CTL = 0, CTL_ZERO_BYTES = 1 * MiB;
constexpr size_t WS_MODP = 1 * MiB;
constexpr size_t WS_ROPE = 4 * MiB;
constexpr size_t WS_LB = 4 * MiB + 256 * 1024;
constexpr size_t WS_LAM = WS_LB + 8192;
constexpr size_t WS_TOKE = 5 * MiB;
constexpr size_t WS_TOKP = 5 * MiB + 256 * 1024;
constexpr size_t WS_LISTTOK = 6 * MiB;
constexpr size_t WS_LISTW = 8 * MiB;
constexpr size_t WS_P64 = 460 * MiB;
constexpr size_t WS_MODF = 10 * MiB;
constexpr size_t WS_WCAT = 11 * MiB;
constexpr size_t WS_WIN_T = 16 * MiB, WS_WBH_T = 60 * MiB, WS_WBD_T = 64 * MiB, WS_WOUT_T = 68 * MiB, WS_WGU_T = 76 * MiB, WS_WD_T = 332 * MiB;
constexpr size_t WS_TMPG = 76 * MiB;
constexpr size_t WS_H1 = 460 * MiB, WS_QHG = 524 * MiB, WS_LOGF = 556 * MiB, WS_VHG = 620 * MiB, WS_GHG = 652 * MiB;
constexpr size_t WS_QDA = 684 * MiB, WS_KDA = 716 * MiB, WS_VDA = 748 * MiB, WS_GATEH = 780 * MiB, WS_GATED = 844 * MiB;
constexpr size_t WS_YCAT = 908 * MiB;
constexpr size_t WS_YHG = WS_YCAT, WS_YDA = WS_YCAT + (BRANCH_FP8 ? 1024 : 2048), WS_O1 = 972 * MiB, WS_O2 = 1004 * MiB, WS_END = 1036 * MiB;
constexpr size_t WS_TMP = 460 * MiB;
constexpr size_t WS_MERGED = 588 * MiB;
constexpr size_t WS_U = 652 * MiB;
constexpr size_t WS_X1 = 460 * MiB;
constexpr size_t WS_H2 = 588 * MiB;
constexpr size_t WS_ACT = 716 * MiB;
constexpr size_t WS_YW = 796 * MiB;
constexpr int CW_TMO = 0, CW_CODE = 1, CW_BAR = 4096, CW_CNT = 8192  , CW_ATTQ = 9216, CW_TQ = 9216 + 128;

constexpr int RING_BYTES = 131072 + 8192;
constexpr int LDSCTL_OFF = RING_BYTES, MISC_OFF = LDSCTL_OFF + 320;
constexpr int LDS_BYTES = 147456;
static_assert(MISC_OFF + 128 <= LDS_BYTES, "LDS map");

#define GAS __attribute__((address_space(1)))
#define LAS __attribute__((address_space(3)))
typedef unsigned short bf16;
typedef float f32x4 __attribute__((ext_vector_type(4)));
typedef unsigned u32x4 __attribute__((ext_vector_type(4)));
typedef unsigned u32x2 __attribute__((ext_vector_type(2)));
typedef float f32x2_t __attribute__((ext_vector_type(2)));
typedef GAS unsigned gu32;
#define RLX_AGENT __ATOMIC_RELAXED, __HIP_MEMORY_SCOPE_AGENT

__device__ __forceinline__ float bf2f(unsigned h) { return __uint_as_float(h << 16); }
__device__ __forceinline__ unsigned f2bf(float f) { unsigned u = __float_as_uint(f); return (u + 0x7fffu + ((u >> 16) & 1u)) >> 16; }
__device__ __forceinline__ unsigned pk2(float lo, float hi) { unsigned r; asm("v_cvt_pk_bf16_f32 %0, %1, %2" : "=v"(r) : "v"(lo), "v"(hi)); return r; }
__device__ __forceinline__ float sigmoidf_(float v) { return __builtin_amdgcn_rcpf(1.0f + __builtin_amdgcn_exp2f(-1.4426950408889634f * v)); }
__device__ __forceinline__ float wave_sum(float v) {
#pragma unroll
    for (int o = 1; o < 64; o <<= 1) v += __shfl_xor(v, o);
    return v;
}

#define XB_TMO      128
#define XB_XCNT(j)  (256  + 64 * (j))
#define XB_XSUB(j)  (1280 + 64 * (j))
#define XB_XGEN(j)  (2304 + 64 * (j))
#define XB_TOP      3328
#define XB_TOPGEN   3392
#define XCD_BAR_WORDS 3456
#define XB_SPIN_CAP (1u << 22)
__device__ __forceinline__ unsigned xb_ld(unsigned* p)              { return __hip_atomic_load(p, __ATOMIC_RELAXED, __HIP_MEMORY_SCOPE_AGENT); }
__device__ __forceinline__ unsigned xb_add(unsigned* p, unsigned v) { return __hip_atomic_fetch_add(p, v, __ATOMIC_RELAXED, __HIP_MEMORY_SCOPE_AGENT); }
__device__ __forceinline__ unsigned xb_xcc_id() { return (unsigned)__builtin_amdgcn_s_getreg((3 << 11) | 20) & 0xFu; }
#define XB_SPIN(cond, bar) do { unsigned _sp = 0; while (cond) { __builtin_amdgcn_s_sleep(1); \
    if ((++_sp & 255u) == 0u) { if (xb_ld(&(bar)[XB_TMO])) break; if (_sp > XB_SPIN_CAP) { atomicAdd(&(bar)[XB_TMO], 1u); break; } } } } while (0)
struct XcdBarrier { unsigned* bar; unsigned x; volatile LAS unsigned* st; };
__device__ __forceinline__ XcdBarrier xcd_barrier_post(unsigned* bar, volatile LAS unsigned* st) {
    XcdBarrier b; b.bar = bar; b.x = xb_xcc_id(); b.st = st;
    if (threadIdx.x == 0) (void)xb_add(&bar[XB_XCNT(b.x)], 1u);
    return b;
}
__device__ __forceinline__ void xcd_barrier_complete(unsigned* bar, unsigned x, unsigned& nloc, unsigned& nx) {
    const unsigned G = gridDim.x * gridDim.y * gridDim.z;
    unsigned sum, cnt, mine, sp = 0u;
    for (;;) {
        sum = 0u; cnt = 0u; mine = 0u;
#pragma unroll
        for (unsigned j = 0; j < 16; ++j) { const unsigned c = xb_ld(&bar[XB_XCNT(j)]); sum += c; cnt += (c > 0u) ? 1u : 0u; mine = (j == x) ? c : mine; }
        if (sum == G) break;
        __builtin_amdgcn_s_sleep(1);
        if ((++sp & 255u) == 0u) { if (xb_ld(&bar[XB_TMO])) break; if (sp > XB_SPIN_CAP) { atomicAdd(&bar[XB_TMO], 1u); break; } }
    }
    nloc = mine > 0u ? mine : 1u; nx = cnt > 0u ? cnt : 1u;
}
__device__ __forceinline__ void xcd_barrier(const XcdBarrier& b) {
    asm volatile("s_waitcnt vmcnt(0)" ::: "memory");
    __syncthreads();
    if (threadIdx.x == 0) {
        unsigned* bar = b.bar;
        __builtin_amdgcn_s_waitcnt(0);
        unsigned nloc = b.st[0], nx = b.st[1];
        if (nloc == 0u) { xcd_barrier_complete(bar, b.x, nloc, nx); b.st[0] = nloc; b.st[1] = nx; }
        const unsigned old = xb_add(&bar[XB_XSUB(b.x)], 1u);
        const unsigned gen = old / nloc;
        if (old + 1u == (gen + 1u) * nloc) {
            __builtin_amdgcn_fence(__ATOMIC_RELEASE, "agent");
            asm volatile("s_waitcnt vmcnt(0)" ::: "memory");
            const unsigned og = xb_add(&bar[XB_TOP], 1u);
            const unsigned tg = og / nx;
            if (og + 1u == (tg + 1u) * nx) xb_add(&bar[XB_TOPGEN], 1u);
            else XB_SPIN(xb_ld(&bar[XB_TOPGEN]) == tg, bar);
            __builtin_amdgcn_fence(__ATOMIC_ACQUIRE, "agent");
            xb_add(&bar[XB_XGEN(b.x)], 1u);
            asm volatile("s_waitcnt vmcnt(0)" ::: "memory");
        } else {
            XB_SPIN(xb_ld(&bar[XB_XGEN(b.x)]) == gen, bar);
            __builtin_amdgcn_fence(__ATOMIC_ACQUIRE, "agent");
            asm volatile("s_waitcnt vmcnt(0)" ::: "memory");
        }
    }
    __syncthreads();
}

struct Frame {
    LAS unsigned char* lds;
    gu32* ctl;
    int tid, lane, wave, G, bid;
    unsigned char* ws;
    const float* x; const float* c; const float* w_ada; const float* b_ada;
    const float *pre_mix, *post_mix, *pre_ffn, *post_ffn;
    const float* w_in; const float* hg_lb; const float* hg_nw;
    const float *lq1, *lk1, *lq2, *lk2; const float* da_nw;
    const float *w_bhg, *w_bda, *w_out, *w_group, *b_group, *w_router, *b_router, *w_gate, *w_up, *w_down;
    float* out;
};
template <class Tp> __device__ __forceinline__ Tp* wsp(const Frame& F, size_t off) { return (Tp*)(F.ws + off); }

__device__ __forceinline__ void mod_vec(const Frame& F, LAS float* dst, int chunk, int batch) {
    const float* M = wsp<const float>(F, WS_MODF) + (batch * 6 + chunk) * DM;
    for (int j = F.tid; j < DM; j += NTHREADS) dst[j] = M[j];
}
constexpr int MODX = NB * 6 * DM;
__device__ __forceinline__ void ph_mod(Frame& F) {
    const int gt = F.bid * NTHREADS + F.tid, NGT = F.G * NTHREADS;
    const float* P = wsp<const float>(F, WS_P64); float* MF = wsp<float>(F, WS_MODF);
    for (int o = gt; o < NB * 6 * DM; o += NGT) {
        const int b = o / (6 * DM), col = o % (6 * DM);
        float s0 = 0.f, s1 = 0.f, s2 = 0.f, s3 = 0.f;
#pragma unroll 8
        for (int kc = 0; kc < 64; kc += 4) {
            s0 += P[(size_t)((kc + 0) * 8 + b) * (6 * DM) + col]; s1 += P[(size_t)((kc + 1) * 8 + b) * (6 * DM) + col];
            s2 += P[(size_t)((kc + 2) * 8 + b) * (6 * DM) + col]; s3 += P[(size_t)((kc + 3) * 8 + b) * (6 * DM) + col];
        }
        const float mv = F.b_ada[col] + ((s0 + s1) + (s2 + s3));
        MF[o] = mv;
        const int chunk = col / DM, cc = col % DM;
        if (chunk == 2) MF[MODX + (b * 2 + 0) * DM + cc] = mv * F.post_mix[cc];
        if (chunk == 4) MF[MODX + (b * 2 + 1) * DM + cc] = F.pre_ffn[cc] * (1.0f + mv);
    }
}

template <class Rows, class Epi>
__device__ __forceinline__ void sg_tile(LAS float* As, LAS float* Bs, const bf16* A, int lda, const Rows& rows, const float* B, int ldb, int n0, int K, const Epi& epi) {
    int tid = threadIdx.x; asm volatile("" : "+v"(tid));
    const int tx = tid & 15, ty = tid >> 4;
    float acc[4][8];
#pragma unroll
    for (int i = 0; i < 4; ++i)
#pragma unroll
        for (int j = 0; j < 8; ++j) acc[i][j] = 0.f;
    const int ar = tid >> 2, akq = tid & 3;
    const int arow = rows(ar);
    const bf16* ap = A + (size_t)(arow < 0 ? 0 : arow) * lda + akq * 4;
    const int bk = tid >> 5, bn = (tid & 31) * 4;
    const float* bp = B + (size_t)bk * ldb + n0 + bn;
    for (int k0 = 0; k0 < K; k0 += 16) {
        u32x2 av = *(const u32x2*)(ap + k0);
        const f32x4 bv = *(const f32x4*)(bp + (size_t)k0 * ldb);
        if (arow < 0) { av.x = 0u; av.y = 0u; }
        __syncthreads();
        As[(akq * 4 + 0) * 132 + ar] = bf2f(av.x & 0xffffu);
        As[(akq * 4 + 1) * 132 + ar] = bf2f(av.x >> 16);
        As[(akq * 4 + 2) * 132 + ar] = bf2f(av.y & 0xffffu);
        As[(akq * 4 + 3) * 132 + ar] = bf2f(av.y >> 16);
        *(LAS f32x4*)&Bs[bk * 132 + bn] = bv;
        __syncthreads();
#pragma unroll 2
        for (int kk = 0; kk < 16; ++kk) {
            const f32x4 a4 = *(const LAS f32x4*)&As[kk * 132 + ty * 4];
            const f32x4 b0 = *(const LAS f32x4*)&Bs[kk * 132 + tx * 8];
            const f32x4 b1 = *(const LAS f32x4*)&Bs[kk * 132 + tx * 8 + 4];
#pragma unroll
            for (int i = 0; i < 4; ++i) {
                acc[i][0] += a4[i] * b0[0]; acc[i][1] += a4[i] * b0[1]; acc[i][2] += a4[i] * b0[2]; acc[i][3] += a4[i] * b0[3];
                acc[i][4] += a4[i] * b1[0]; acc[i][5] += a4[i] * b1[1]; acc[i][6] += a4[i] * b1[2]; acc[i][7] += a4[i] * b1[3];
            }
        }
    }
#pragma unroll
    for (int i = 0; i < 4; ++i) epi(ty * 4 + i, n0 + tx * 8, acc[i]);
}
struct RowsDense { int m0; __device__ __forceinline__ int operator()(int r) const { return m0 + r; } };
struct RowsList { const int* list; int n; __device__ __forceinline__ int operator()(int r) const { return r < n ? list[r] : -1; } };

__device__ __forceinline__ void store8_bf16(bf16* p, const float (&v)[8]) {
    u32x4 w; w.x = pk2(v[0], v[1]); w.y = pk2(v[2], v[3]); w.z = pk2(v[4], v[5]); w.w = pk2(v[6], v[7]);
    *(u32x4*)p = w;
}

__device__ __forceinline__ void proj_store8(const Frame& F, int row, int col0, const float (&vin)[8], int pxor) {
    const int sec = col0 >> 10;
    float v[8];
#pragma unroll
    for (int i = 0; i < 8; ++i) v[i] = vin[i];
    if (sec == 0) {
#pragma unroll
        for (int i = 0; i < 8; ++i) v[i] = v[i] * sigmoidf_(v[i]);
        store8_bf16(wsp<bf16>(F, WS_QHG) + (size_t)row * HW + col0, v);
    } else if (sec == 1) {
        const int j = col0 - 1024; const float* lb = wsp<const float>(F, WS_LB) + j;
        float* o = wsp<float>(F, WS_LOGF) + (size_t)row * HW + j;
        f32x4 o0, o1;
#pragma unroll
        for (int i = 0; i < 8; ++i) { const float l = lb[i]; const float f = l + (1.0f - l) * sigmoidf_(v[i]); const float lf = __logf(f); if (i < 4) o0[i] = lf; else o1[i - 4] = lf; }
        *(f32x4*)o = o0; *(f32x4*)(o + 4) = o1;
    } else if (sec == 2) {
        store8_bf16(wsp<bf16>(F, WS_VHG) + (size_t)row * HW + (col0 - 2048), v);
    } else if (sec == 3) {
#pragma unroll
        for (int i = 0; i < 8; ++i) v[i] = sigmoidf_(v[i]);
        store8_bf16(wsp<bf16>(F, WS_GHG) + (size_t)row * HW + (col0 - 3072), v);
    } else if (sec == 4 || sec == 5) {
        const int d0 = col0 & 63;
        float pv[8];
#pragma unroll
        for (int i = 0; i < 8; ++i) pv[i] = __shfl_xor(v[i], pxor);
        if (d0 < 16) {
            const float* rt = wsp<const float>(F, WS_ROPE) + (size_t)(row & (SEQ - 1)) * 16;
            const f32x4 c0 = *(const f32x4*)rt, c1 = *(const f32x4*)(rt + 4), s0 = *(const f32x4*)(rt + 8), s1 = *(const f32x4*)(rt + 12);
            const float sg = (d0 == 0) ? -1.0f : 1.0f;
#pragma unroll
            for (int i = 0; i < 8; ++i) { const float cs = i < 4 ? c0[i] : c1[i - 4], sn = i < 4 ? s0[i] : s1[i - 4]; v[i] = v[i] * cs + sg * pv[i] * sn; }
        }
        if (sec == 4) {
#pragma unroll
            for (int i = 0; i < 8; ++i) v[i] *= QSCALE;
            store8_bf16(wsp<bf16>(F, WS_QDA) + (size_t)row * HW + (col0 - 4096), v);
        } else store8_bf16(wsp<bf16>(F, WS_KDA) + (size_t)row * HW + (col0 - 5120), v);
    } else if (sec == 6) {
        store8_bf16(wsp<bf16>(F, WS_VDA) + (size_t)row * HW + (col0 - 6144), v);
    } else {
#pragma unroll
        for (int i = 0; i < 8; ++i) v[i] = sigmoidf_(v[i]);
        if (sec < 9) store8_bf16(wsp<bf16>(F, WS_GATEH) + (size_t)row * DM + (col0 - 7168), v);
        else store8_bf16(wsp<bf16>(F, WS_GATED) + (size_t)row * DM + (col0 - 9216), v);
    }
}


constexpr float Y8S = 8.0f, Y8I = 1.0f / 8.0f;
constexpr float W8S = 64.0f, W8I = 1.0f / 64.0f;
__device__ __forceinline__ unsigned pk4_fp8(float a, float b, float c, float d) { const int p = __builtin_amdgcn_cvt_pk_fp8_f32(a, b, 0, false); return (unsigned)__builtin_amdgcn_cvt_pk_fp8_f32(c, d, p, true); }
__device__ __forceinline__ float clamp8(float v) { return __builtin_amdgcn_fmed3f(v, -448.0f, 448.0f); }
namespace fg {
typedef short bf16x8 __attribute__((ext_vector_type(8)));
constexpr int BM = 256, BK = 64, HALF = 128, HTB = HALF * BK * 2, STAGE_BYTES = 8 * HTB, NXCD = 8, WGM = 8;
__device__ __forceinline__ int lds_byte(int r, int c) { const int st = (r >> 4) * 2 + (c >> 5), rr = r & 15, cc = c & 31, ob = rr * 64 + cc * 2; return st * 1024 + (ob ^ (((ob >> 9) & 1) << 5)); }
__device__ __forceinline__ void stage_rc(int b, int& R, int& C) { const int st = b / 1024, sb = b % 1024, swz = sb ^ (((sb >> 9) & 1) << 5); R = (st >> 1) * 16 + swz / 64; C = (st & 1) * 32 + (swz % 64) / 2; }
__device__ __forceinline__ int perm32(int rho) { const int n = rho >> 4, i = rho & 15; return 8 * (i >> 2) + 4 * n + (i & 3); }
struct Unit { int pm, pn, e, nvalid, slot0; };
typedef int i32x8 __attribute__((ext_vector_type(8)));
typedef short s16x16 __attribute__((ext_vector_type(16)));
__device__ __forceinline__ i32x8 cat16(bf16x8 a, bf16x8 b) { const s16x16 v = __builtin_shufflevector(a, b, 0, 1, 2, 3, 4, 5, 6, 7, 8, 9, 10, 11, 12, 13, 14, 15); return __builtin_bit_cast(i32x8, v); }
__device__ __forceinline__ unsigned cvt_pk_bf16(float lo, float hi) { unsigned r; asm volatile("v_cvt_pk_bf16_f32 %0, %1, %2" : "=v"(r) : "v"(lo), "v"(hi)); return r; }

template <bool FP8_ = false> struct DenseOrderT {
    int nM, nN, nwg, G, c; const char* A; const char* Bt; int K;
    __device__ __forceinline__ void init(const void* A_, const void* Bt_, int M, int N, int K_, int G_, int c_) { A = (const char*)A_; Bt = (const char*)Bt_; K = K_; nM = M / BM; nN = N / BM; nwg = nM * nN; G = G_; c = c_; }
    __device__ __forceinline__ bool next(int i, Unit& u) const {
        const long L = (long)i * G + c; if (L >= nwg) return false;
        int wgid = (int)L; { const int q = nwg / NXCD, r = nwg % NXCD, xcd = wgid % NXCD, off = wgid / NXCD; wgid = (xcd < r ? xcd * (q + 1) : r * (q + 1) + (xcd - r) * q) + off; }
        const int nig = WGM * nN, gid = wgid / nig, fm = gid * WGM, gsz = (nM - fm) < WGM ? (nM - fm) : WGM;
        u.pm = fm + ((wgid % nig) % gsz); u.pn = (wgid % nig) / gsz; u.e = 0; u.nvalid = BM; u.slot0 = u.pm * BM; return true;
    }
    static constexpr bool GATHER = FP8_, FP8 = FP8_;
    __device__ __forceinline__ const char* a_ptr(const Unit& u) const { return GATHER ? A : A + (size_t)u.pm * BM * K * 2; }
    __device__ __forceinline__ int a_row(const Unit& u, int r) const { return u.pm * BM + r; }
    __device__ __forceinline__ const char* b_ptr(const Unit& u) const { return Bt + (size_t)u.pn * BM * K * 2; }
};

typedef DenseOrderT<false> DenseOrder;
template <class Epi, class Sched>
__device__ __forceinline__ void gemm_phase(LAS unsigned char* lds, const int K, const Sched& S, const Epi& E) {
    int tid = threadIdx.x; asm volatile("" : "+v"(tid));
    const int wid = __builtin_amdgcn_readfirstlane(tid >> 6), lane = tid & 63, wr = wid >> 2, wc = wid & 3, fr = lane & 15, fq = lane >> 4;
    const int nt = K / BK;
    constexpr bool GA = Sched::GATHER;
    int RA[2]; unsigned voffA[2], voffB[2];
#pragma unroll
    for (int i = 0; i < 2; ++i) { int R, C; stage_rc(tid * 16 + i * 8192, R, C); const int Rb = Epi::PERM ? ((R & ~31) + perm32(R & 31)) : R;
        RA[i] = R; voffA[i] = GA ? (unsigned)C * 2u : (unsigned)(R * K + C) * 2u; voffB[i] = (unsigned)(Rb * K + C) * 2u; }
    const size_t kstep = (size_t)(BK * 2);
    const size_t hstep = (size_t)HALF * K * 2;
    const unsigned ldsw = (unsigned)wid * 1024u;
    const int aoff = lds_byte(wr * 64 + fr, fq * 8), boff = lds_byte(wc * 32 + fr, fq * 8);
    const unsigned rowb = (unsigned)K * 2u;
#define PG8_SA(b, h) (((b) * 2 + (h)) * HTB)
#define PG8_SB(b, h) ((4 + (b) * 2 + (h)) * HTB)
#define PG8_STAGE(bufoff, gbase, voff) do { _Pragma("unroll") for (int _i = 0; _i < 2; ++_i) \
        __builtin_amdgcn_global_load_lds((const unsigned*)((const char*)(gbase) + (voff)[_i]), (LAS unsigned*)(lds + (bufoff) + ldsw + _i * 8192), 16, 0, 0); } while (0)
#define PG8_STAGE_A(bufoff, h, kb) do { if constexpr (GA) { PG8_STAGE(bufoff, cA + (kb), oc[h]); } else { PG8_STAGE(bufoff, cA + (kb) + (h) * hstep, voffA); } } while (0)
#define PG8_LDA(dst, b, h) do { if constexpr (Sched::FP8) { _Pragma("unroll") for (int m = 0; m < 4; ++m) dst##8[m] = cat16(*(const LAS bf16x8*)(lds + PG8_SA(b, h) + aoff + m * 2048), *(const LAS bf16x8*)(lds + PG8_SA(b, h) + aoff + m * 2048 + 1024)); } \
        else { _Pragma("unroll") for (int m = 0; m < 4; ++m) _Pragma("unroll") for (int k = 0; k < 2; ++k) dst[m][k] = *(const LAS bf16x8*)(lds + PG8_SA(b, h) + aoff + m * 2048 + k * 1024); } } while (0)
#define PG8_LDB(dst, b, h) do { if constexpr (Sched::FP8) { _Pragma("unroll") for (int n = 0; n < 2; ++n) dst##8[n] = cat16(*(const LAS bf16x8*)(lds + PG8_SB(b, h) + boff + n * 2048), *(const LAS bf16x8*)(lds + PG8_SB(b, h) + boff + n * 2048 + 1024)); } \
        else { _Pragma("unroll") for (int n = 0; n < 2; ++n) _Pragma("unroll") for (int k = 0; k < 2; ++k) dst[n][k] = *(const LAS bf16x8*)(lds + PG8_SB(b, h) + boff + n * 2048 + k * 1024); } } while (0)
#define PG8_MMA(ai, bj, At, Bt) do { __builtin_amdgcn_s_setprio(1); _Pragma("unroll") for (int m = 0; m < 4; ++m) _Pragma("unroll") for (int n = 0; n < 2; ++n) { \
        if constexpr (Sched::FP8) acc[ai][bj][m][n] = __builtin_amdgcn_mfma_scale_f32_16x16x128_f8f6f4(Bt##8[n], At##8[m], acc[ai][bj][m][n], 0, 0, 0, 0, 0, 0); \
        else { _Pragma("unroll") for (int k = 0; k < 2; ++k) acc[ai][bj][m][n] = __builtin_amdgcn_mfma_f32_16x16x32_bf16(Bt[n][k], At[m][k], acc[ai][bj][m][n], 0, 0, 0); } } \
        __builtin_amdgcn_s_setprio(0); } while (0)
#define PG8_WAIT_V(n) asm volatile("s_waitcnt vmcnt(" #n ")" ::: "memory")
#define PG8_WAIT_L(n) asm volatile("s_waitcnt lgkmcnt(" #n ")" ::: "memory")
#define PG8_BAR __builtin_amdgcn_s_barrier()
#define PG8_SCHED __builtin_amdgcn_sched_barrier(0)
#define PG8_AOFFS(dst, u) do { _Pragma("unroll") for (int _h = 0; _h < 2; ++_h) _Pragma("unroll") for (int _i = 0; _i < 2; ++_i) dst[_h][_i] = (unsigned)S.a_row(u, _h * HALF + RA[_i]) * rowb + voffA[_i]; } while (0)
    Unit cur, nxt; int ui = 0;
    if (!S.next(0, cur)) return;
    f32x4 acc[2][2][4][2];
#pragma unroll
    for (int a = 0; a < 2; ++a)
#pragma unroll
        for (int b = 0; b < 2; ++b)
#pragma unroll
            for (int m = 0; m < 4; ++m)
#pragma unroll
                for (int n = 0; n < 2; ++n) acc[a][b][m][n] = (f32x4){0.f, 0.f, 0.f, 0.f};
    bf16x8 At[4][2], B0[2][2], B1[2][2];
    i32x8 At8[4], B08[2], B18[2];
    unsigned oc[2][2] = {{0u, 0u}, {0u, 0u}}, on[2][2] = {{0u, 0u}, {0u, 0u}};
    const char* cA = S.a_ptr(cur); const char* cB = S.b_ptr(cur);
    if constexpr (GA) PG8_AOFFS(oc, cur);
    PG8_STAGE(PG8_SB(0, 0), cB, voffB); PG8_STAGE(PG8_SB(0, 1), cB + hstep, voffB); PG8_STAGE_A(PG8_SA(0, 0), 0, 0); PG8_STAGE_A(PG8_SA(0, 1), 1, 0);
    if (wr == 1) PG8_BAR;
    PG8_WAIT_V(2); PG8_BAR;
    PG8_STAGE(PG8_SB(1, 0), cB + kstep, voffB); PG8_STAGE_A(PG8_SA(1, 0), 0, kstep); PG8_STAGE(PG8_SB(1, 1), cB + hstep + kstep, voffB);
    PG8_WAIT_V(6); PG8_BAR;
    for (;;) {
        const bool has_next = S.next(ui + 1, nxt);
        const char* nA = cA; const char* nB = cB;
        if (has_next) { nA = S.a_ptr(nxt); nB = S.b_ptr(nxt); if constexpr (GA) PG8_AOFFS(on, nxt); }
        else if constexpr (GA) {
#pragma unroll
            for (int _h = 0; _h < 2; ++_h)
#pragma unroll
                for (int _i = 0; _i < 2; ++_i) on[_h][_i] = oc[_h][_i];
        }
#pragma unroll 1
        for (int t = 0; t < nt; t += 2) {
            const bool last = (t == nt - 2);
            if constexpr (Epi::MID) { if (t == (nt >> 1)) E.mid(acc, cur, wr, wc, fr, fq); }
            PG8_LDB(B0, 0, 0); PG8_LDB(B1, 0, 1); PG8_SCHED; PG8_LDA(At, 0, 0); PG8_STAGE_A(PG8_SA(1, 1), 1, (size_t)(t + 1) * kstep);
            if (last) {
                cA = nA; cB = nB;
                if constexpr (GA) {
#pragma unroll
                    for (int _h = 0; _h < 2; ++_h)
#pragma unroll
                        for (int _i = 0; _i < 2; ++_i) oc[_h][_i] = on[_h][_i];
                }
            }
            const size_t k2 = last ? (size_t)0 : (size_t)(t + 2) * kstep, k3 = k2 + kstep;
            PG8_WAIT_V(8); PG8_WAIT_L(0); PG8_BAR; PG8_MMA(0, 0, At, B0); PG8_MMA(0, 1, At, B1); PG8_BAR; PG8_SCHED;
            PG8_LDA(At, 0, 1); PG8_STAGE(PG8_SB(0, 0), cB + k2, voffB); PG8_STAGE(PG8_SB(0, 1), cB + k2 + hstep, voffB); PG8_STAGE_A(PG8_SA(0, 0), 0, k2);
            PG8_WAIT_V(8); PG8_WAIT_L(0); PG8_BAR; PG8_MMA(1, 0, At, B0); PG8_MMA(1, 1, At, B1); PG8_BAR; PG8_SCHED;
            PG8_LDB(B0, 1, 0); PG8_LDB(B1, 1, 1); PG8_SCHED; PG8_LDA(At, 1, 0); PG8_STAGE_A(PG8_SA(0, 1), 1, k2);
            PG8_WAIT_V(8); PG8_WAIT_L(0); PG8_BAR; PG8_MMA(0, 0, At, B0); PG8_MMA(0, 1, At, B1); PG8_BAR; PG8_SCHED;
            PG8_LDA(At, 1, 1); PG8_STAGE(PG8_SB(1, 0), cB + k3, voffB); PG8_STAGE(PG8_SB(1, 1), cB + k3 + hstep, voffB); PG8_STAGE_A(PG8_SA(1, 0), 0, k3);
            PG8_WAIT_V(8); PG8_WAIT_L(0); PG8_BAR; PG8_MMA(1, 0, At, B0); PG8_MMA(1, 1, At, B1); PG8_BAR; PG8_SCHED;
        }
        if (wr == 0) PG8_BAR;
        E(acc, cur, wr, wc, fr, fq);
        if (!has_next) break;
#pragma unroll
        for (int a = 0; a < 2; ++a)
#pragma unroll
            for (int b = 0; b < 2; ++b)
#pragma unroll
                for (int m = 0; m < 4; ++m)
#pragma unroll
                    for (int n = 0; n < 2; ++n) acc[a][b][m][n] = (f32x4){0.f, 0.f, 0.f, 0.f};
        cur = nxt; ++ui;
        if (wr == 1) PG8_BAR;
    }
    PG8_WAIT_V(0);
    PG8_BAR;
#undef PG8_SA
#undef PG8_SB
#undef PG8_STAGE
#undef PG8_STAGE_A
#undef PG8_LDA
#undef PG8_LDB
#undef PG8_MMA
#undef PG8_WAIT_V
#undef PG8_WAIT_L
#undef PG8_BAR
#undef PG8_SCHED
#undef PG8_AOFFS
}
}

template <bool F8 = false>
__device__ __forceinline__ void transpose_item(const float* W, int K, int N, bf16* WT, int k0, int n0, int drow, LAS float* scr, int lane, int ldt = 0, int kd0 = 0) {
    if (ldt == 0) ldt = K;
    float tv[32];
#pragma unroll
    for (int i = 0; i < 32; ++i) tv[i] = W[(size_t)(k0 + 2 * i + (lane >> 5)) * N + n0 + (lane & 31)];
#pragma unroll
    for (int i = 0; i < 32; ++i) scr[(2 * i + (lane >> 5)) * 33 + (lane & 31)] = tv[i];
    asm volatile("s_waitcnt lgkmcnt(0)" ::: "memory");
    const int c = lane & 7;
#pragma unroll
    for (int j = 0; j < 4; ++j) { const int n = (lane >> 3) + 8 * j; const LAS float* sp = scr + (8 * c) * 33 + n;
        if constexpr (F8) { u32x2 o; o.x = pk4_fp8(sp[0 * 33] * W8S, sp[1 * 33] * W8S, sp[2 * 33] * W8S, sp[3 * 33] * W8S); o.y = pk4_fp8(sp[4 * 33] * W8S, sp[5 * 33] * W8S, sp[6 * 33] * W8S, sp[7 * 33] * W8S);
            *(u32x2*)((unsigned char*)WT + (size_t)(drow + n) * ldt + kd0 + k0 + 8 * c) = o; }
        else { u32x4 o; o.x = pk2(sp[0 * 33], sp[1 * 33]); o.y = pk2(sp[2 * 33], sp[3 * 33]); o.z = pk2(sp[4 * 33], sp[5 * 33]); o.w = pk2(sp[6 * 33], sp[7 * 33]);
            *(u32x4*)(WT + (size_t)(drow + n) * ldt + kd0 + k0 + 8 * c) = o; } }
    asm volatile("s_waitcnt lgkmcnt(0)" ::: "memory");
}

__device__ __forceinline__ void transpose_item2(const float* W, int K, int N, bf16* WT, int k0, int n0a, int drowa, int n0b, int drowb, LAS float* scr, int lane) {
    float ta[32], tb[32];
#pragma unroll
    for (int i = 0; i < 32; ++i) ta[i] = W[(size_t)(k0 + 2 * i + (lane >> 5)) * N + n0a + (lane & 31)];
#pragma unroll
    for (int i = 0; i < 32; ++i) tb[i] = W[(size_t)(k0 + 2 * i + (lane >> 5)) * N + n0b + (lane & 31)];
    const int c = lane & 7;
#pragma unroll
    for (int i = 0; i < 32; ++i) scr[(2 * i + (lane >> 5)) * 33 + (lane & 31)] = ta[i];
    asm volatile("s_waitcnt lgkmcnt(0)" ::: "memory");
#pragma unroll
    for (int j = 0; j < 4; ++j) { const int n = (lane >> 3) + 8 * j; const LAS float* sp = scr + (8 * c) * 33 + n;
        u32x4 o; o.x = pk2(sp[0 * 33], sp[1 * 33]); o.y = pk2(sp[2 * 33], sp[3 * 33]); o.z = pk2(sp[4 * 33], sp[5 * 33]); o.w = pk2(sp[6 * 33], sp[7 * 33]);
        *(u32x4*)(WT + (size_t)(drowa + n) * K + k0 + 8 * c) = o; }
    asm volatile("s_waitcnt lgkmcnt(0)" ::: "memory");
#pragma unroll
    for (int i = 0; i < 32; ++i) scr[(2 * i + (lane >> 5)) * 33 + (lane & 31)] = tb[i];
    asm volatile("s_waitcnt lgkmcnt(0)" ::: "memory");
#pragma unroll
    for (int j = 0; j < 4; ++j) { const int n = (lane >> 3) + 8 * j; const LAS float* sp = scr + (8 * c) * 33 + n;
        u32x4 o; o.x = pk2(sp[0 * 33], sp[1 * 33]); o.y = pk2(sp[2 * 33], sp[3 * 33]); o.z = pk2(sp[4 * 33], sp[5 * 33]); o.w = pk2(sp[6 * 33], sp[7 * 33]);
        *(u32x4*)(WT + (size_t)(drowb + n) * K + k0 + 8 * c) = o; }
    asm volatile("s_waitcnt lgkmcnt(0)" ::: "memory");
}

__device__ __forceinline__ void ph_prologue(Frame& F) {
    const int gw = F.bid * NWAVES + F.wave, NGW = F.G * NWAVES;
    LAS float* SC = (LAS float*)(F.lds + 8 * 8704);
    for (int i = F.tid; i < NB * DM; i += NTHREADS) { const float cv = F.c[i]; SC[i] = cv * sigmoidf_(cv); }
    __syncthreads();
    float* P = wsp<float>(F, WS_P64);
    for (int it = gw; it < 48 * 64; it += NGW) {
        const int cb = it % 48, kc = it / 48;
        f32x4 acc[8];
#pragma unroll
        for (int b = 0; b < 8; ++b) acc[b] = (f32x4){0.f, 0.f, 0.f, 0.f};
        const float* wp = F.w_ada + (size_t)(kc * 32) * (6 * DM) + cb * 256 + F.lane * 4;
        const LAS float* cp = SC + kc * 32;
#pragma unroll 1
        for (int k0 = 0; k0 < 32; k0 += 8) {
            f32x4 w[8];
#pragma unroll
            for (int k = 0; k < 8; ++k) w[k] = *(const f32x4*)(wp + (size_t)(k0 + k) * (6 * DM));
#pragma unroll
            for (int k = 0; k < 8; ++k)
#pragma unroll
                for (int b = 0; b < 8; ++b) acc[b] += w[k] * cp[b * DM + k0 + k];
        }
#pragma unroll
        for (int b = 0; b < 8; ++b) *(f32x4*)(P + (size_t)(kc * 8 + b) * (6 * DM) + cb * 256 + F.lane * 4) = acc[b];
    }
    const int gt = F.bid * NTHREADS + F.tid, NGT = F.G * NTHREADS;
    float* rope = wsp<float>(F, WS_ROPE);
    for (int i = gt; i < SEQ * 8; i += NGT) {
        const int pos = i >> 3, j = i & 7;
        const float invf = powf(500000.0f, -(float)(2 * j) / 16.0f);
        const float ang = (float)pos * invf;
        float sn, cs; sincosf(ang, &sn, &cs);
        rope[pos * 16 + j] = cs; rope[pos * 16 + 8 + j] = sn;
    }
    bf16* wch = wsp<bf16>(F, WS_WCAT); bf16* wcl = wch + 48 * DM;
    for (int i = gt; i < DM * 48; i += NGT) { const int c = i / DM, k = i % DM; const float v = c < 4 ? F.w_group[k * 4 + c] : (c < 36 ? F.w_router[k * 32 + c - 4] : 0.f);
        const unsigned hi = f2bf(v); wch[i] = (bf16)hi; wcl[i] = (bf16)f2bf(v - bf2f(hi)); }
    float* lb = wsp<float>(F, WS_LB);
    for (int i = gt; i < HW; i += NGT) { const float p0 = F.hg_lb[i], p1 = F.hg_lb[HW + i]; lb[i] = 1.0f / (1.0f + __expf(p1 - p0)); }
    if (F.bid == 0 && F.wave == 0) {
        const float a = wave_sum(F.lq1[F.lane] * F.lk1[F.lane]), b = wave_sum(F.lq2[F.lane] * F.lk2[F.lane]);
        if (F.lane == 0) *wsp<float>(F, WS_LAM) = __expf(a) - __expf(b) + LAMBDA_INIT;
    }
}

__device__ __forceinline__ void ph_h1(Frame& F) {
    LAS float* Lsh = (LAS float*)F.lds; LAS float* Lsc = Lsh + DM;
    bf16* H1 = wsp<bf16>(F, WS_H1);
    for (int rb = F.bid; rb < T / 64; rb += F.G) {
        const int batch = (rb * 64) / SEQ;
        __syncthreads(); mod_vec(F, Lsh, 0, batch); mod_vec(F, Lsc, 1, batch); __syncthreads();
#pragma unroll 1
        for (int half = 0; half < 2; ++half) {
            const int row0 = rb * 64 + F.wave * 8 + half * 4;
            f32x4 v[4][8];
#pragma unroll
            for (int r = 0; r < 4; ++r)
#pragma unroll
                for (int j = 0; j < 8; ++j) v[r][j] = *(const f32x4*)(F.x + (size_t)(row0 + r) * DM + 4 * F.lane + 256 * j);
            f32x4 wv[8];
#pragma unroll
            for (int j = 0; j < 8; ++j) wv[j] = *(const f32x4*)(F.pre_mix + 4 * F.lane + 256 * j);
#pragma unroll
            for (int r = 0; r < 4; ++r) {
                float s = 0.f;
#pragma unroll
                for (int j = 0; j < 8; ++j) s += (v[r][j][0] * v[r][j][0] + v[r][j][1] * v[r][j][1]) + (v[r][j][2] * v[r][j][2] + v[r][j][3] * v[r][j][3]);
                const float rstd = 1.0f / sqrtf(wave_sum(s) * (1.0f / DM) + EPS);
#pragma unroll
                for (int j = 0; j < 8; ++j) {
                    const int c0 = 4 * F.lane + 256 * j;
                    const f32x4 w = wv[j];
                    const f32x4 sc = *(const LAS f32x4*)(Lsc + c0), sh = *(const LAS f32x4*)(Lsh + c0);
                    const f32x4 h = v[r][j] * rstd * w * (sc + 1.0f) + sh;
#if PROJ_FP8
                    *(unsigned*)((unsigned char*)H1 + (size_t)(row0 + r) * DM + c0) = pk4_fp8(clamp8(h[0]), clamp8(h[1]), clamp8(h[2]), clamp8(h[3]));
#else
                    u32x2 o; o.x = pk2(h[0], h[1]); o.y = pk2(h[2], h[3]);
                    *(u32x2*)(H1 + (size_t)(row0 + r) * DM + c0) = o;
#endif
                }
            }
        }
    }
}

struct EpiProj { const Frame* F; int m0; __device__ __forceinline__ void operator()(int r, int col0, const float (&v)[8]) const { proj_store8(*F, m0 + r, col0, v, 1); } };
__device__ __forceinline__ void ph_proj_simple(Frame& F) {
    LAS float* As = (LAS float*)F.lds; LAS float* Bs = As + 16 * 132;
    const int NT_ = INC / 128, MT_ = T / 128;
    for (int t = F.bid; t < NT_ * MT_; t += F.G) {
        const int mt = t / NT_, nt = t % NT_;
        RowsDense rows{mt * 128}; EpiProj epi{&F, mt * 128};
        sg_tile(As, Bs, wsp<const bf16>(F, WS_H1), DM, rows, F.w_in, INC, nt * 128, DM, epi);
    }
}

__device__ __forceinline__ void hgrn_chain_simple(Frame& F, int ch) {
    const int b = ch >> 3, h = ch & 7;
    LAS float* Qs = (LAS float*)F.lds;
    LAS float* Fs = Qs + 16 * 128;
    LAS float* Vs = Fs + 16 * 128;
    LAS float* Gs = Vs + 16 * 128;
    LAS float* Po = Gs + 16 * 128;
    LAS float* Red = Po + 2 * 4 * 128;
    const int v = F.tid & 127, kg = F.tid >> 7;
    float S[32];
#pragma unroll
    for (int i = 0; i < 32; ++i) S[i] = 0.f;
    const bf16* QHG = wsp<const bf16>(F, WS_QHG); const float* LOGF = wsp<const float>(F, WS_LOGF);
    const bf16* VHG = wsp<const bf16>(F, WS_VHG); const bf16* GHG = wsp<const bf16>(F, WS_GHG);
    bf16* YHG = wsp<bf16>(F, WS_YHG);
    const float nw = F.hg_nw[h * HD + v];
    const int lt = F.tid >> 5, lc = (F.tid & 31) * 4;
    for (int t0 = 0; t0 < SEQ; t0 += 16) {
        __syncthreads();
        {
            const size_t off = (size_t)(b * SEQ + t0 + lt) * HW + h * HD + lc;
            const u32x2 q = *(const u32x2*)(QHG + off), vv = *(const u32x2*)(VHG + off), g = *(const u32x2*)(GHG + off);
            const f32x4 lf = *(const f32x4*)(LOGF + off);
            LAS float* d = Qs + lt * 128 + lc; d[0] = bf2f(q.x & 0xffffu); d[1] = bf2f(q.x >> 16); d[2] = bf2f(q.y & 0xffffu); d[3] = bf2f(q.y >> 16);
            d = Vs + lt * 128 + lc; d[0] = bf2f(vv.x & 0xffffu); d[1] = bf2f(vv.x >> 16); d[2] = bf2f(vv.y & 0xffffu); d[3] = bf2f(vv.y >> 16);
            d = Gs + lt * 128 + lc; d[0] = bf2f(g.x & 0xffffu); d[1] = bf2f(g.x >> 16); d[2] = bf2f(g.y & 0xffffu); d[3] = bf2f(g.y >> 16);
            d = Fs + lt * 128 + lc; d[0] = __expf(lf[0]); d[1] = __expf(lf[1]); d[2] = __expf(lf[2]); d[3] = __expf(lf[3]);
        }
        __syncthreads();
        for (int tt = 0; tt < 16; ++tt) {
            const int p = tt & 1;
            const float vv = Vs[tt * 128 + v];
            float part = 0.f;
#pragma unroll
            for (int i = 0; i < 32; ++i) {
                const float f = Fs[tt * 128 + kg * 32 + i], q = Qs[tt * 128 + kg * 32 + i];
                S[i] = f * S[i] + (1.0f - f) * vv;
                part += q * S[i];
            }
            Po[(p * 4 + kg) * 128 + v] = part;
            __syncthreads();
            float o = 0.f;
            if (F.tid < 128) {
                o = (Po[(p * 4 + 0) * 128 + v] + Po[(p * 4 + 1) * 128 + v]) + (Po[(p * 4 + 2) * 128 + v] + Po[(p * 4 + 3) * 128 + v]);
                const float sq = wave_sum(o * o);
                if (F.lane == 0) Red[p * 2 + F.wave] = sq;
            }
            __syncthreads();
            if (F.tid < 128) {
                const float tot = Red[p * 2] + Red[p * 2 + 1];
                const float y = o * (1.0f / sqrtf(tot * (1.0f / HD) + EPS)) * nw * Gs[tt * 128 + v];
                YHG[(size_t)(b * SEQ + t0 + tt) * DM + h * HD + v] = (bf16)f2bf(y);
            }
        }
    }
}

__device__ __forceinline__ void attn_unit_simple(Frame& F, int b, int h, int c) {
    LAS float* Q1 = (LAS float*)F.lds; LAS float* Q2 = Q1 + 64 * 65; LAS float* K1 = Q2 + 64 * 65; LAS float* K2 = K1 + 64 * 65;
    LAS float* Vt = K2 + 64 * 65; LAS float* P1 = Vt + 64 * 132; LAS float* P2 = P1 + 64 * 65;
    const bf16* QDA = wsp<const bf16>(F, WS_QDA); const bf16* KDA = wsp<const bf16>(F, WS_KDA); const bf16* VDA = wsp<const bf16>(F, WS_VDA);
    const int r = F.tid >> 3, p = F.tid & 7;
    const int lr = F.tid >> 3, lc = (F.tid & 7) * 16;
    __syncthreads();
    {
        const bf16* src = QDA + (size_t)(b * SEQ + c * 64 + lr) * HW + h * HD + lc;
        const u32x4 a0 = *(const u32x4*)src, a1 = *(const u32x4*)(src + 8);
        LAS float* d = (lc < 64 ? Q1 + lr * 65 + lc : Q2 + lr * 65 + (lc - 64));
        const unsigned w[8] = {a0.x, a0.y, a0.z, a0.w, a1.x, a1.y, a1.z, a1.w};
#pragma unroll
        for (int i = 0; i < 8; ++i) { d[2 * i] = bf2f(w[i] & 0xffffu); d[2 * i + 1] = bf2f(w[i] >> 16); }
    }
    float m1 = -INFINITY, l1 = 0.f, m2 = -INFINITY, l2 = 0.f;
    float O1[16], O2[16];
#pragma unroll
    for (int i = 0; i < 16; ++i) { O1[i] = 0.f; O2[i] = 0.f; }
    for (int kt = 0; kt <= c; ++kt) {
        __syncthreads();
        {
            const size_t ro = (size_t)(b * SEQ + kt * 64 + lr) * HW + h * HD + lc;
            const u32x4 a0 = *(const u32x4*)(KDA + ro), a1 = *(const u32x4*)(KDA + ro + 8);
            const u32x4 b0 = *(const u32x4*)(VDA + ro), b1 = *(const u32x4*)(VDA + ro + 8);
            LAS float* d = (lc < 64 ? K1 + lr * 65 + lc : K2 + lr * 65 + (lc - 64));
            const unsigned w[8] = {a0.x, a0.y, a0.z, a0.w, a1.x, a1.y, a1.z, a1.w};
#pragma unroll
            for (int i = 0; i < 8; ++i) { d[2 * i] = bf2f(w[i] & 0xffffu); d[2 * i + 1] = bf2f(w[i] >> 16); }
            LAS float* dv = Vt + lr * 132 + lc;
            const unsigned wv[8] = {b0.x, b0.y, b0.z, b0.w, b1.x, b1.y, b1.z, b1.w};
#pragma unroll
            for (int i = 0; i < 8; ++i) { dv[2 * i] = bf2f(wv[i] & 0xffffu); dv[2 * i + 1] = bf2f(wv[i] >> 16); }
        }
        __syncthreads();
        float s1[8], s2[8];
#pragma unroll
        for (int j = 0; j < 8; ++j) { s1[j] = 0.f; s2[j] = 0.f; }
        for (int d = 0; d < 64; ++d) {
            const float q1 = Q1[r * 65 + d], q2 = Q2[r * 65 + d];
#pragma unroll
            for (int j = 0; j < 8; ++j) { s1[j] += q1 * K1[(p * 8 + j) * 65 + d]; s2[j] += q2 * K2[(p * 8 + j) * 65 + d]; }
        }
        float mx1 = s1[0], mx2 = s2[0];
#pragma unroll
        for (int j = 1; j < 8; ++j) { mx1 = fmaxf(mx1, s1[j]); mx2 = fmaxf(mx2, s2[j]); }
#pragma unroll
        for (int o = 1; o < 8; o <<= 1) { mx1 = fmaxf(mx1, __shfl_xor(mx1, o)); mx2 = fmaxf(mx2, __shfl_xor(mx2, o)); }
        const float mn1 = fmaxf(m1, mx1), mn2 = fmaxf(m2, mx2);
        const float al1 = exp2f(m1 - mn1), al2 = exp2f(m2 - mn2);
        float rs1 = 0.f, rs2 = 0.f;
#pragma unroll
        for (int j = 0; j < 8; ++j) { const float e1 = exp2f(s1[j] - mn1), e2 = exp2f(s2[j] - mn2); rs1 += e1; rs2 += e2; P1[r * 65 + p * 8 + j] = e1; P2[r * 65 + p * 8 + j] = e2; }
#pragma unroll
        for (int o = 1; o < 8; o <<= 1) { rs1 += __shfl_xor(rs1, o); rs2 += __shfl_xor(rs2, o); }
        l1 = l1 * al1 + rs1; l2 = l2 * al2 + rs2; m1 = mn1; m2 = mn2;
        __syncthreads();
#pragma unroll
        for (int i = 0; i < 16; ++i) { O1[i] *= al1; O2[i] *= al2; }
        for (int k = 0; k < 64; ++k) {
            const float p1 = P1[r * 65 + k], p2 = P2[r * 65 + k];
#pragma unroll
            for (int i4 = 0; i4 < 4; ++i4) {
                const f32x4 vv = *(const LAS f32x4*)&Vt[k * 132 + p * 16 + i4 * 4];
#pragma unroll
                for (int i = 0; i < 4; ++i) { O1[i4 * 4 + i] += p1 * vv[i]; O2[i4 * 4 + i] += p2 * vv[i]; }
            }
        }
    }
    const float i1 = 1.0f / l1, i2 = 1.0f / l2;
    float o1[8], o2[8];
    bf16* Ob1 = wsp<bf16>(F, WS_O1) + (size_t)(b * SEQ + c * 64 + r) * HW + h * HD + p * 16;
    bf16* Ob2 = wsp<bf16>(F, WS_O2) + (size_t)(b * SEQ + c * 64 + r) * HW + h * HD + p * 16;
#pragma unroll
    for (int hh = 0; hh < 2; ++hh) {
#pragma unroll
        for (int i = 0; i < 8; ++i) { o1[i] = O1[hh * 8 + i] * i1; o2[i] = O2[hh * 8 + i] * i2; }
        store8_bf16(Ob1 + hh * 8, o1); store8_bf16(Ob2 + hh * 8, o2);
    }
}

__device__ __forceinline__ void hgrn_chain_fast(Frame& F, int ch);
__device__ __forceinline__ void ph_mix_simple(Frame& F) {
#if FAST_HGRN
    for (int ch = F.bid; ch < NB * NH; ch += F.G) hgrn_chain_fast(F, ch);
#else
    for (int ch = F.bid; ch < NB * NH; ch += F.G) hgrn_chain_simple(F, ch);
#endif
    for (int u = F.bid; u < NB * NH * 32; u += F.G) {
        const int c = 31 - (u >> 6), bh = u & 63;
        attn_unit_simple(F, bh >> 3, bh & 7, c);
    }
}

__device__ __forceinline__ void ph_yda(Frame& F) {
    const int gw = F.bid * NWAVES + F.wave, NGW = F.G * NWAVES;
    const float lam = *wsp<const float>(F, WS_LAM);
    const bf16* O1 = wsp<const bf16>(F, WS_O1); const bf16* O2 = wsp<const bf16>(F, WS_O2); bf16* YDA = wsp<bf16>(F, WS_YDA);
    for (int row = gw; row < T; row += NGW) {
        const size_t off = (size_t)row * HW + F.lane * 16;
        const u32x4 a0 = *(const u32x4*)(O1 + off), a1 = *(const u32x4*)(O1 + off + 8), b0 = *(const u32x4*)(O2 + off), b1 = *(const u32x4*)(O2 + off + 8);
        const unsigned wa[8] = {a0.x, a0.y, a0.z, a0.w, a1.x, a1.y, a1.z, a1.w}, wb[8] = {b0.x, b0.y, b0.z, b0.w, b1.x, b1.y, b1.z, b1.w};
        float o[16]; float s = 0.f;
#pragma unroll
        for (int i = 0; i < 8; ++i) {
            o[2 * i] = bf2f(wa[i] & 0xffffu) - lam * bf2f(wb[i] & 0xffffu); o[2 * i + 1] = bf2f(wa[i] >> 16) - lam * bf2f(wb[i] >> 16);
            s += o[2 * i] * o[2 * i] + o[2 * i + 1] * o[2 * i + 1];
        }
        s += __shfl_xor(s, 1); s += __shfl_xor(s, 2); s += __shfl_xor(s, 4);
        const float rs = (1.0f / sqrtf(s * (1.0f / HD) + EPS)) * (1.0f - LAMBDA_INIT);
        float y[8];
#pragma unroll
        for (int hh = 0; hh < 2; ++hh) {
#pragma unroll
            for (int i = 0; i < 8; ++i) y[i] = o[hh * 8 + i] * rs * F.da_nw[F.lane * 16 + hh * 8 + i];
#if BRANCH_FP8
            { u32x2 p; p.x = pk4_fp8(clamp8(y[0]), clamp8(y[1]), clamp8(y[2]), clamp8(y[3])); p.y = pk4_fp8(clamp8(y[4]), clamp8(y[5]), clamp8(y[6]), clamp8(y[7]));
              *(u32x2*)((unsigned char*)YDA + (size_t)row * DM + F.lane * 16 + hh * 8) = p; }
#else
            store8_bf16(YDA + (size_t)row * DM + F.lane * 16 + hh * 8, y);
#endif
        }
    }
}

struct EpiBr1 { const Frame* F; int m0; __device__ __forceinline__ void operator()(int r, int col0, const float (&v)[8]) const {
    const size_t off = (size_t)(m0 + r) * DM + col0; const u32x4 g = *(const u32x4*)(wsp<const bf16>(*F, WS_GATEH) + off);
    float* o = wsp<float>(*F, WS_TMP) + off; const unsigned w[4] = {g.x, g.y, g.z, g.w};
    f32x4 o0, o1;
#pragma unroll
    for (int i = 0; i < 4; ++i) { const float a = v[2 * i] * bf2f(w[i] & 0xffffu), b = v[2 * i + 1] * bf2f(w[i] >> 16); if (i < 2) { o0[2 * i] = a; o0[2 * i + 1] = b; } else { o1[2 * i - 4] = a; o1[2 * i - 3] = b; } }
    *(f32x4*)o = o0; *(f32x4*)(o + 4) = o1; } };
struct EpiBr2 { const Frame* F; int m0; __device__ __forceinline__ void operator()(int r, int col0, const float (&v)[8]) const {
    const size_t off = (size_t)(m0 + r) * DM + col0; const u32x4 g = *(const u32x4*)(wsp<const bf16>(*F, WS_GATED) + off);
    const float* t = wsp<const float>(*F, WS_TMP) + off; const f32x4 t0 = *(const f32x4*)t, t1 = *(const f32x4*)(t + 4); const unsigned w[4] = {g.x, g.y, g.z, g.w};
    float o[8];
#pragma unroll
    for (int i = 0; i < 4; ++i) { o[2 * i] = (i < 2 ? t0[2 * i] : t1[2 * i - 4]) + v[2 * i] * bf2f(w[i] & 0xffffu); o[2 * i + 1] = (i < 2 ? t0[2 * i + 1] : t1[2 * i - 3]) + v[2 * i + 1] * bf2f(w[i] >> 16); }
    store8_bf16(wsp<bf16>(*F, WS_MERGED) + off, o); } };
__device__ __forceinline__ void ph_branch_simple(Frame& F) {
    LAS float* As = (LAS float*)F.lds; LAS float* Bs = As + 16 * 132;
    const int NT_ = DM / 128, MT_ = T / 128;
    for (int t = F.bid; t < NT_ * MT_; t += F.G) {
        const int mt = t / NT_, nt = t % NT_;
        RowsDense rows{mt * 128};
        EpiBr1 e1{&F, mt * 128}; sg_tile(As, Bs, wsp<const bf16>(F, WS_YHG), DM, rows, F.w_bhg, DM, nt * 128, HW, e1);
        EpiBr2 e2{&F, mt * 128}; sg_tile(As, Bs, wsp<const bf16>(F, WS_YDA), DM, rows, F.w_bda, DM, nt * 128, HW, e2);
    }
}
struct EpiU { const Frame* F; int m0; __device__ __forceinline__ void operator()(int r, int col0, const float (&v)[8]) const { store8_bf16(wsp<bf16>(*F, WS_U) + (size_t)(m0 + r) * DM + col0, v); } };
__device__ __forceinline__ void ph_wout_simple(Frame& F) {
    LAS float* As = (LAS float*)F.lds; LAS float* Bs = As + 16 * 132;
    const int NT_ = DM / 128, MT_ = T / 128;
    for (int t = F.bid; t < NT_ * MT_; t += F.G) {
        const int mt = t / NT_, nt = t % NT_;
        RowsDense rows{mt * 128}; EpiU e{&F, mt * 128};
        sg_tile(As, Bs, wsp<const bf16>(F, WS_MERGED), DM, rows, F.w_out, DM, nt * 128, DM, e);
    }
}

__device__ __forceinline__ void ph_post(Frame& F) {
    LAS float* Lgt = (LAS float*)F.lds; LAS float* Lsh = Lgt + DM; LAS float* Lsc = Lsh + DM;
    LAS float* Lh = Lsc + DM + F.wave * DM;
    const bf16* U = wsp<const bf16>(F, WS_U); bf16* X1 = wsp<bf16>(F, WS_X1); bf16* H2 = wsp<bf16>(F, WS_H2);
    int* TOKE = wsp<int>(F, WS_TOKE); int* TOKP = wsp<int>(F, WS_TOKP); int* LT = wsp<int>(F, WS_LISTTOK); float* LW = wsp<float>(F, WS_LISTW);
    int curb = -1;
    for (int rb = F.bid; rb < T / 8; rb += F.G) {
        const int batch = rb / (SEQ / 8);
        if (batch != curb) { __syncthreads(); mod_vec(F, Lgt, 2, batch); mod_vec(F, Lsh, 3, batch); mod_vec(F, Lsc, 4, batch); __syncthreads(); curb = batch; }
        const int row = rb * 8 + F.wave;
        f32x4 u[8]; float s = 0.f;
#pragma unroll
        for (int j = 0; j < 8; ++j) {
            const u32x2 w = *(const u32x2*)(U + (size_t)row * DM + 4 * F.lane + 256 * j);
            u[j] = (f32x4){bf2f(w.x & 0xffffu), bf2f(w.x >> 16), bf2f(w.y & 0xffffu), bf2f(w.y >> 16)};
            s += (u[j][0] * u[j][0] + u[j][1] * u[j][1]) + (u[j][2] * u[j][2] + u[j][3] * u[j][3]);
        }
        const float r1 = 1.0f / sqrtf(wave_sum(s) * (1.0f / DM) + EPS);
        float s2 = 0.f;
#pragma unroll
        for (int j = 0; j < 8; ++j) {
            const int c0 = 4 * F.lane + 256 * j;
            const f32x4 xv = *(const f32x4*)(F.x + (size_t)row * DM + c0), w = *(const f32x4*)(F.post_mix + c0), g = *(const LAS f32x4*)(Lgt + c0);
            u[j] = xv + g * (u[j] * r1 * w);
            { u32x2 xo; xo.x = pk2(u[j][0], u[j][1]); xo.y = pk2(u[j][2], u[j][3]); *(u32x2*)(X1 + (size_t)row * DM + c0) = xo; }
            s2 += (u[j][0] * u[j][0] + u[j][1] * u[j][1]) + (u[j][2] * u[j][2] + u[j][3] * u[j][3]);
        }
        const float r2 = 1.0f / sqrtf(wave_sum(s2) * (1.0f / DM) + EPS);
#pragma unroll
        for (int j = 0; j < 8; ++j) {
            const int c0 = 4 * F.lane + 256 * j;
            const f32x4 w = *(const f32x4*)(F.pre_ffn + c0), sc = *(const LAS f32x4*)(Lsc + c0), sh = *(const LAS f32x4*)(Lsh + c0);
            u[j] = u[j] * r2 * w * (sc + 1.0f) + sh;
            u32x2 o; o.x = pk2(u[j][0], u[j][1]); o.y = pk2(u[j][2], u[j][3]);
            *(u32x2*)(H2 + (size_t)row * DM + c0) = o;
            *(LAS f32x4*)(Lh + c0) = u[j];
        }
        float elog, glog;
        {
            const int j = F.lane & 31, kh = F.lane >> 5;
            const float* wr = F.w_router + (size_t)(kh * 1024) * 32 + j; const LAS float* hp = Lh + kh * 1024;
            float a0 = 0.f, a1 = 0.f;
#pragma unroll 8
            for (int k = 0; k < 1024; k += 2) { a0 += hp[k] * wr[(size_t)k * 32]; a1 += hp[k + 1] * wr[(size_t)(k + 1) * 32]; }
            float a = a0 + a1; a += __shfl_xor(a, 32);
            elog = a + F.b_router[j];
            const int g = F.lane & 3, kp = F.lane >> 2;
            const float* wg = F.w_group + (size_t)(kp * 128) * 4 + g; const LAS float* hq = Lh + kp * 128;
            float c0 = 0.f;
#pragma unroll 8
            for (int k = 0; k < 128; ++k) c0 += hq[k] * wg[(size_t)k * 4];
            c0 += __shfl_xor(c0, 4); c0 += __shfl_xor(c0, 8); c0 += __shfl_xor(c0, 16); c0 += __shfl_xor(c0, 32);
            glog = c0 + F.b_group[g];
        }
        float lg[4];
#pragma unroll
        for (int i = 0; i < 4; ++i) lg[i] = __shfl(glog, i);
        int gi = 0; float gm = lg[0];
#pragma unroll
        for (int i = 1; i < 4; ++i) if (lg[i] > gm) { gm = lg[i]; gi = i; }
        float gden = 0.f;
#pragma unroll
        for (int i = 0; i < 4; ++i) gden += __expf(lg[i] - gm);
        const float gw_ = 1.0f / gden;
        float ev[8];
#pragma unroll
        for (int i = 0; i < 8; ++i) ev[i] = __shfl(elog, gi * 8 + i);
        int i0 = 0; float v0 = ev[0];
#pragma unroll
        for (int i = 1; i < 8; ++i) if (ev[i] > v0) { v0 = ev[i]; i0 = i; }
        int i1 = -1; float v1 = -INFINITY;
#pragma unroll
        for (int i = 0; i < 8; ++i) if (i != i0 && ev[i] > v1) { v1 = ev[i]; i1 = i; }
        const float e1 = __expf(v1 - v0); const float w0 = gw_ / (1.0f + e1), w1 = gw_ * e1 / (1.0f + e1);
        if (F.lane == 0) {
            const int ea = gi * 8 + i0, eb = gi * 8 + i1;
            const int pa = (int)__hip_atomic_fetch_add((unsigned*)(F.ctl + CW_CNT + 16 * ea), 1u, RLX_AGENT);
            const int pb = (int)__hip_atomic_fetch_add((unsigned*)(F.ctl + CW_CNT + 16 * eb), 1u, RLX_AGENT);
            TOKE[row * 2] = ea; TOKE[row * 2 + 1] = eb; TOKP[row * 2] = pa; TOKP[row * 2 + 1] = pb;
            LT[ea * 16384 + pa] = row; LW[ea * 16384 + pa] = w0; LT[eb * 16384 + pb] = row; LW[eb * 16384 + pb] = w1;
        }
    }
#undef POST_LOAD
}


__device__ __forceinline__ void ph_post_fast(Frame& F) {
    typedef short bf16x8_t __attribute__((ext_vector_type(8)));
    constexpr int HP = 2056;
    LAS unsigned short* Hb = (LAS unsigned short*)F.lds;
    LAS float* Ps = (LAS float*)F.lds;
    LAS float* Lg = (LAS float*)(F.lds + 32 * HP * 2);
    const bf16* U = wsp<const bf16>(F, WS_U); bf16* X1 = wsp<bf16>(F, WS_X1); unsigned char* H2 = wsp<unsigned char>(F, WS_H2);
    const float* MODF = wsp<const float>(F, WS_MODF);
    int* TOKE = wsp<int>(F, WS_TOKE); int* TOKP = wsp<int>(F, WS_TOKP); int* LT = wsp<int>(F, WS_LISTTOK); float* LW = wsp<float>(F, WS_LISTW);
    const int l15 = F.lane & 15, kq = F.lane >> 4;
    constexpr int NG = T / 32;
    f32x4 xv2[2][8];
#define POST_LOAD(row_) do { _Pragma("unroll") for (int rr = 0; rr < 2; ++rr) _Pragma("unroll") for (int j = 0; j < 8; ++j) { \
        const size_t off = (size_t)((row_) + rr) * DM + 4 * F.lane + 256 * j; xv2[rr][j] = *(const f32x4*)(F.x + off); } } while (0)
    float bias[3];
#pragma unroll
    for (int i = 0; i < 3; ++i) { const int c_ = (F.tid + 512 * i) % 48; bias[i] = c_ < 4 ? F.b_group[c_] : (c_ < 36 ? F.b_router[c_ - 4] : 0.f); }
    if (F.bid < NG) POST_LOAD(F.bid * 32 + F.wave * 4);
    for (int g = F.bid; g < NG; g += F.G) {
        const int batch = (g * 32) / SEQ;
        const float* Msh = MODF + (batch * 6 + 3) * DM;
        __syncthreads();
#pragma unroll 1
        for (int ps = 0; ps < 2; ++ps) {
            {
                int ln = F.lane; asm volatile("" : "+v"(ln));
                const int rl = F.wave * 4 + ps * 2, row = g * 32 + rl;
                const float* Gw = MODF + MODX + (batch * 2 + 0) * DM; const float* Ws = MODF + MODX + (batch * 2 + 1) * DM;
                f32x4 u0[8], u1[8]; float sq0 = 0.f, sq1 = 0.f, s20 = 0.f, s21 = 0.f;
                {
                    u32x2 ua[8], ub[8];
#pragma unroll
                    for (int j = 0; j < 8; ++j) { ua[j] = *(const u32x2*)(U + (size_t)row * DM + 4 * ln + 256 * j); ub[j] = *(const u32x2*)(U + (size_t)(row + 1) * DM + 4 * ln + 256 * j); }
#pragma unroll
                    for (int j = 0; j < 8; ++j) {
                        u0[j] = (f32x4){bf2f(ua[j].x & 0xffffu), bf2f(ua[j].x >> 16), bf2f(ua[j].y & 0xffffu), bf2f(ua[j].y >> 16)};
                        u1[j] = (f32x4){bf2f(ub[j].x & 0xffffu), bf2f(ub[j].x >> 16), bf2f(ub[j].y & 0xffffu), bf2f(ub[j].y >> 16)};
                        sq0 += (u0[j][0] * u0[j][0] + u0[j][1] * u0[j][1]) + (u0[j][2] * u0[j][2] + u0[j][3] * u0[j][3]);
                        sq1 += (u1[j][0] * u1[j][0] + u1[j][1] * u1[j][1]) + (u1[j][2] * u1[j][2] + u1[j][3] * u1[j][3]);
                    }
                }
                {
                    asm volatile("" ::: "memory");
                    f32x4 gw[8];
#pragma unroll
                    for (int j = 0; j < 8; ++j) gw[j] = *(const f32x4*)(Gw + 4 * ln + 256 * j);
                    const float r10 = 1.0f / sqrtf(wave_sum(sq0) * (1.0f / DM) + EPS), r11 = 1.0f / sqrtf(wave_sum(sq1) * (1.0f / DM) + EPS);
#pragma unroll
                    for (int j = 0; j < 8; ++j) {
                        const int c0 = 4 * ln + 256 * j;
                        u0[j] = xv2[0][j] + gw[j] * (u0[j] * r10); u1[j] = xv2[1][j] + gw[j] * (u1[j] * r11);
                        { u32x2 xo; xo.x = pk2(u0[j][0], u0[j][1]); xo.y = pk2(u0[j][2], u0[j][3]); *(u32x2*)(X1 + (size_t)row * DM + c0) = xo; }
                        { u32x2 xo; xo.x = pk2(u1[j][0], u1[j][1]); xo.y = pk2(u1[j][2], u1[j][3]); *(u32x2*)(X1 + (size_t)(row + 1) * DM + c0) = xo; }
                        s20 += (u0[j][0] * u0[j][0] + u0[j][1] * u0[j][1]) + (u0[j][2] * u0[j][2] + u0[j][3] * u0[j][3]);
                        s21 += (u1[j][0] * u1[j][0] + u1[j][1] * u1[j][1]) + (u1[j][2] * u1[j][2] + u1[j][3] * u1[j][3]);
                    }
                }
                asm volatile("" ::: "memory");
                {
                    f32x4 ws[8], sh[8];
#pragma unroll
                    for (int j = 0; j < 8; ++j) { const int c0 = 4 * ln + 256 * j; ws[j] = *(const f32x4*)(Ws + c0); sh[j] = *(const f32x4*)(Msh + c0); }
                    const float r20 = 1.0f / sqrtf(wave_sum(s20) * (1.0f / DM) + EPS), r21 = 1.0f / sqrtf(wave_sum(s21) * (1.0f / DM) + EPS);
#pragma unroll
                    for (int j = 0; j < 8; ++j) {
                        const int c0 = 4 * ln + 256 * j;
                        const f32x4 h0 = u0[j] * r20 * ws[j] + sh[j], h1 = u1[j] * r21 * ws[j] + sh[j];
                        *(unsigned*)(H2 + (size_t)row * DM + c0) = pk4_fp8(clamp8(h0[0]), clamp8(h0[1]), clamp8(h0[2]), clamp8(h0[3]));
                        *(unsigned*)(H2 + (size_t)(row + 1) * DM + c0) = pk4_fp8(clamp8(h1[0]), clamp8(h1[1]), clamp8(h1[2]), clamp8(h1[3]));
                        u32x2 hb0, hb1; hb0.x = pk2(h0[0], h0[1]); hb0.y = pk2(h0[2], h0[3]); hb1.x = pk2(h1[0], h1[1]); hb1.y = pk2(h1[2], h1[3]);
                        *(LAS u32x2*)(Hb + rl * HP + c0) = hb0; *(LAS u32x2*)(Hb + (rl + 1) * HP + c0) = hb1;
                    }
                }
                asm volatile("" ::: "memory");
            }
            asm volatile("" ::: "memory");
            if (ps == 0) POST_LOAD(g * 32 + F.wave * 4 + 2);
            else if (g + F.G < NG) POST_LOAD((g + F.G) * 32 + F.wave * 4);
        }
        bf16x8_t bh[8][3];
        {
            const __amdgpu_buffer_rsrc_t wrs = __builtin_amdgcn_make_buffer_rsrc((void*)wsp<bf16>(F, WS_WCAT), 0, 2 * 48 * DM * 2, 0x00020000);
            const int wvo = (l15 * DM + 256 * F.wave + 8 * kq) * 2;
#pragma unroll
            for (int st = 0; st < 8; ++st)
#pragma unroll
                for (int n = 0; n < 3; ++n) bh[st][n] = __builtin_bit_cast(bf16x8_t, __builtin_amdgcn_raw_buffer_load_b128(wrs, wvo, n * 16 * DM * 2 + 64 * st, 0));
        }
        __syncthreads();
        f32x4 acc[2][3];
#pragma unroll
        for (int rt = 0; rt < 2; ++rt)
#pragma unroll
            for (int n = 0; n < 3; ++n) acc[rt][n] = (f32x4){0.f, 0.f, 0.f, 0.f};
        {
            const LAS unsigned short* ap = Hb + l15 * HP + 256 * F.wave + 8 * kq;
#pragma unroll
            for (int st = 0; st < 8; ++st) {
                const bf16x8_t a0 = *(const LAS bf16x8_t*)(ap + 32 * st), a1 = *(const LAS bf16x8_t*)(ap + 16 * HP + 32 * st);
#pragma unroll
                for (int n = 0; n < 3; ++n) {
                    acc[0][n] = __builtin_amdgcn_mfma_f32_16x16x32_bf16(a0, bh[st][n], acc[0][n], 0, 0, 0);
                    acc[1][n] = __builtin_amdgcn_mfma_f32_16x16x32_bf16(a1, bh[st][n], acc[1][n], 0, 0, 0);
                }
            }
        }
        __syncthreads();
#pragma unroll
        for (int rt = 0; rt < 2; ++rt)
#pragma unroll
            for (int n = 0; n < 3; ++n)
#pragma unroll
                for (int r = 0; r < 4; ++r) Ps[(F.wave * 32 + rt * 16 + 4 * kq + r) * 48 + 16 * n + l15] = acc[rt][n][r];
        __syncthreads();
#pragma unroll
        for (int i = 0; i < 3; ++i) {
            const int o = F.tid + 512 * i;
            float sacc = 0.f;
#pragma unroll
            for (int w8 = 0; w8 < 8; ++w8) sacc += Ps[w8 * 1536 + o];
            Lg[o] = sacc + bias[i];
        }
        __syncthreads();
        if (F.lane < 4) {
            const int rl = F.wave * 4 + F.lane, row = g * 32 + rl; const LAS float* lg = Lg + rl * 48;
            int gi = 0; float gm = lg[0];
#pragma unroll
            for (int i = 1; i < 4; ++i) { const float v = lg[i]; if (v > gm) { gm = v; gi = i; } }
            float gden = 0.f;
#pragma unroll
            for (int i = 0; i < 4; ++i) gden += __expf(lg[i] - gm);
            const float gw_ = 1.0f / gden;
            const LAS float* ev = lg + 4 + gi * 8;
            int i0 = 0; float v0 = ev[0];
#pragma unroll
            for (int i = 1; i < 8; ++i) { const float v = ev[i]; if (v > v0) { v0 = v; i0 = i; } }
            int i1 = -1; float v1 = -INFINITY;
#pragma unroll
            for (int i = 0; i < 8; ++i) { const float v = ev[i]; if (i != i0 && v > v1) { v1 = v; i1 = i; } }
            const float e1 = __expf(v1 - v0); const float w0 = gw_ / (1.0f + e1), w1 = gw_ * e1 / (1.0f + e1);
            const int ea = gi * 8 + i0, eb = gi * 8 + i1;
            const int pa = (int)__hip_atomic_fetch_add((unsigned*)(F.ctl + CW_CNT + 16 * ea), 1u, RLX_AGENT);
            const int pb = (int)__hip_atomic_fetch_add((unsigned*)(F.ctl + CW_CNT + 16 * eb), 1u, RLX_AGENT);
            TOKE[row * 2] = ea; TOKE[row * 2 + 1] = eb; TOKP[row * 2] = pa; TOKP[row * 2 + 1] = pb;
            LT[ea * 16384 + pa] = row; LW[ea * 16384 + pa] = w0; LT[eb * 16384 + pb] = row; LW[eb * 16384 + pb] = w1;
        }
    }
#undef POST_LOAD
}
__device__ __forceinline__ void expert_tables(Frame& F, LAS int* tab, int tile_rows) {
    if (F.tid < NE) tab[F.tid] = (int)__hip_atomic_load((unsigned*)(F.ctl + CW_CNT + 16 * F.tid), RLX_AGENT);
    __syncthreads();
    if (F.tid == 0) {
        int ps = 0, ts = 0;
#pragma unroll 8
        for (int e = 0; e < NE; ++e) {
            const int c = tab[e];
            tab[32 + e] = ps; tab[72 + e] = ts;
            ps += (c + 255) / 256 * 256; ts += (c + tile_rows - 1) / tile_rows;
        }
        tab[32 + NE] = ps; tab[72 + NE] = ts;
    }
    __syncthreads();
}

struct EpiG { const Frame* F; int slot0, n; __device__ __forceinline__ void operator()(int r, int col0, const float (&v)[8]) const {
    if (r >= n) return; float* o = wsp<float>(*F, WS_TMPG) + (size_t)(slot0 + r) * DE + col0;
    f32x4 o0, o1;
#pragma unroll
    for (int i = 0; i < 8; ++i) { const float s = v[i] * sigmoidf_(v[i]); if (i < 4) o0[i] = s; else o1[i - 4] = s; }
    *(f32x4*)o = o0; *(f32x4*)(o + 4) = o1; } };
struct EpiUp { const Frame* F; int slot0, n; __device__ __forceinline__ void operator()(int r, int col0, const float (&v)[8]) const {
    if (r >= n) return; const float* t = wsp<const float>(*F, WS_TMPG) + (size_t)(slot0 + r) * DE + col0; const f32x4 t0 = *(const f32x4*)t, t1 = *(const f32x4*)(t + 4);
    float o[8];
#pragma unroll
    for (int i = 0; i < 8; ++i) o[i] = (i < 4 ? t0[i] : t1[i - 4]) * v[i];
    store8_bf16(wsp<bf16>(*F, WS_ACT) + (size_t)(slot0 + r) * DE + col0, o); } };
__device__ __forceinline__ void ph_moe1_simple(Frame& F) {
    LAS float* As = (LAS float*)F.lds; LAS float* Bs = As + 16 * 132; LAS int* tab = (LAS int*)(Bs + 16 * 132);
    expert_tables(F, tab, 128);
    const int NT_ = DE / 128, ntl = tab[72 + NE] * NT_;
    for (int t = F.bid; t < ntl; t += F.G) {
        const int mtg = t / NT_, nt = t % NT_;
        int e = 0;
#pragma unroll 1
        for (int q = 1; q < NE; ++q) if (tab[72 + q] <= mtg) e = q;
        const int mt = mtg - tab[72 + e], n = min(128, tab[e] - mt * 128), slot0 = tab[32 + e] + mt * 128;
        RowsList rows{wsp<const int>(F, WS_LISTTOK) + e * 16384 + mt * 128, n};
        EpiG eg{&F, slot0, n}; sg_tile(As, Bs, wsp<const bf16>(F, WS_H2), DM, rows, F.w_gate + (size_t)e * DM * DE, DE, nt * 128, DM, eg);
        EpiUp eu{&F, slot0, n}; sg_tile(As, Bs, wsp<const bf16>(F, WS_H2), DM, rows, F.w_up + (size_t)e * DM * DE, DE, nt * 128, DM, eu);
    }
}
struct EpiDown { const Frame* F; int slot0, n; const float* lw; __device__ __forceinline__ void operator()(int r, int col0, const float (&v)[8]) const {
    if (r >= n) return; const float w = lw[r]; float o[8];
#pragma unroll
    for (int i = 0; i < 8; ++i) o[i] = v[i] * w;
    store8_bf16(wsp<bf16>(*F, WS_YW) + (size_t)(slot0 + r) * DM + col0, o); } };
__device__ __forceinline__ void ph_moe2_simple(Frame& F) {
    LAS float* As = (LAS float*)F.lds; LAS float* Bs = As + 16 * 132; LAS int* tab = (LAS int*)(Bs + 16 * 132);
    expert_tables(F, tab, 128);
    const int NT_ = DM / 128, ntl = tab[72 + NE] * NT_;
    for (int t = F.bid; t < ntl; t += F.G) {
        const int mtg = t / NT_, nt = t % NT_;
        int e = 0;
#pragma unroll 1
        for (int q = 1; q < NE; ++q) if (tab[72 + q] <= mtg) e = q;
        const int mt = mtg - tab[72 + e], n = min(128, tab[e] - mt * 128), slot0 = tab[32 + e] + mt * 128;
        RowsDense rows{slot0};
        EpiDown ed{&F, slot0, n, wsp<const float>(F, WS_LISTW) + e * 16384 + mt * 128};
        sg_tile(As, Bs, wsp<const bf16>(F, WS_ACT), DE, rows, F.w_down + (size_t)e * DE * DM, DM, nt * 128, DE, ed);
    }
}

__device__ __forceinline__ void ph_final(Frame& F) {
    LAS int* tab = (LAS int*)F.lds;
    expert_tables(F, tab, 128);
    const bf16* X1 = wsp<const bf16>(F, WS_X1); const unsigned char* YW = wsp<const unsigned char>(F, WS_YW); const float* MODF = wsp<const float>(F, WS_MODF);
    const int* TOKE = wsp<const int>(F, WS_TOKE); const int* TOKP = wsp<const int>(F, WS_TOKP); const float* LW = wsp<const float>(F, WS_LISTW);
    const int gw = F.bid * NWAVES + F.wave, NGW = F.G * NWAVES;
    for (int rp = gw; rp < T / 2; rp += NGW) {
        const int row0 = rp * 2;
        int ln = F.lane; asm volatile("" : "+v"(ln));
        const float* Mgt = MODF + ((row0 / SEQ) * 6 + 5) * DM;
        int sl[2][2]; float rw[2][2];
#pragma unroll
        for (int r = 0; r < 2; ++r)
#pragma unroll
            for (int q = 0; q < 2; ++q) { const int e_ = TOKE[(row0 + r) * 2 + q], p_ = TOKP[(row0 + r) * 2 + q]; sl[r][q] = tab[32 + e_] + p_; rw[r][q] = LW[e_ * 16384 + p_] * Y8I; }
        unsigned ya[2][8], yb[2][8]; u32x2 xr[2][8];
#pragma unroll
        for (int r = 0; r < 2; ++r)
#pragma unroll
            for (int j = 0; j < 8; ++j) { const int c0 = 4 * ln + 256 * j; ya[r][j] = *(const unsigned*)(YW + (size_t)sl[r][0] * DM + c0); yb[r][j] = *(const unsigned*)(YW + (size_t)sl[r][1] * DM + c0);
                xr[r][j] = *(const u32x2*)(X1 + (size_t)(row0 + r) * DM + c0); }
        f32x4 wv[8], gv[8];
#pragma unroll
        for (int j = 0; j < 8; ++j) { const int c0 = 4 * ln + 256 * j; wv[j] = *(const f32x4*)(F.post_ffn + c0); gv[j] = *(const f32x4*)(Mgt + c0); }
#pragma unroll
        for (int r = 0; r < 2; ++r) {
            f32x4 y[8]; float s = 0.f;
#pragma unroll
            for (int j = 0; j < 8; ++j) {
                const f32x2_t a0 = __builtin_amdgcn_cvt_pk_f32_fp8((int)ya[r][j], false), a1 = __builtin_amdgcn_cvt_pk_f32_fp8((int)ya[r][j], true);
                const f32x2_t b0 = __builtin_amdgcn_cvt_pk_f32_fp8((int)yb[r][j], false), b1 = __builtin_amdgcn_cvt_pk_f32_fp8((int)yb[r][j], true);
                y[j] = (f32x4){a0[0] * rw[r][0] + b0[0] * rw[r][1], a0[1] * rw[r][0] + b0[1] * rw[r][1], a1[0] * rw[r][0] + b1[0] * rw[r][1], a1[1] * rw[r][0] + b1[1] * rw[r][1]};
                s += (y[j][0] * y[j][0] + y[j][1] * y[j][1]) + (y[j][2] * y[j][2] + y[j][3] * y[j][3]);
            }
            const float rn = 1.0f / sqrtf(wave_sum(s) * (1.0f / DM) + EPS);
#pragma unroll
            for (int j = 0; j < 8; ++j) {
                const int c0 = 4 * ln + 256 * j;
                const f32x4 xv = (f32x4){bf2f(xr[r][j].x & 0xffffu), bf2f(xr[r][j].x >> 16), bf2f(xr[r][j].y & 0xffffu), bf2f(xr[r][j].y >> 16)};
                *(f32x4*)(F.out + (size_t)(row0 + r) * DM + c0) = xv + gv[j] * (y[j] * rn * wv[j]);
            }
        }
    }
}


#define T_LOAD32(tv, RS, N, k0, n0) do { const int vo_ = ((8 * (lane >> 3)) * (N) + (n0) + 4 * (lane & 7)) * 4; \
        _Pragma("unroll") for (int i = 0; i < 8; ++i) tv[i] = __builtin_bit_cast(f32x4, __builtin_amdgcn_raw_buffer_load_b128(RS, vo_, ((k0) + i) * (N) * 4, 2)); } while (0)
#define T_STORE32F8(tv, WT, K, k0, drow) do { _Pragma("unroll") for (int j = 0; j < 4; ++j) { \
        u32x2 o_; o_.x = pk4_fp8(tv[0][j] * W8S, tv[1][j] * W8S, tv[2][j] * W8S, tv[3][j] * W8S); o_.y = pk4_fp8(tv[4][j] * W8S, tv[5][j] * W8S, tv[6][j] * W8S, tv[7][j] * W8S); \
        *(u32x2*)((WT) + (size_t)((drow) + 4 * (lane & 7) + j) * (K) + (k0) + 8 * (lane >> 3)) = o_; } } while (0)
#define T_STORE32(tv, WT, K, k0, drow) do { _Pragma("unroll") for (int j = 0; j < 4; ++j) { \
        u32x4 o_; o_.x = pk2(tv[0][j], tv[1][j]); o_.y = pk2(tv[2][j], tv[3][j]); o_.z = pk2(tv[4][j], tv[5][j]); o_.w = pk2(tv[6][j], tv[7][j]); \
        *(u32x4*)((WT) + (size_t)((drow) + 4 * (lane & 7) + j) * (K) + (k0) + 8 * (lane >> 3)) = o_; } } while (0)
namespace hg {
typedef short bf16x8 __attribute__((ext_vector_type(8)));
typedef short bf16x4 __attribute__((ext_vector_type(4)));
constexpr int QE_OFF = 0, KE_OFF = 17408, KDT_OFF = 34816, VT_OFF = 53248, AM_OFF = 71680, OB_OFF = 80896, SEG_OFF = 114688, DV_OFF = 118784;
constexpr int QROW = 272, TROW = 144, OROW = 528;
__device__ __forceinline__ bf16x8 cat8(bf16x4 a, bf16x4 b) { return (bf16x8){a[0], a[1], a[2], a[3], b[0], b[1], b[2], b[3]}; }
}
__device__ __forceinline__ void hgrn_chain_fast(Frame& F, int ch) {
    using namespace hg;
    const int b = ch >> 3, h = ch & 7;
    const int lane = F.lane, w = F.wave, tid = F.tid;
    LAS unsigned char* L = F.lds;
    const int l15 = lane & 15, kq = lane >> 4;
    const float* LOGF = wsp<const float>(F, WS_LOGF); const bf16* QHG = wsp<const bf16>(F, WS_QHG); const bf16* VHG = wsp<const bf16>(F, WS_VHG); const bf16* GHG = wsp<const bf16>(F, WS_GHG);
    bf16* YHG = wsp<bf16>(F, WS_YHG);
    const size_t rowbase = (size_t)(b * SEQ) * HW + h * HD;
    f32x4 S[8];
#pragma unroll
    for (int i = 0; i < 8; ++i) S[i] = (f32x4){0.f, 0.f, 0.f, 0.f};
    float lf[8][2]; unsigned qv[8], vv[8]; u32x4 gq[2];
    const int nt_ = tid >> 3, nvg = tid & 7;
#define HG_LOAD(c) do { _Pragma("unroll") for (int i = 0; i < 8; ++i) { const size_t off = rowbase + (size_t)((c) * 64 + 8 * w + i) * HW + 2 * lane; \
        const u32x2 t2 = *(const u32x2*)(LOGF + off); lf[i][0] = __uint_as_float(t2.x); lf[i][1] = __uint_as_float(t2.y); qv[i] = *(const unsigned*)(QHG + off); vv[i] = *(const unsigned*)(VHG + off); } \
        { const bf16* gp = GHG + rowbase + (size_t)((c) * 64 + nt_) * HW + 16 * nvg; gq[0] = *(const u32x4*)gp; gq[1] = *(const u32x4*)(gp + 8); } } while (0)
    f32x4 nwv[4];
#pragma unroll
    for (int i = 0; i < 4; ++i) nwv[i] = *(const f32x4*)(F.hg_nw + h * HD + 16 * nvg + 4 * i);
    HG_LOAD(0);
    __syncthreads();
    for (int c = 0; c < SEQ / 64; ++c) {
        float sum0 = lf[0][0], sum1 = lf[0][1];
#pragma unroll
        for (int i = 1; i < 8; ++i) { sum0 += lf[i][0]; sum1 += lf[i][1]; }
        *(LAS f32x2_t*)(L + SEG_OFF + (w * 128 + 2 * lane) * 4) = (f32x2_t){sum0, sum1};
        __syncthreads();
        float base0 = 0.f, base1 = 0.f, tot0 = 0.f, tot1 = 0.f;
#pragma unroll
        for (int s_ = 0; s_ < 8; ++s_) { const f32x2_t sv = *(const LAS f32x2_t*)(L + SEG_OFF + (s_ * 128 + 2 * lane) * 4); tot0 += sv[0]; tot1 += sv[1]; if (s_ < w) { base0 += sv[0]; base1 += sv[1]; } }
        const float eb0 = __expf(tot0), eb1 = __expf(tot1);
        float E0 = __expf(base0), E1 = __expf(base1);
        unsigned kd0[4], kd1[4], vt0[4], vt1[4];
#pragma unroll
        for (int i = 0; i < 8; ++i) {
            const float f0 = __expf(lf[i][0]), f1 = __expf(lf[i][1]);
            E0 *= f0; E1 *= f1;
            const float q0 = bf2f(qv[i] & 0xffffu), q1 = bf2f(qv[i] >> 16);
            const float qe0 = q0 * E0, qe1 = q1 * E1;
            const float ke0 = (1.0f - f0) * __builtin_amdgcn_rcpf(E0), ke1 = (1.0f - f1) * __builtin_amdgcn_rcpf(E1);
            const float d0 = ke0 * eb0, d1 = ke1 * eb1;
            *(LAS unsigned*)(L + QE_OFF + (8 * w + i) * QROW + 4 * lane) = pk2(qe0, qe1);
            *(LAS unsigned*)(L + KE_OFF + (8 * w + i) * QROW + 4 * lane) = pk2(ke0, ke1);
            const unsigned dd0 = f2bf(d0), dd1 = f2bf(d1);
            if (i & 1) { kd0[i >> 1] |= dd0 << 16; kd1[i >> 1] |= dd1 << 16; vt0[i >> 1] |= (vv[i] & 0xffffu) << 16; vt1[i >> 1] |= (vv[i] >> 16) << 16; }
            else { kd0[i >> 1] = dd0; kd1[i >> 1] = dd1; vt0[i >> 1] = vv[i] & 0xffffu; vt1[i >> 1] = vv[i] >> 16; }
        }
        *(LAS u32x4*)(L + KDT_OFF + (2 * lane) * TROW + 16 * w) = (u32x4){kd0[0], kd0[1], kd0[2], kd0[3]};
        *(LAS u32x4*)(L + KDT_OFF + (2 * lane + 1) * TROW + 16 * w) = (u32x4){kd1[0], kd1[1], kd1[2], kd1[3]};
        *(LAS u32x4*)(L + VT_OFF + (2 * lane) * TROW + 16 * w) = (u32x4){vt0[0], vt0[1], vt0[2], vt0[3]};
        *(LAS u32x4*)(L + VT_OFF + (2 * lane + 1) * TROW + 16 * w) = (u32x4){vt1[0], vt1[1], vt1[2], vt1[3]};
        if (w == 0) *(LAS f32x2_t*)(L + DV_OFF + 8 * lane) = (f32x2_t){eb0, eb1};
        u32x4 gcur[2] = {gq[0], gq[1]};
        if (c + 1 < SEQ / 64) HG_LOAD(c + 1);
        f32x4 twa[8], twb[8];
        const bool tjob = ((w + c) & 1) == 0;
        const int tid_ = (ch * (SEQ / 64) + c) * 4 + (w >> 1), te = tid_ >> 8, tkp = 4 + ((tid_ & 255) >> 6), tnb = tid_ & 63;
        const __amdgpu_buffer_rsrc_t trs = __builtin_amdgcn_make_buffer_rsrc((void*)(F.w_down + (size_t)te * DE * DM), 0, DM * DE * 4, 0x00020000);
        if (tjob) { const int vo_ = ((16 * (lane >> 3)) * DM + tnb * 32 + 4 * (lane & 7)) * 4;
#pragma unroll
            for (int i = 0; i < 8; ++i) twa[i] = __builtin_bit_cast(f32x4, __builtin_amdgcn_raw_buffer_load_b128(trs, vo_, (tkp * 128 + i) * DM * 4, 2));
#pragma unroll
            for (int i = 0; i < 8; ++i) twb[i] = __builtin_bit_cast(f32x4, __builtin_amdgcn_raw_buffer_load_b128(trs, vo_, (tkp * 128 + 8 + i) * DM * 4, 2)); }
        __syncthreads();
        {
            const int ti = w >> 1;
#pragma unroll
            for (int sj = 0; sj < 2; ++sj) {
                const int si = 2 * (w & 1) + sj;
                f32x4 a = (f32x4){0.f, 0.f, 0.f, 0.f};
                if (si <= ti) {
#pragma unroll
                    for (int j = 0; j < 4; ++j) {
                        const bf16x8 ka = *(const LAS bf16x8*)(L + KE_OFF + (16 * si + l15) * QROW + (32 * j + 8 * kq) * 2);
                        const bf16x8 qb = *(const LAS bf16x8*)(L + QE_OFF + (16 * ti + l15) * QROW + (32 * j + 8 * kq) * 2);
                        a = __builtin_amdgcn_mfma_f32_16x16x32_bf16(ka, qb, a, 0, 0, 0);
                    }
                    const int t = 16 * ti + l15, s0 = 16 * si + 4 * kq;
#pragma unroll
                    for (int r = 0; r < 4; ++r) if (s0 + r > t) a[r] = 0.f;
                }
                *(LAS u32x2*)(L + AM_OFF + (16 * ti + l15) * TROW + (16 * si + 4 * kq) * 2) = (u32x2){pk2(a[0], a[1]), pk2(a[2], a[3])};
            }
        }
        __syncthreads();
        {
            bf16x8 vf[2];
#pragma unroll
            for (int j = 0; j < 2; ++j) vf[j] = *(const LAS bf16x8*)(L + VT_OFF + (16 * w + l15) * TROW + (32 * j + 8 * kq) * 2);
            bf16x8 sb[4];
#pragma unroll
            for (int j = 0; j < 4; ++j) { const u32x4 t4 = (u32x4){pk2(S[2 * j][0], S[2 * j][1]), pk2(S[2 * j][2], S[2 * j][3]), pk2(S[2 * j + 1][0], S[2 * j + 1][1]), pk2(S[2 * j + 1][2], S[2 * j + 1][3])}; sb[j] = __builtin_bit_cast(bf16x8, t4); }
#pragma unroll
            for (int ti = 0; ti < 4; ++ti) {
                f32x4 o = (f32x4){0.f, 0.f, 0.f, 0.f};
#pragma unroll
                for (int j = 0; j < 2; ++j) { const bf16x8 am = *(const LAS bf16x8*)(L + AM_OFF + (16 * ti + l15) * TROW + (32 * j + 8 * kq) * 2); o = __builtin_amdgcn_mfma_f32_16x16x32_bf16(am, vf[j], o, 0, 0, 0); }
#pragma unroll
                for (int j = 0; j < 4; ++j) {
                    const bf16x4 lo = *(const LAS bf16x4*)(L + QE_OFF + (16 * ti + l15) * QROW + (32 * j + 4 * kq) * 2);
                    const bf16x4 hi = *(const LAS bf16x4*)(L + QE_OFF + (16 * ti + l15) * QROW + (32 * j + 16 + 4 * kq) * 2);
                    o = __builtin_amdgcn_mfma_f32_16x16x32_bf16(cat8(lo, hi), sb[j], o, 0, 0, 0);
                }
#pragma unroll
                for (int r = 0; r < 4; ++r) *(LAS float*)(L + OB_OFF + (16 * ti + 4 * kq + r) * OROW + (16 * w + l15) * 4) = o[r];
            }
#pragma unroll
            for (int kt = 0; kt < 8; ++kt) {
                const f32x4 dv = *(const LAS f32x4*)(L + DV_OFF + (16 * kt + 4 * kq) * 4);
                f32x4 cacc = S[kt] * dv;
#pragma unroll
                for (int j = 0; j < 2; ++j) { const bf16x8 kd = *(const LAS bf16x8*)(L + KDT_OFF + (16 * kt + l15) * TROW + (32 * j + 8 * kq) * 2); cacc = __builtin_amdgcn_mfma_f32_16x16x32_bf16(kd, vf[j], cacc, 0, 0, 0); }
                S[kt] = cacc;
            }
        }
        __syncthreads();
        {
            f32x4 o4[4]; float ss = 0.f;
#pragma unroll
            for (int i = 0; i < 4; ++i) { o4[i] = *(const LAS f32x4*)(L + OB_OFF + nt_ * OROW + (16 * nvg + 4 * i) * 4); ss += (o4[i][0] * o4[i][0] + o4[i][1] * o4[i][1]) + (o4[i][2] * o4[i][2] + o4[i][3] * o4[i][3]); }
            ss += __shfl_xor(ss, 1); ss += __shfl_xor(ss, 2); ss += __shfl_xor(ss, 4);
            const float rstd = 1.0f / sqrtf(ss * (1.0f / HD) + EPS);
            float y[8];
            bf16* yp = YHG + (size_t)(b * SEQ + c * 64 + nt_) * DM + h * HD + 16 * nvg;
#pragma unroll
            for (int hh = 0; hh < 2; ++hh) {
                const f32x4 n0 = nwv[2 * hh], n1 = nwv[2 * hh + 1];
                const u32x4 g = gcur[hh];
                y[0] = o4[2 * hh][0] * rstd * n0[0] * bf2f(g.x & 0xffffu); y[1] = o4[2 * hh][1] * rstd * n0[1] * bf2f(g.x >> 16);
                y[2] = o4[2 * hh][2] * rstd * n0[2] * bf2f(g.y & 0xffffu); y[3] = o4[2 * hh][3] * rstd * n0[3] * bf2f(g.y >> 16);
                y[4] = o4[2 * hh + 1][0] * rstd * n1[0] * bf2f(g.z & 0xffffu); y[5] = o4[2 * hh + 1][1] * rstd * n1[1] * bf2f(g.z >> 16);
                y[6] = o4[2 * hh + 1][2] * rstd * n1[2] * bf2f(g.w & 0xffffu); y[7] = o4[2 * hh + 1][3] * rstd * n1[3] * bf2f(g.w >> 16);
#if BRANCH_FP8
                { u32x2 p; p.x = pk4_fp8(clamp8(y[0]), clamp8(y[1]), clamp8(y[2]), clamp8(y[3])); p.y = pk4_fp8(clamp8(y[4]), clamp8(y[5]), clamp8(y[6]), clamp8(y[7]));
                  *(u32x2*)((unsigned char*)YHG + (size_t)(b * SEQ + c * 64 + nt_) * DM + h * HD + 16 * nvg + hh * 8) = p; }
#else
                store8_bf16(yp + hh * 8, y);
#endif
            }
        }
        if (tjob) { unsigned char* wt_ = wsp<unsigned char>(F, WS_WD_T) + (size_t)te * DM * DE;
#pragma unroll
            for (int j = 0; j < 4; ++j) { u32x4 o_;
                o_.x = pk4_fp8(twa[0][j] * W8S, twa[1][j] * W8S, twa[2][j] * W8S, twa[3][j] * W8S); o_.y = pk4_fp8(twa[4][j] * W8S, twa[5][j] * W8S, twa[6][j] * W8S, twa[7][j] * W8S);
                o_.z = pk4_fp8(twb[0][j] * W8S, twb[1][j] * W8S, twb[2][j] * W8S, twb[3][j] * W8S); o_.w = pk4_fp8(twb[4][j] * W8S, twb[5][j] * W8S, twb[6][j] * W8S, twb[7][j] * W8S);
                __builtin_nontemporal_store(o_, (u32x4*)(wt_ + (size_t)(tnb * 32 + 4 * (lane & 7) + j) * DE + tkp * 128 + 16 * (lane >> 3))); } }
    }
#undef HG_LOAD
    __syncthreads();
}


#include <hip/hip_bf16.h>
#include <cmath>
namespace attn_body {
using bf16=__hip_bfloat16;
using bf16x8=__attribute__((ext_vector_type(8)))short;
using s16x4=__attribute__((ext_vector_type(4)))short;
using f32x16=__attribute__((ext_vector_type(16)))float;
using u32x4=__attribute__((ext_vector_type(4)))unsigned;
constexpr int SEQ=2048,D=64,DM=1024;
constexpr int NW=8,QBLK=32,QB=QBLK*NW,KVBLK=64,NQB=SEQ/QB;
constexpr int ATTN_PITCH=DM, ATTN_UNIT_ROWS=QB;
__device__ __forceinline__ int crow(int r,int hi){return (r&3)+8*(r>>2)+4*hi;}
#define SBAR() __builtin_amdgcn_sched_barrier(0)
__device__ __forceinline__ void cmask(f32x16&p0,f32x16&p1,int jb,int qrel,int hi){
  const float NEG=-INFINITY;
  if(64*jb>(qrel|63)){
  #pragma unroll
  for(int r=0;r<16;++r){p0[r]=NEG;p1[r]=NEG;} }
}

constexpr int NSLOT=3, SLOTB=8192;
constexpr int LDS_K=0, LDS_V=NSLOT*SLOTB, LDS_WS=2*NSLOT*SLOTB, LDS_OST=LDS_WS+NW*64*4, LDS_BYTES=LDS_OST+NW*4096;
constexpr float C2=0.125f*1.4426950408889634f;
__device__ __forceinline__ void glds16(const void*gsrc,unsigned lds_dst){unsigned keep;
  asm volatile("s_mov_b32 %0, m0\n\ts_mov_b32 m0, %2\n\ts_nop 0\n\tglobal_load_lds_dwordx4 %1, off\n\ts_mov_b32 m0, %0":"=&s"(keep):"v"(gsrc),"s"(lds_dst):"memory");}
__device__ __forceinline__ float max3f(float a,float b,float c){float r;asm("v_max3_f32 %0, %1, %2, %3":"=v"(r):"v"(a),"v"(b),"v"(c));return r;}
__device__ __forceinline__ float max2f(float a,float b){float r;asm("v_max_f32_e32 %0, %1, %2":"=v"(r):"v"(a),"v"(b));return r;}
__device__ __forceinline__ float fadd_s(float a,float b){float r;asm("v_add_f32_e32 %0, %1, %2":"=v"(r):"v"(a),"v"(b));return r;}
__device__ __forceinline__ float fsub_s(float a,float b){float r;asm("v_sub_f32_e32 %0, %1, %2":"=v"(r):"v"(a),"v"(b));return r;}
typedef float f32x2_t __attribute__((ext_vector_type(2))); typedef __bf16 bf16x2_t __attribute__((ext_vector_type(2)));
__device__ __forceinline__ unsigned cvtpk_s(float lo,float hi){f32x2_t v={lo,hi};bf16x2_t b=__builtin_convertvector(v,bf16x2_t);return __builtin_bit_cast(unsigned,b);}
#define WAIT_BAR(N) asm volatile("s_waitcnt vmcnt(" #N ") lgkmcnt(0)\n\ts_barrier":::"memory")

__device__ __forceinline__ void qkt(f32x16&p0,f32x16&p1,const char*Kslot,const bf16x8*qr,const f32x16&negm,int r32,int hi){
  const char*kb=Kslot+hi*1024+r32*16;
  #pragma unroll
  for(int d0=0;d0<4;++d0){
    const bf16x8 b0=*reinterpret_cast<const bf16x8*>(kb+d0*2048);
    const bf16x8 b1=*reinterpret_cast<const bf16x8*>(kb+d0*2048+512);
    if(d0==0){p0=__builtin_amdgcn_mfma_f32_32x32x16_bf16(b0,qr[0],negm,0,0,0);p1=__builtin_amdgcn_mfma_f32_32x32x16_bf16(b1,qr[0],negm,0,0,0);}
    else{p0=__builtin_amdgcn_mfma_f32_32x32x16_bf16(b0,qr[d0],p0,0,0,0);p1=__builtin_amdgcn_mfma_f32_32x32x16_bf16(b1,qr[d0],p1,0,0,0);}}
}
typedef __attribute__((address_space(3))) const char* lds_cptr;
typedef short v4i16_t __attribute__((ext_vector_type(4)));
__device__ __forceinline__ void kload8(bf16x8*kf,lds_cptr kp){
  kf[0]=*(const __attribute__((address_space(3))) bf16x8*)(kp);      kf[1]=*(const __attribute__((address_space(3))) bf16x8*)(kp+512);
  kf[2]=*(const __attribute__((address_space(3))) bf16x8*)(kp+2048); kf[3]=*(const __attribute__((address_space(3))) bf16x8*)(kp+2560);
  kf[4]=*(const __attribute__((address_space(3))) bf16x8*)(kp+4096); kf[5]=*(const __attribute__((address_space(3))) bf16x8*)(kp+4608);
  kf[6]=*(const __attribute__((address_space(3))) bf16x8*)(kp+6144); kf[7]=*(const __attribute__((address_space(3))) bf16x8*)(kp+6656);
}
__device__ __forceinline__ void kload2(bf16x8*kf,lds_cptr kp,int j){ kf[2*j]=*(const __attribute__((address_space(3))) bf16x8*)(kp+j*2048); kf[2*j+1]=*(const __attribute__((address_space(3))) bf16x8*)(kp+j*2048+512); }
__device__ __forceinline__ s16x4 vtr(lds_cptr p){ return __builtin_bit_cast(s16x4,__builtin_amdgcn_ds_read_tr16_b64_v4i16((__attribute__((address_space(3))) v4i16_t*)p)); }
__device__ __forceinline__ float rowmax(const f32x16&p0,const f32x16&p1){
  float a=max3f(p0[0],p0[1],p1[0]),b=max3f(p0[2],p0[3],p1[1]);a=max3f(a,p1[2],p1[3]);
  #pragma unroll
  for(int r=4;r<16;r+=4){a=max3f(a,p0[r],p0[r+1]);b=max3f(b,p0[r+2],p0[r+3]);a=max3f(a,p1[r],p1[r+1]);b=max3f(b,p1[r+2],p1[r+3]);}
  const float m=max2f(a,b);
  auto rr=__builtin_amdgcn_permlane32_swap(__float_as_uint(m),__float_as_uint(m),false,false);
  return max2f(__uint_as_float(rr[0]),__uint_as_float(rr[1]));
}
__device__ __forceinline__ void pv(f32x16*o,int vb,bf16x8 pa0,bf16x8 pa1,bf16x8 pa2,bf16x8 pa3){
  #pragma unroll
  for(int d0=0;d0<2;++d0){s16x4 lo[4],hi[4];
    #pragma unroll
    for(int ks=0;ks<4;++ks){
      asm volatile("ds_read_b64_tr_b16 %0,%1 offset:%c2":"=&v"(lo[ks]):"v"(vb),"i"(d0*4096+ks*1024):"memory");
      asm volatile("ds_read_b64_tr_b16 %0,%1 offset:%c2":"=&v"(hi[ks]):"v"(vb),"i"(d0*4096+ks*1024+512):"memory");}
    asm volatile("s_waitcnt lgkmcnt(0)":::"memory");SBAR();
    #define PK(k) (bf16x8){lo[k][0],lo[k][1],lo[k][2],lo[k][3],hi[k][0],hi[k][1],hi[k][2],hi[k][3]}
    o[d0]=__builtin_amdgcn_mfma_f32_32x32x16_bf16(pa0,PK(0),o[d0],0,0,0);
    o[d0]=__builtin_amdgcn_mfma_f32_32x32x16_bf16(pa1,PK(1),o[d0],0,0,0);
    o[d0]=__builtin_amdgcn_mfma_f32_32x32x16_bf16(pa2,PK(2),o[d0],0,0,0);
    o[d0]=__builtin_amdgcn_mfma_f32_32x32x16_bf16(pa3,PK(3),o[d0],0,0,0);
    #undef PK
  }
}

#ifndef ATTN_STORE16
#define ATTN_STORE16(p,v) (*(u32x4*)(p)=(v))
#endif
template<int THRL> __device__ __forceinline__ void attn_unit(int b,int h,int hv,int qb,const bf16*Q,const bf16*__restrict__ K,const bf16*__restrict__ V,bf16*O,char*shm){
  const int tid=threadIdx.x,lane=tid&63,r32=lane&31,hi=lane>>5; const int wid=__builtin_amdgcn_readfirstlane(tid>>6);
  const long rowbase=(long)b*SEQ; const int q0=qb*QB;
  const bf16*Qw=Q+(rowbase+q0+wid*QBLK)*DM+h*D;
  const bf16*Kh=K+rowbase*DM+h*D,*Vh=V+rowbase*DM+hv*D;
  const unsigned lds0=(unsigned)(uintptr_t)shm;
  float*wsf=(float*)(shm+LDS_WS)+wid*64;
  const bf16*ksrc=Kh+(long)lane*DM+wid*8;
  const bf16*vsrc=Vh+(long)(16*(wid&3)+(lane>>2))*DM+(wid>>2)*32+(lane&3)*8;
  const unsigned kdst=lds0+LDS_K+wid*1024, vdst=lds0+LDS_V+wid*1024;
  #define DMA_K(t,slot) glds16(ksrc+(long)(t)*KVBLK*DM,(unsigned)__builtin_amdgcn_readfirstlane(kdst+(slot)))
  #define DMA_V(t,slot) glds16(vsrc+(long)(t)*KVBLK*DM,(unsigned)__builtin_amdgcn_readfirstlane(vdst+(slot)))
  const int vb0=(int)(lds0+LDS_V)+((lane>>4)&1)*32+(lane&3)*8+(4*hi+((lane&15)>>2))*64;
  const char*Kbase=shm+LDS_K; bf16x8 kf[8];
  const lds_cptr shm3=(lds_cptr)shm; const lds_cptr kp0=shm3+LDS_K+hi*1024+r32*16; const lds_cptr vp0=shm3+LDS_V+((lane>>4)&1)*32+(lane&3)*8+(4*hi+((lane&15)>>2))*64;
  const int NT=(q0+QB)/KVBLK;
  DMA_K(0,0);DMA_V(0,0);DMA_K(1,SLOTB);
  bf16x8 qr[4];
  #pragma unroll
  for(int d0=0;d0<4;++d0)qr[d0]=*reinterpret_cast<const bf16x8*>(&Qw[(long)r32*DM+d0*16+hi*8]);
  float mhat=0.f,l_reg=0.f;f32x16 o[2];o[0]=f32x16{};o[1]=f32x16{};f32x16 negm=f32x16{};asm volatile("":"+v"(negm));
  const int qrel=wid*QBLK+r32;
  #define CMASK(P0,P1,t) do{int jb_=(t)-(NT-4); if(jb_>=0)cmask(P0,P1,jb_,qrel,hi);}while(0)
  bool resc=false;
  #define START(P0,P1) do{ const float rm=rowmax(P0,P1); resc=false; \
    { const float dl=rm; mhat=fadd_s(mhat,dl); \
      _Pragma("unroll") for(int r=0;r<16;++r){P0[r]=fsub_s(P0[r],dl);P1[r]=fsub_s(P1[r],dl);} \
      _Pragma("unroll") for(int r=0;r<16;++r)negm[r]=-mhat; asm volatile("":"+v"(negm)); } \
    _Pragma("unroll") for(int r=0;r<16;++r)P0[r]=__builtin_amdgcn_exp2f(P0[r]); }while(0)
  #define RESC() do{ if(resc){ asm volatile("s_waitcnt lgkmcnt(0)":::"memory"); \
      _Pragma("unroll") for(int d_=0;d_<2;++d_) _Pragma("unroll") for(int r=0;r<16;++r)o[d_][r]*=wsf[crow(r,hi)]; } }while(0)
  f32x16 pA0,pA1,pB0,pB1;
  int sl_prev=0,sl_cur=0,sl_next=SLOTB;
  #define ROT() do{sl_prev=sl_cur;sl_cur=sl_next;sl_next=(sl_next==(NSLOT-1)*SLOTB)?0:sl_next+SLOTB;}while(0)
  DMA_K(2,2*SLOTB);
  WAIT_BAR(3);
  qkt(pA0,pA1,Kbase,qr,negm,r32,hi);asm volatile("s_nop 15\n\ts_nop 7":"+v"(pA0),"+v"(pA1));CMASK(pA0,pA1,0);
  START(pA0,pA1);
  _Pragma("unroll") for(int r=0;r<16;++r)pA1[r]=__builtin_amdgcn_exp2f(pA1[r]);
  WAIT_BAR(0);
  DMA_K(3,0);DMA_V(1,SLOTB);
  ROT();
  kload8(kf,kp0+sl_cur);
  WAIT_BAR(2);
  s16x4 vlo[8],vhi[8]; u32x4 pw0,pw1,pw2,pw3;
  #define PKW(P,B) cvtpk_s(P[B],P[B+1])
  #define PAF(k) __builtin_bit_cast(bf16x8,pw##k)
  #define VFR(i) (bf16x8){vlo[i][0],vlo[i][1],vlo[i][2],vlo[i][3],vhi[i][0],vhi[i][1],vhi[i][2],vhi[i][3]}
  #define PIN(x) asm volatile("":"+v"(x))
  #define MX3(a,b,c) __builtin_fmaxf(__builtin_fmaxf((a),(b)),(c))
  #define GAPA(MF,A0,A1,A2,A3,W0,W1,PW) do{ MF; sacc+=A0; sacc+=A1; sacc+=A2; sacc+=A3; PIN(sacc); W0; W1; PIN(PW); SBAR(); }while(0)
  #define EX(v) __builtin_amdgcn_exp2f(v)
  #define GAPB(MF,X,B) do{ MF; X[B]=EX(X[B]); X[B+1]=EX(X[B+1]); X[B+2]=EX(X[B+2]); X[B+3]=EX(X[B+3]); PIN(X); SBAR(); }while(0)
  #define VRD(i) do{ vlo[i]=vtr(vp_+(((i)>>2)*4096+((i)&3)*1024)); vhi[i]=vtr(vp_+(((i)>>2)*4096+((i)&3)*1024+512)); }while(0)
  #define KRD(G,j) do{ if(G){ kload2(kf,kp0+sl_next,j); SBAR(); } }while(0)
  #define STEP(C0,C1,P0,P1,t,GK,GV,GL) do{ SBAR(); \
    const lds_cptr vp_=vp0+sl_prev; \
    VRD(0); SBAR(); float sacc=(P0[0]+P0[1]); \
    GAPA(C0=__builtin_amdgcn_mfma_f32_32x32x16_bf16(kf[0],qr[0],negm,0,0,0), P0[2],P0[3],P0[4],P0[5],     pw0[0]=PKW(P0,0), pw0[1]=PKW(P0,2), pw0); \
    VRD(4); SBAR(); GAPA(C1=__builtin_amdgcn_mfma_f32_32x32x16_bf16(kf[1],qr[0],negm,0,0,0), P0[6],P0[7],P0[8],P0[9],     pw0[2]=PKW(P0,4), pw0[3]=PKW(P0,6), pw0); \
    VRD(1); SBAR(); GAPA(C0=__builtin_amdgcn_mfma_f32_32x32x16_bf16(kf[2],qr[1],C0,0,0,0),   P0[10],P0[11],P0[12],P0[13], pw1[0]=PKW(P0,8), pw1[1]=PKW(P0,10), pw1); \
    VRD(5); SBAR(); GAPA(C1=__builtin_amdgcn_mfma_f32_32x32x16_bf16(kf[3],qr[1],C1,0,0,0),   P0[14],P0[15],P1[0],P1[1],   pw1[2]=PKW(P0,12),pw1[3]=PKW(P0,14), pw1); \
    VRD(2); SBAR(); GAPA(C0=__builtin_amdgcn_mfma_f32_32x32x16_bf16(kf[4],qr[2],C0,0,0,0),   P1[2],P1[3],P1[4],P1[5],     pw2[0]=PKW(P1,0), pw2[1]=PKW(P1,2), pw2); \
    VRD(6); SBAR(); GAPA(C1=__builtin_amdgcn_mfma_f32_32x32x16_bf16(kf[5],qr[2],C1,0,0,0),   P1[6],P1[7],P1[8],P1[9],     pw2[2]=PKW(P1,4), pw2[3]=PKW(P1,6), pw2); \
    VRD(3); SBAR(); GAPA(C0=__builtin_amdgcn_mfma_f32_32x32x16_bf16(kf[6],qr[3],C0,0,0,0),   P1[10],P1[11],P1[12],P1[13], pw3[0]=PKW(P1,8), pw3[1]=PKW(P1,10), pw3); \
    VRD(7); SBAR(); GAPA(C1=__builtin_amdgcn_mfma_f32_32x32x16_bf16(kf[7],qr[3],C1,0,0,0),   P1[14],P1[15],0.f,0.f,       pw3[2]=PKW(P1,12),pw3[3]=PKW(P1,14), pw3); \
    l_reg+=sacc; \
    if(GK){DMA_K((t)+3,sl_cur);} if(GV){DMA_V((t)+1,sl_next);} \
    CMASK(C0,C1,t); \
    { float a=MX3(C0[0],C0[1],C1[0]),b=MX3(C0[2],C0[3],C1[1]); a=MX3(a,C1[2],C1[3]); \
      _Pragma("unroll") for(int r=4;r<16;r+=4){a=MX3(a,C0[r],C0[r+1]);b=MX3(b,C0[r+2],C0[r+3]);a=MX3(a,C1[r],C1[r+1]);b=MX3(b,C1[r+2],C1[r+3]);} \
      float rm=__builtin_fmaxf(a,b); { auto rr=__builtin_amdgcn_permlane32_swap(__float_as_uint(rm),__float_as_uint(rm),false,false); rm=__builtin_fmaxf(__uint_as_float(rr[0]),__uint_as_float(rr[1])); } \
      resc=false; \
      if(__builtin_expect(__any(rm>(float)THRL),0)){ const float dl=__builtin_fmaxf(rm,0.f); mhat+=dl; \
        _Pragma("unroll") for(int r=0;r<16;++r){C0[r]-=dl;C1[r]-=dl;} \
        _Pragma("unroll") for(int r=0;r<16;++r)negm[r]=-mhat; asm volatile("":"+v"(negm)); \
        const float f=__builtin_amdgcn_exp2f(-dl); l_reg*=f; if(hi==0)wsf[r32]=f; resc=true; } } \
    SBAR(); \
    GAPB(o[0]=__builtin_amdgcn_mfma_f32_32x32x16_bf16(PAF(0),VFR(0),o[0],0,0,0), C0,0); \
    GAPB(o[1]=__builtin_amdgcn_mfma_f32_32x32x16_bf16(PAF(0),VFR(4),o[1],0,0,0), C0,4); \
    KRD(GL,0); GAPB(o[0]=__builtin_amdgcn_mfma_f32_32x32x16_bf16(PAF(1),VFR(1),o[0],0,0,0), C0,8); \
    KRD(GL,1); GAPB(o[1]=__builtin_amdgcn_mfma_f32_32x32x16_bf16(PAF(1),VFR(5),o[1],0,0,0), C0,12); \
    KRD(GL,2); GAPB(o[0]=__builtin_amdgcn_mfma_f32_32x32x16_bf16(PAF(2),VFR(2),o[0],0,0,0), C1,0); \
    KRD(GL,3); GAPB(o[1]=__builtin_amdgcn_mfma_f32_32x32x16_bf16(PAF(2),VFR(6),o[1],0,0,0), C1,4); \
    GAPB(o[0]=__builtin_amdgcn_mfma_f32_32x32x16_bf16(PAF(3),VFR(3),o[0],0,0,0), C1,8); \
    GAPB(o[1]=__builtin_amdgcn_mfma_f32_32x32x16_bf16(PAF(3),VFR(7),o[1],0,0,0), C1,12); \
    }while(0)
  int t=1;
  #undef CMASK
  #define CMASK(P0,P1,t) do{}while(0)
  for(;t+5<NT;t+=2){
    STEP(pB0,pB1,pA0,pA1,t,true,true,true);     WAIT_BAR(2); RESC(); ROT();
    STEP(pA0,pA1,pB0,pB1,t+1,true,true,true);   WAIT_BAR(2); RESC(); ROT();
  }
  #undef CMASK
  #define CMASK(P0,P1,t) do{int jb_=(t)-(NT-4); if(jb_>=0)cmask(P0,P1,jb_,qrel,hi);}while(0)
  #define ENDW(tt) do{ if((tt)+3<NT){WAIT_BAR(2);} else if((tt)+2<NT){WAIT_BAR(1);} else {WAIT_BAR(0);} }while(0)
  for(;t+1<NT;t+=2){
    STEP(pB0,pB1,pA0,pA1,t,(t+3<NT),(t+1<NT),(t+1<NT));       ENDW(t);   RESC(); ROT();
    STEP(pA0,pA1,pB0,pB1,t+1,(t+4<NT),(t+2<NT),(t+2<NT));     ENDW(t+1); RESC(); ROT();
  }
  STEP(pB0,pB1,pA0,pA1,NT-1,false,false,false); RESC();
  { float sacc=pB0[0]+pB0[1]; _Pragma("unroll") for(int r=2;r<16;++r)sacc+=pB0[r]; _Pragma("unroll") for(int r=0;r<16;++r)sacc+=pB1[r]; l_reg+=sacc;
    pw0=(u32x4){PKW(pB0,0),PKW(pB0,2),PKW(pB0,4),PKW(pB0,6)};pw1=(u32x4){PKW(pB0,8),PKW(pB0,10),PKW(pB0,12),PKW(pB0,14)};pw2=(u32x4){PKW(pB1,0),PKW(pB1,2),PKW(pB1,4),PKW(pB1,6)};pw3=(u32x4){PKW(pB1,8),PKW(pB1,10),PKW(pB1,12),PKW(pB1,14)};
    SBAR(); pv(o,vb0+sl_cur,PAF(0),PAF(1),PAF(2),PAF(3)); }
  #undef PKW
  #undef PAF
  #undef VFR
  #undef PIN
  #undef MX3
  #undef GAPA
  #undef GAPB
  #undef EX
  #undef VRD
  #undef KRD
  #undef STEP
  #undef ENDW
  {auto rr=__builtin_amdgcn_permlane32_swap(__float_as_uint(l_reg),__float_as_uint(l_reg),false,false);l_reg=__uint_as_float(rr[0])+__uint_as_float(rr[1]);}
  if(hi==0)wsf[32+r32]=l_reg;asm volatile("s_waitcnt lgkmcnt(0)":::"memory");
  float rli[16];
  #pragma unroll
  for(int r=0;r<16;++r)rli[r]=__builtin_amdgcn_rcpf(wsf[32+crow(r,hi)]);
  bf16*Ow=O+(rowbase+q0+wid*QBLK)*DM+hv*D;
  { bf16*stg=(bf16*)(shm+LDS_OST)+wid*2048;
    #pragma unroll
    for(int r=0;r<16;++r){const int orow=crow(r,hi);
      #pragma unroll
      for(int d0=0;d0<2;++d0)stg[orow*64+d0*32+r32]=__float2bfloat16(o[d0][r]*rli[r]);}
    asm volatile("s_waitcnt lgkmcnt(0)":::"memory");
    #pragma unroll
    for(int i=0;i<4;++i){const int row=i*8+(lane>>3),ch=lane&7; const u32x4 v=*(const u32x4*)(stg+row*64+ch*8); ATTN_STORE16(Ow+(long)row*DM+ch*8,v);} }
  asm volatile("s_waitcnt lgkmcnt(0)\n\ts_barrier":::"memory");
  #undef DMA_K
  #undef DMA_V
  #undef CMASK
  #undef START
  #undef RESC
  #undef ROT
}
constexpr int ATTN_LDS_BYTES=LDS_BYTES;
#undef SBAR
#undef WAIT_BAR
}

#define ACC8(v, A_, ai, bj, m) float v[8] = {A_[ai][bj][m][0][0], A_[ai][bj][m][0][1], A_[ai][bj][m][0][2], A_[ai][bj][m][0][3], A_[ai][bj][m][1][0], A_[ai][bj][m][1][1], A_[ai][bj][m][1][2], A_[ai][bj][m][1][3]}
struct EpiProjFast { static constexpr bool PERM = true, MID = false; const Frame* F;
    static constexpr float PSC = PROJ_FP8 ? W8I : 1.0f;
    __device__ __forceinline__ void operator()(const f32x4 (&acc)[2][2][4][2], const fg::Unit& u, int wr, int wc, int fr, int fq) const {
        const int row0 = u.pm * 256 + wr * 64 + fr, col0 = u.pn * 256 + wc * 32 + 8 * fq;
        const int sec = u.pn >> 2;
        if (sec == 1) {
            const float* lb = wsp<const float>(*F, WS_LB) + (col0 - 1024);
            f32x4 l4[2][2];
#pragma unroll
            for (int bj = 0; bj < 2; ++bj) { l4[bj][0] = *(const f32x4*)(lb + bj * 128); l4[bj][1] = *(const f32x4*)(lb + bj * 128 + 4); }
#pragma unroll
            for (int ai = 0; ai < 2; ++ai)
#pragma unroll
                for (int m = 0; m < 4; ++m)
#pragma unroll
                    for (int bj = 0; bj < 2; ++bj) {
                        f32x4 o[2];
#pragma unroll
                        for (int n = 0; n < 2; ++n)
#pragma unroll
                            for (int i = 0; i < 4; ++i) { const float l = l4[bj][n][i]; o[n][i] = __logf(l + (1.0f - l) * sigmoidf_(acc[ai][bj][m][n][i] * PSC)); }
                        float* op = wsp<float>(*F, WS_LOGF) + (size_t)(row0 + ai * 128 + m * 16) * HW + (col0 - 1024) + bj * 128;
                        *(f32x4*)op = o[0]; *(f32x4*)(op + 4) = o[1];
                    }
        } else if (sec == 4 || sec == 5) {
            const bool ropel = ((wc & 1) == 0) && (fq < 2);
            const float sg = (fq == 0) ? -1.0f : 1.0f;
            bf16* dst = wsp<bf16>(*F, sec == 4 ? WS_QDA : WS_KDA); const int cb = col0 - (sec == 4 ? 4096 : 5120);
            const float scl = (sec == 4 ? QSCALE : 1.0f) * PSC;
#pragma unroll
            for (int am = 0; am < 2; ++am) {
                const int ai = am, mb = 0;
                f32x4 rt[4][4];
#pragma unroll
                for (int mm = 0; mm < 4; ++mm) { const float* rp = wsp<const float>(*F, WS_ROPE) + (size_t)((row0 + ai * 128 + (mb + mm) * 16) & (SEQ - 1)) * 16;
#pragma unroll
                    for (int q = 0; q < 4; ++q) rt[mm][q] = *(const f32x4*)(rp + 4 * q); }
#pragma unroll
                for (int mm = 0; mm < 4; ++mm)
#pragma unroll
                    for (int bj = 0; bj < 2; ++bj) {
                        const int m = mb + mm;
                        ACC8(v, acc, ai, bj, m);
                        float pv[8];
#pragma unroll
                        for (int i = 0; i < 8; ++i) pv[i] = __shfl_xor(v[i], 16);
#pragma unroll
                        for (int i = 0; i < 8; ++i) { const float cs = ropel ? rt[mm][i >> 2][i & 3] : 1.0f, sn = ropel ? sg * rt[mm][2 + (i >> 2)][i & 3] : 0.0f; v[i] = v[i] * cs + pv[i] * sn; }
#pragma unroll
                        for (int i = 0; i < 8; ++i) v[i] *= scl;
                        store8_bf16(dst + (size_t)(row0 + ai * 128 + m * 16) * HW + cb + bj * 128, v);
                    }
            }
        } else if (sec >= 7) {
            const int gc0 = (u.pn - 28) * 128 + wc * 32 + 8 * fq;
            bf16* RT = wsp<bf16>(*F, WS_GATEH); bf16* GD = wsp<bf16>(*F, WS_GATED);
#pragma unroll
            for (int ai = 0; ai < 2; ++ai)
#pragma unroll
                for (int m = 0; m < 4; ++m) {
                    ACC8(a, acc, ai, 0, m); ACC8(b, acc, ai, 1, m);
                    float rt[8], gd[8];
#pragma unroll
                    for (int i = 0; i < 8; ++i) {
                        const float ea = __builtin_fminf(__builtin_amdgcn_exp2f(-1.4426950408889634f * PSC * a[i]), 1e30f), eb = __builtin_fminf(__builtin_amdgcn_exp2f(-1.4426950408889634f * PSC * b[i]), 1e30f);
                        rt[i] = (1.0f + eb) * __builtin_amdgcn_rcpf(1.0f + ea); gd[i] = __builtin_amdgcn_rcpf(1.0f + eb);
                    }
                    const size_t off = (size_t)(row0 + ai * 128 + m * 16) * DM + gc0;
                    store8_bf16(RT + off, rt); store8_bf16(GD + off, gd);
                }
        } else {
#pragma unroll
            for (int ai = 0; ai < 2; ++ai)
#pragma unroll
                for (int m = 0; m < 4; ++m)
#pragma unroll
                    for (int bj = 0; bj < 2; ++bj) { ACC8(v, acc, ai, bj, m);
#pragma unroll
                        for (int i = 0; i < 8; ++i) v[i] *= PSC;
                        proj_store8(*F, row0 + ai * 128 + m * 16, col0 + bj * 128, v, 16); }
        }
    } };
__device__ __forceinline__ void ph_proj_fast(Frame& F) {
#if PROJ_FP8
    fg::DenseOrderT<true> S; S.init(wsp<const bf16>(F, WS_H1), wsp<const bf16>(F, WS_WIN_T), T, INC, DM / 2, F.G, F.bid);
    EpiProjFast E{&F};
    fg::gemm_phase(F.lds, DM / 2, S, E);
#else
    fg::DenseOrder S; S.init(wsp<const bf16>(F, WS_H1), wsp<const bf16>(F, WS_WIN_T), T, INC, DM, F.G, F.bid);
    EpiProjFast E{&F};
    fg::gemm_phase(F.lds, DM, S, E);
#endif
}
struct EpiBranchFast { static constexpr bool PERM = true, MID = true; const Frame* F;
    __device__ __forceinline__ void mid(f32x4 (&acc)[2][2][4][2], const fg::Unit& u, int wr, int wc, int fr, int fq) const {
        int row0 = u.pm * 256 + wr * 64 + fr, col0 = u.pn * 256 + wc * 32 + 8 * fq;
        asm volatile("" : "+v"(row0), "+v"(col0));
        const bf16* RT = wsp<const bf16>(*F, WS_GATEH);
        u32x4 rt2[2][2][4];
#pragma unroll
        for (int ai = 0; ai < 2; ++ai)
#pragma unroll
            for (int bj = 0; bj < 2; ++bj)
#pragma unroll
                for (int m = 0; m < 4; ++m) rt2[ai][bj][m] = *(const u32x4*)(RT + (size_t)(row0 + ai * 128 + m * 16) * DM + col0 + bj * 128);
#pragma unroll
        for (int ai = 0; ai < 2; ++ai)
#pragma unroll
            for (int bj = 0; bj < 2; ++bj)
#pragma unroll
                for (int m = 0; m < 4; ++m) {
                    const unsigned hh[4] = {rt2[ai][bj][m].x, rt2[ai][bj][m].y, rt2[ai][bj][m].z, rt2[ai][bj][m].w};
#pragma unroll
                    for (int i = 0; i < 4; ++i) { acc[ai][bj][m][i >> 1][(i & 1) * 2] *= bf2f(hh[i] & 0xffffu); acc[ai][bj][m][i >> 1][(i & 1) * 2 + 1] *= bf2f(hh[i] >> 16); }
                }
    }
    __device__ __forceinline__ void operator()(const f32x4 (&acc)[2][2][4][2], const fg::Unit& u, int wr, int wc, int fr, int fq) const {
        const int row0 = u.pm * 256 + wr * 64 + fr, col0 = u.pn * 256 + wc * 32 + 8 * fq;
        const bf16* GD = wsp<const bf16>(*F, WS_GATED);
        u32x4 gda[2][4][2];
#pragma unroll
        for (int ai = 0; ai < 2; ++ai)
#pragma unroll
            for (int m = 0; m < 4; ++m)
#pragma unroll
                for (int bj = 0; bj < 2; ++bj) gda[ai][m][bj] = *(const u32x4*)(GD + (size_t)(row0 + ai * 128 + m * 16) * DM + col0 + bj * 128);
#pragma unroll
        for (int ai = 0; ai < 2; ++ai) {
#pragma unroll
            for (int m = 0; m < 4; ++m)
#pragma unroll
                for (int bj = 0; bj < 2; ++bj) {
                    const u32x4 g = gda[ai][m][bj]; const f32x4 a0 = acc[ai][bj][m][0], a1 = acc[ai][bj][m][1];
                    float o[8] = {a0[0] * bf2f(g.x & 0xffffu), a0[1] * bf2f(g.x >> 16), a0[2] * bf2f(g.y & 0xffffu), a0[3] * bf2f(g.y >> 16),
                                  a1[0] * bf2f(g.z & 0xffffu), a1[1] * bf2f(g.z >> 16), a1[2] * bf2f(g.w & 0xffffu), a1[3] * bf2f(g.w >> 16)};
#if BRANCH_FP8
#pragma unroll
                    for (int i = 0; i < 8; ++i) o[i] *= W8I;
#endif
#if WOUT_FP8
                    { u32x2 p; p.x = pk4_fp8(clamp8(o[0]), clamp8(o[1]), clamp8(o[2]), clamp8(o[3])); p.y = pk4_fp8(clamp8(o[4]), clamp8(o[5]), clamp8(o[6]), clamp8(o[7]));
                      *(u32x2*)(wsp<unsigned char>(*F, WS_MERGED) + (size_t)(row0 + ai * 128 + m * 16) * DM + col0 + bj * 128) = p; }
#else
                    store8_bf16(wsp<bf16>(*F, WS_MERGED) + (size_t)(row0 + ai * 128 + m * 16) * DM + col0 + bj * 128, o);
#endif
                }
        }
    } };
__device__ __forceinline__ void ph_branch_fast(Frame& F) {
#if BRANCH_FP8
    fg::DenseOrderT<true> S; S.init(wsp<const bf16>(F, WS_YCAT), wsp<const bf16>(F, WS_WBH_T), T, DM, DM / 2, F.G, F.bid);
    EpiBranchFast E{&F};
    fg::gemm_phase(F.lds, DM / 2, S, E);
#else
    fg::DenseOrder S; S.init(wsp<const bf16>(F, WS_YCAT), wsp<const bf16>(F, WS_WBH_T), T, DM, DM, F.G, F.bid);
    EpiBranchFast E{&F};
    fg::gemm_phase(F.lds, DM, S, E);
#endif
}
struct EpiUFast { static constexpr bool PERM = true, MID = false; const Frame* F;
    __device__ __forceinline__ void operator()(const f32x4 (&acc)[2][2][4][2], const fg::Unit& u, int wr, int wc, int fr, int fq) const {
        const int row0 = u.pm * 256 + wr * 64 + fr, col0 = u.pn * 256 + wc * 32 + 8 * fq;
#pragma unroll
        for (int ai = 0; ai < 2; ++ai)
#pragma unroll
            for (int m = 0; m < 4; ++m)
#pragma unroll
                for (int bj = 0; bj < 2; ++bj) { ACC8(v, acc, ai, bj, m);
#if WOUT_FP8
#pragma unroll
                    for (int i = 0; i < 8; ++i) v[i] *= W8I;
#endif
                    store8_bf16(wsp<bf16>(*F, WS_U) + (size_t)(row0 + ai * 128 + m * 16) * DM + col0 + bj * 128, v); }
    } };
__device__ __forceinline__ void ph_wout_fast(Frame& F) {
#if WOUT_FP8
    fg::DenseOrderT<true> S; S.init(wsp<const bf16>(F, WS_MERGED), wsp<const bf16>(F, WS_WOUT_T), T, DM, DM / 2, F.G, F.bid);
    EpiUFast E{&F};
    fg::gemm_phase(F.lds, DM / 2, S, E);
#else
    fg::DenseOrder S; S.init(wsp<const bf16>(F, WS_MERGED), wsp<const bf16>(F, WS_WOUT_T), T, DM, DM, F.G, F.bid);
    EpiUFast E{&F};
    fg::gemm_phase(F.lds, DM, S, E);
#endif
}
struct Args;
typedef const __attribute__((address_space(4))) Args* CArgs;
constexpr int TU_L = 2, TU_M = 40 - TU_L;
constexpr int N_TU_LATE = NE * TU_L, N_TU_MIX = NE * TU_M;
__device__ __forceinline__ void t_unit(CArgs A, int e, int r);
__device__ __forceinline__ int q_claim(CArgs A, int ctr);
template <bool GATHER_, bool IDENT_ = false> struct MoeOrder {
    static constexpr bool GATHER = GATHER_, FP8 = true;
    const LAS int* tab; int G, c; const char* A; const char* Bt; int K; size_t bstride; const int* list;
    __device__ __forceinline__ bool next(int i, fg::Unit& u) const {
        const int q = i * (G >> 3) + (c >> 3), x = c & 7;
        const int mtg = 2 * (q >> 1) + (x >> 2), pn = 2 * (x & 3) + (q & 1);
        if (mtg >= tab[72 + NE]) return false;
        int e = 0;
#pragma unroll
        for (int st = 16; st >= 1; st >>= 1) if (tab[72 + e + st] <= mtg) e += st;
        const int mt = mtg - tab[72 + e];
        u.pm = mt; u.pn = pn; u.e = e; u.nvalid = min(256, tab[e] - mt * 256); u.slot0 = tab[32 + e] + mt * 256; return true;
    }
    __device__ __forceinline__ const char* a_ptr(const fg::Unit& u) const { return GATHER ? A : A + (size_t)u.slot0 * K * 2; }
    __device__ __forceinline__ int a_row(const fg::Unit& u, int r) const { if constexpr (IDENT_) return u.slot0 + r; else return r < u.nvalid ? list[u.e * 16384 + u.pm * 256 + r] : 0; }
    __device__ __forceinline__ const char* b_ptr(const fg::Unit& u) const { return Bt + (size_t)u.e * bstride + (size_t)u.pn * 256 * K * 2; }
};
struct EpiMoe1Fast { static constexpr bool PERM = true, MID = false; const Frame* F;
    __device__ __forceinline__ void operator()(const f32x4 (&acc)[2][2][4][2], const fg::Unit& u, int wr, int wc, int fr, int fq) const {
        const int col0 = u.pn * 128 + wc * 32 + 8 * fq;
#pragma unroll
        for (int ai = 0; ai < 2; ++ai)
#pragma unroll
            for (int m = 0; m < 4; ++m) {
                const int r = ai * 128 + wr * 64 + m * 16 + fr;
                ACC8(g, acc, ai, 0, m); ACC8(up, acc, ai, 1, m);
                float o[8];
#pragma unroll
                for (int i = 0; i < 8; ++i) { const float gs = g[i] * W8I; o[i] = clamp8(gs * sigmoidf_(gs) * (up[i] * W8I)); }
                if (r < u.nvalid) { u32x2 p; p.x = pk4_fp8(o[0], o[1], o[2], o[3]); p.y = pk4_fp8(o[4], o[5], o[6], o[7]); *(u32x2*)(wsp<unsigned char>(*F, WS_ACT) + (size_t)(u.slot0 + r) * DE + col0) = p; }
            }
    } };
struct EpiMoe2Fast { static constexpr bool PERM = true, MID = false; const Frame* F;
    __device__ __forceinline__ void operator()(const f32x4 (&acc)[2][2][4][2], const fg::Unit& u, int wr, int wc, int fr, int fq) const {
        const int col0 = u.pn * 256 + wc * 32 + 8 * fq;
        unsigned char* YW8 = wsp<unsigned char>(*F, WS_YW);
#pragma unroll
        for (int ai = 0; ai < 2; ++ai)
#pragma unroll
            for (int m = 0; m < 4; ++m) {
                const int r = ai * 128 + wr * 64 + m * 16 + fr;
                const bool ok = r < u.nvalid;
#pragma unroll
                for (int bj = 0; bj < 2; ++bj) { ACC8(v, acc, ai, bj, m);
#pragma unroll
                    for (int i = 0; i < 8; ++i) v[i] = clamp8(v[i] * (W8I * Y8S));
                    if (ok) { u32x2 p; p.x = pk4_fp8(v[0], v[1], v[2], v[3]); p.y = pk4_fp8(v[4], v[5], v[6], v[7]); *(u32x2*)(YW8 + (size_t)(u.slot0 + r) * DM + col0 + bj * 128) = p; } }
            }
    } };
__device__ __forceinline__ void ph_moe1_fast(Frame& F, CArgs A) {
    LAS int* tab = (LAS int*)(F.lds + 131072);
    expert_tables(F, tab, 256);
    MoeOrder<true> S{tab, F.G, F.bid, (const char*)wsp<const bf16>(F, WS_H2), (const char*)wsp<const bf16>(F, WS_WGU_T), DM / 2, (size_t)2048 * DM, wsp<const int>(F, WS_LISTTOK)};
    EpiMoe1Fast E{&F};
    fg::gemm_phase(F.lds, DM / 2, S, E);
    for (;;) {
        const int j = q_claim(A, CW_TQ + 64);
        if (j >= N_TU_LATE) break;
        t_unit(A, j / TU_L, 32 + j % TU_L);
    }
}
__device__ __forceinline__ void ph_moe2_fast(Frame& F) {
    LAS int* tab = (LAS int*)(F.lds + 131072);
    expert_tables(F, tab, 256);
    MoeOrder<true, true> S{tab, F.G, F.bid, (const char*)wsp<const bf16>(F, WS_ACT), (const char*)wsp<const bf16>(F, WS_WD_T), DE / 2, (size_t)DM * DE, nullptr};
    EpiMoe2Fast E{&F};
    fg::gemm_phase(F.lds, DE / 2, S, E);
}

struct Args { const float* in[26]; float* out; unsigned char* ws; int ph_lo, ph_hi; };
__device__ __forceinline__ void t_unit(CArgs A, int e, int r) {
    asm volatile("" : "+s"(A));
    int t_ = threadIdx.x; asm volatile("" : "+v"(t_));
    const int lane = t_ & 63, wave = __builtin_amdgcn_readfirstlane(t_ >> 6);
    unsigned char* ws = A->ws;
    f32x4 t0[8], t1[8], t2[8], t3[8];
#define T_LOADP(ta, tb, RS, N, k0, n0) do { const int vo_ = ((16 * (lane >> 3)) * (N) + (n0) + 4 * (lane & 7)) * 4; \
        _Pragma("unroll") for (int i = 0; i < 8; ++i) ta[i] = __builtin_bit_cast(f32x4, __builtin_amdgcn_raw_buffer_load_b128(RS, vo_, ((k0) + i) * (N) * 4, 2)); \
        _Pragma("unroll") for (int i = 0; i < 8; ++i) tb[i] = __builtin_bit_cast(f32x4, __builtin_amdgcn_raw_buffer_load_b128(RS, vo_, ((k0) + 8 + i) * (N) * 4, 2)); } while (0)
#define T_STOREP8(ta, tb, WT, K, k0, drow) do { _Pragma("unroll") for (int j = 0; j < 4; ++j) { u32x4 o_; \
        o_.x = pk4_fp8(ta[0][j] * W8S, ta[1][j] * W8S, ta[2][j] * W8S, ta[3][j] * W8S); o_.y = pk4_fp8(ta[4][j] * W8S, ta[5][j] * W8S, ta[6][j] * W8S, ta[7][j] * W8S); \
        o_.z = pk4_fp8(tb[0][j] * W8S, tb[1][j] * W8S, tb[2][j] * W8S, tb[3][j] * W8S); o_.w = pk4_fp8(tb[4][j] * W8S, tb[5][j] * W8S, tb[6][j] * W8S, tb[7][j] * W8S); \
        __builtin_nontemporal_store(o_, (u32x4*)((WT) + (size_t)((drow) + 4 * (lane & 7) + j) * (K) + (k0) + 16 * (lane >> 3))); } } while (0)
#define T_WAVE(W, N, WT, K, k0, n0, dr) do { \
        T_LOADP(t0, t1, W, N, k0, n0); T_LOADP(t2, t3, W, N, k0, (n0) + 32); \
        T_STOREP8(t0, t1, WT, K, k0, dr); T_LOADP(t0, t1, W, N, k0, (n0) + 64); \
        T_STOREP8(t2, t3, WT, K, k0, (dr) + 32); T_LOADP(t2, t3, W, N, k0, (n0) + 96); \
        T_STOREP8(t0, t1, WT, K, k0, (dr) + 64); T_STOREP8(t2, t3, WT, K, k0, (dr) + 96); } while (0)
    if (r < 32) {
        const int up = r >> 4, k0 = (r & 15) * 128;
        const float* Wp = (up ? A->in[24] : A->in[23]) + (size_t)e * DM * DE; unsigned char* WT = ws + WS_WGU_T + (size_t)e * 2048 * DM;
        const __amdgpu_buffer_rsrc_t W = __builtin_amdgcn_make_buffer_rsrc((void*)Wp, 0, DM * DE * 4, 0x00020000);
        const int n0 = wave * 128, dr = wave * 256 + up * 128;
        T_WAVE(W, DE, WT, DM, k0, n0, dr);
    } else {
        const int rr = r - 32, k0 = (rr >> 1) * 128, n0 = (rr & 1) * 1024 + wave * 128;
        const float* Wp = A->in[25] + (size_t)e * DE * DM; unsigned char* WT = ws + WS_WD_T + (size_t)e * DM * DE;
        const __amdgpu_buffer_rsrc_t W = __builtin_amdgcn_make_buffer_rsrc((void*)Wp, 0, DM * DE * 4, 0x00020000);
        T_WAVE(W, DM, WT, DE, k0, n0, n0);
    }
#undef T_WAVE
#undef T_LOADP
#undef T_STOREP8
}
__device__ __forceinline__ int q_claim(CArgs A, int ctr) {
    volatile LAS int* qslot = (volatile LAS int*)((LAS unsigned char*)0 + MISC_OFF + 64);
    __syncthreads();
    if (threadIdx.x == 0) *qslot = (int)__hip_atomic_fetch_add((unsigned*)(A->ws + WS_CTL) + ctr, 1u, RLX_AGENT);
    __syncthreads();
    return __builtin_amdgcn_readfirstlane(*qslot);
}
__device__ __forceinline__ int attn_claim(CArgs A, int base) {
    volatile LAS int* qslot = (volatile LAS int*)((LAS unsigned char*)0 + MISC_OFF + 64);
    __syncthreads();
    if (threadIdx.x == 0) {
        unsigned* q = (unsigned*)(A->ws + WS_CTL) + base;
        const unsigned x = xb_xcc_id() & 7u;
        int res = -1;
        unsigned j = __hip_atomic_fetch_add(q + 16 * x, 1u, RLX_AGENT);
        if (j < 256u) res = (int)(x * 256u + j);
        else {
            unsigned c[8];
#pragma unroll
            for (int k = 0; k < 8; ++k) c[k] = __hip_atomic_load(q + 16 * k, RLX_AGENT);
#pragma unroll 1
            for (unsigned k = 1; k < 8 && res < 0; ++k) { const unsigned s2 = (x + k) & 7u; bool live = false;
#pragma unroll
                for (int k2 = 0; k2 < 8; ++k2) live = live || ((unsigned)k2 == s2 && c[k2] < 256u);
                if (!live) continue;
                j = __hip_atomic_fetch_add(q + 16 * s2, 1u, RLX_AGENT);
                if (j < 256u) res = (int)(s2 * 256u + j); }
        }
        *qslot = res;
    }
    __syncthreads();
    return __builtin_amdgcn_readfirstlane(*qslot);
}
__device__ __forceinline__ void ph_mix_fast(Frame& F, CArgs A, char* lds_generic, int coff = 0) {
    constexpr float TPC = 1.25f * (float)N_TU_MIX / 55168.0f;
    float credit = (float)(F.bid & 3) * 0.5f; bool a_done = false, t_done = false;
    for (int ch = F.bid; ch < NB * NH; ch += F.G) { hgrn_chain_fast(F, ch); credit += 60.0f * TPC; }
    while (!(a_done && t_done)) {
        while (!t_done && (credit >= 1.0f || a_done)) {
            const int t = q_claim(A, CW_TQ + coff);
            if (t >= N_TU_MIX) { t_done = true; break; }
            { const int e = t / TU_M, rm = t % TU_M; t_unit(A, e, rm < 32 ? rm : rm + TU_L); } credit -= 1.0f;
        }
        if (!a_done) {
            const int a = attn_claim(A, coff ? 12288 : CW_ATTQ);
            if (a < 0) { a_done = true; continue; }
            const int sq = a >> 8, jq = a & 255, wq = jq & 63, pr = sq * 8 + 2 * (jq >> 6) + ((wq >> 2) & 1);
            const int qb = 7 - (wq >> 3), b = pr >> 3, h = pr & 7, m = (wq >> 1) & 1, vhalf = wq & 1;
            unsigned char* ws = A->ws;
            attn_body::attn_unit<8>(b, 2 * h + m, 2 * h + vhalf, qb, (const attn_body::bf16*)(ws + WS_QDA), (const attn_body::bf16*)(ws + WS_KDA), (const attn_body::bf16*)(ws + WS_VDA),
                                    (attn_body::bf16*)(ws + (m ? WS_O2 : WS_O1)), lds_generic);
            credit += (float)(4 * qb + 7) * TPC;
        }
    }
    __syncthreads();
}
__device__ __forceinline__ void ph_transposes(Frame& F) {
    LAS float* scr = (LAS float*)(F.lds + F.wave * 8704);
    const int gw = F.bid * NWAVES + F.wave, NGW = F.G * NWAVES;
    constexpr int I_IN = 32 * 352, I_BH = 16 * 64, I_OUT = 32 * 64, I_GE = 32 * 32, I_DE = 16 * 64;
    constexpr int NITEMS = I_IN + 2 * I_BH + I_OUT + (EXPERT_T_IN_MIX ? 0 : NE * (2 * I_GE + I_DE));
    for (int it = gw; it < NITEMS; it += NGW) {
        int r = it;
        if (r < I_IN) { const int kb = r / 352, nb = r % 352; const int c0_ = nb * 32;
            const int dr_ = c0_ < 7168 ? c0_ : (c0_ < 9216 ? (28 + ((c0_ - 7168) >> 7)) * 256 + ((c0_ - 7168) & 127) : (28 + ((c0_ - 9216) >> 7)) * 256 + 128 + ((c0_ - 9216) & 127));
            transpose_item<PROJ_FP8 != 0>(F.w_in, DM, INC, wsp<bf16>(F, WS_WIN_T), kb * 64, c0_, dr_, scr, F.lane); continue; } r -= I_IN;
        if (r < I_BH) { const int kb = r / 64, nb = r % 64; transpose_item<BRANCH_FP8 != 0>(F.w_bhg, HW, DM, wsp<bf16>(F, WS_WBH_T), kb * 64, nb * 32, nb * 32, scr, F.lane, DM, 0); continue; } r -= I_BH;
        if (r < I_BH) { const int kb = r / 64, nb = r % 64; transpose_item<BRANCH_FP8 != 0>(F.w_bda, HW, DM, wsp<bf16>(F, WS_WBH_T), kb * 64, nb * 32, nb * 32, scr, F.lane, DM, HW); continue; } r -= I_BH;
        if (r < I_OUT) { const int kb = r / 64, nb = r % 64; transpose_item<WOUT_FP8 != 0>(F.w_out, DM, DM, wsp<bf16>(F, WS_WOUT_T), kb * 64, nb * 32, nb * 32, scr, F.lane); continue; } r -= I_OUT;
        const int e = r / (2 * I_GE + I_DE); r -= e * (2 * I_GE + I_DE);
        if (r < 2 * I_GE) { const int up = r >= I_GE ? 1 : 0; r -= up * I_GE; const int kb = r / 32, nb = r % 32;
            transpose_item((up ? F.w_up : F.w_gate) + (size_t)e * DM * DE, DM, DE, wsp<bf16>(F, WS_WGU_T) + (size_t)e * 2048 * DM, kb * 64, nb * 32, (nb >> 2) * 256 + up * 128 + (nb & 3) * 32, scr, F.lane); continue; }
        r -= 2 * I_GE;
        { const int kb = r / 64, nb = r % 64; transpose_item(F.w_down + (size_t)e * DE * DM, DE, DM, wsp<bf16>(F, WS_WD_T) + (size_t)e * DM * DE, kb * 64, nb * 32, nb * 32, scr, F.lane); }
    }
}

__global__ void __launch_bounds__(NTHREADS, 2) mk_fwd(Args args) {
    extern __shared__ __attribute__((aligned(16))) unsigned char lds[];
    Frame F;
    CArgs A = (CArgs)__builtin_amdgcn_kernarg_segment_ptr();
    F.lds = (LAS unsigned char*)lds;
    F.G = gridDim.x; F.bid = blockIdx.x;
#define ENTER() do { asm volatile("" : "+s"(A)); int t_ = threadIdx.x; asm volatile("" : "+v"(t_)); F.tid = t_; F.lane = t_ & 63; F.wave = __builtin_amdgcn_readfirstlane(t_ >> 6); \
    F.ws = A->ws; F.ctl = (gu32*)(F.ws + WS_CTL); F.out = A->out; \
    F.x = A->in[0]; F.c = A->in[1]; F.w_ada = A->in[2]; F.b_ada = A->in[3]; F.pre_mix = A->in[4]; F.post_mix = A->in[5]; F.pre_ffn = A->in[6]; F.post_ffn = A->in[7]; \
    F.w_in = A->in[8]; F.hg_lb = A->in[9]; F.hg_nw = A->in[10]; F.lq1 = A->in[11]; F.lk1 = A->in[12]; F.lq2 = A->in[13]; F.lk2 = A->in[14]; F.da_nw = A->in[15]; \
    F.w_bhg = A->in[16]; F.w_bda = A->in[17]; F.w_out = A->in[18]; F.w_group = A->in[19]; F.b_group = A->in[20]; F.w_router = A->in[21]; F.b_router = A->in[22]; \
    F.w_gate = A->in[23]; F.w_up = A->in[24]; F.w_down = A->in[25]; } while (0)
    ENTER();
    volatile LAS unsigned* MISC = (volatile LAS unsigned*)(F.lds + MISC_OFF);
    for (int u = F.tid; u < (LDS_BYTES - LDSCTL_OFF) / 4; u += NTHREADS) ((LAS unsigned*)(F.lds + LDSCTL_OFF))[u] = 0u;
    __syncthreads();
    const int lo = A->ph_lo, hi = A->ph_hi;
    XcdBarrier bar; bar.bar = (unsigned*)(F.ctl + CW_BAR); bar.x = 0; bar.st = nullptr;
    if (hi - lo > 1) bar = xcd_barrier_post((unsigned*)(F.ctl + CW_BAR), MISC + 8);
#define IN(k) (lo <= (k) && (k) < hi)
#define SEAM(k) do { if (IN(k) && IN((k) + 1)) xcd_barrier(bar); } while (0)
#if FAST_GEMM
    if (IN(PH_PRO)) {
#pragma unroll 1
        for (int s_ = 0; s_ < 2; ++s_) {
            const bool tr_ = (s_ == 0) == ((F.bid & 1) != 0);
            if (tr_) { ENTER(); ph_transposes(F); } else { ENTER(); ph_prologue(F); }
            __syncthreads();
        }
    }
    if (PROBE_DUP == 100) { xcd_barrier(bar); ENTER(); ph_prologue(F); xcd_barrier(bar); }
    if (PROBE_DUP == PH_PRO) { xcd_barrier(bar); ENTER(); ph_transposes(F); }
#else
    if (IN(PH_PRO)) { ENTER(); ph_prologue(F); }
#endif
    SEAM(PH_PRO);
    if (IN(PH_MOD)) { ENTER(); ph_mod(F); } SEAM(PH_MOD);
    if (IN(PH_H1)) { ENTER(); ph_h1(F); }
    if (PROBE_DUP == PH_H1) { xcd_barrier(bar); ENTER(); ph_h1(F); }
    SEAM(PH_H1);
#if FAST_GEMM
    if (IN(PH_PROJ)) { ENTER(); ph_proj_fast(F); }
    if (PROBE_DUP == PH_PROJ) { xcd_barrier(bar); ENTER(); ph_proj_fast(F); }
    SEAM(PH_PROJ);
#else
    if (IN(PH_PROJ)) { ENTER(); ph_proj_simple(F); } SEAM(PH_PROJ);
#endif
#if FAST_ATTN
    if (IN(PH_MIX)) { ENTER(); ph_mix_fast(F, A, (char*)lds); }
    if (PROBE_DUP == PH_MIX) { xcd_barrier(bar); ENTER(); ph_mix_fast(F, A, (char*)lds, 32); }
    SEAM(PH_MIX);
#else
    if (IN(PH_MIX)) { ENTER(); ph_mix_simple(F); } SEAM(PH_MIX);
#endif
    if (IN(PH_YDA)) { ENTER(); ph_yda(F); }
    if (PROBE_DUP == PH_YDA) { xcd_barrier(bar); ENTER(); ph_yda(F); }
    SEAM(PH_YDA);
#if FAST_GEMM
    if (IN(PH_BRANCH)) { ENTER(); ph_branch_fast(F); }
    if (PROBE_DUP == PH_BRANCH) { xcd_barrier(bar); ENTER(); ph_branch_fast(F); }
    SEAM(PH_BRANCH);
#else
    if (IN(PH_BRANCH)) { ENTER(); ph_branch_simple(F); } SEAM(PH_BRANCH);
#endif
#if FAST_GEMM
    if (IN(PH_WOUT)) { ENTER(); ph_wout_fast(F); }
    if (PROBE_DUP == PH_WOUT) { xcd_barrier(bar); ENTER(); ph_wout_fast(F); }
    SEAM(PH_WOUT);
#else
    if (IN(PH_WOUT)) { ENTER(); ph_wout_simple(F); } SEAM(PH_WOUT);
#endif
#if FAST_POST
    if (IN(PH_POST)) { ENTER(); ph_post_fast(F); } SEAM(PH_POST);
#else
    if (IN(PH_POST)) { ENTER(); ph_post(F); } SEAM(PH_POST);
#endif
#if FAST_GEMM
    if (IN(PH_MOE1)) { ENTER(); ph_moe1_fast(F, A); }
    if (PROBE_DUP == PH_MOE1) { xcd_barrier(bar); ENTER(); ph_moe1_fast(F, A); }
    SEAM(PH_MOE1);
#else
    if (IN(PH_MOE1)) { ENTER(); ph_moe1_simple(F); } SEAM(PH_MOE1);
#endif
#if FAST_GEMM
    if (IN(PH_MOE2)) { ENTER(); ph_moe2_fast(F); }
    if (PROBE_DUP == PH_MOE2) { xcd_barrier(bar); ENTER(); ph_moe2_fast(F); }
    SEAM(PH_MOE2);
#else
    if (IN(PH_MOE2)) { ENTER(); ph_moe2_simple(F); } SEAM(PH_MOE2);
#endif
    if (IN(PH_FINAL)) { ENTER(); ph_final(F); }
    if (PROBE_DUP == PH_FINAL) { xcd_barrier(bar); ENTER(); ph_final(F); }
#undef IN
#undef SEAM
}

extern "C" void kernel_launch(void* const* d_in, const int* in_sizes, int n_in, void* d_out, int out_size, void* d_ws, size_t ws_size, hipStream_t stream) {
    static int grid = 0;
    if (grid == 0) {
        if (n_in != 26 || out_size != T * DM || ws_size < WS_END) { fprintf(stderr, "kernel_launch: unexpected shapes (n_in %d out %d ws %zu)\n", n_in, out_size, ws_size); grid = -1; return; }
        int dev = 0, cus = 0, per_cu = 0;
        if (hipGetDevice(&dev) != hipSuccess || hipDeviceGetAttribute(&cus, hipDeviceAttributeMultiprocessorCount, dev) != hipSuccess) { grid = -1; return; }
        if (hipFuncSetAttribute((const void*)mk_fwd, hipFuncAttributeMaxDynamicSharedMemorySize, LDS_BYTES) != hipSuccess) { grid = -1; return; }
        if (hipOccupancyMaxActiveBlocksPerMultiprocessor(&per_cu, (const void*)mk_fwd, NTHREADS, LDS_BYTES) != hipSuccess || per_cu < 1) { fprintf(stderr, "kernel_launch: occupancy query says %d\n", per_cu); }
        (void)hipGetLastError();
        grid = cus;
    }
    if (grid < 0) return;
    (void)hipMemsetAsync((char*)d_ws + WS_CTL, 0, CTL_ZERO_BYTES, stream);
    Args a{};
    for (int i = 0; i < 26; ++i) a.in[i] = (const float*)d_in[i];
    a.out = (float*)d_out; a.ws = (unsigned char*)d_ws;
#if MK_ONE_LAUNCH
    a.ph_lo = 0; a.ph_hi = N_PHASES;
    hipLaunchKernelGGL(mk_fwd, dim3(grid), dim3(NTHREADS), LDS_BYTES, stream, a);
#else
    for (int p = 0; p < N_PHASES; ++p) { a.ph_lo = p; a.ph_hi = p + 1; hipLaunchKernelGGL(mk_fwd, dim3(grid), dim3(NTHREADS), LDS_BYTES, stream, a); }
#endif
}
```
